# Optimizing an MI355X kernel written in HIP

```python
import math
import jax, jax.numpy as jnp
from jax import lax
import numpy as np

D_MODEL = 1024
BATCH = 2
SEQ = 8192
DEPTH = 4

D_RNN = 1024
N_RNN_BLOCKS = 8
RNN_BLOCK = D_RNN // N_RNN_BLOCKS
CONV_WIDTH = 4
LRU_C = 8.0
N_HEADS = 8
N_KV_HEADS = 2
GROUP = N_HEADS // N_KV_HEADS
HEAD_DIM = 128
WINDOW = 128
BLOCK = 128
D_ATTN = N_HEADS * HEAD_DIM
D_KV = N_KV_HEADS * HEAD_DIM
N_BRANCH = 2
D_BRANCH = 1024
OFF_XR = 0
OFF_GR = OFF_XR + D_RNN
OFF_Q = OFF_GR + D_RNN
OFF_K = OFF_Q + D_ATTN
OFF_V = OFF_K + D_KV
OFF_G = OFF_V + D_KV
D_IN = OFF_G + N_BRANCH * D_MODEL
D_FF = 3 * D_MODEL
N_EXPERTS = 8
TOP_K = 2
D_FF_EXPERT = D_FF // 2
N_DENSE = (DEPTH + 1) // 2
N_MOE = DEPTH // 2
EPS = 1e-6

kernel_name = "hybrid_rglru_swa_moe_trunk"


def rms_norm(x, gain):
    xf = x.astype(jnp.float32)
    y = xf * lax.rsqrt(jnp.mean(xf * xf, axis=-1, keepdims=True) + EPS)
    return (y * gain.astype(jnp.float32)).astype(x.dtype)


def causal_depthwise_conv(x, w, b):
    out = lax.conv_general_dilated(
        x, w[:, None, :].astype(x.dtype), window_strides=(1,),
        padding=[(CONV_WIDTH - 1, 0)], dimension_numbers=('NWC', 'WIO', 'NWC'),
        feature_group_count=x.shape[-1])
    return out + b


def rg_lru(x, w_a, b_a, w_x, b_x, lam):
    B, S, _ = x.shape
    xb = x.reshape(B, S, N_RNN_BLOCKS, RNN_BLOCK)
    r = jax.nn.sigmoid((jnp.einsum('bsni,nij->bsnj', xb, w_a).reshape(B, S, D_RNN) + b_a).astype(jnp.float32))
    i = jax.nn.sigmoid((jnp.einsum('bsni,nij->bsnj', xb, w_x).reshape(B, S, D_RNN) + b_x).astype(jnp.float32))
    log_a = -LRU_C * r * jax.nn.softplus(-lam.astype(jnp.float32))
    a = jnp.exp(log_a)
    mult = jnp.sqrt(-jnp.expm1(2.0 * log_a))
    u = mult * i * x.astype(jnp.float32)

    def combine(left, right):
        a1, b1 = left
        a2, b2 = right
        return a1 * a2, a2 * b1 + b2

    _, h = lax.associative_scan(combine, (a, u), axis=1)
    return h.astype(x.dtype)


def alibi_slopes():
    return jnp.asarray([2.0 ** (-8.0 * (h + 1) / N_HEADS) for h in range(N_HEADS)], dtype=jnp.float32)


def sliding_window_attention(q, k, v, sinks):
    B, S = q.shape[0], q.shape[1]
    nb = S // BLOCK
    qb = q.reshape(B, nb, BLOCK, N_KV_HEADS, GROUP, HEAD_DIM)
    kb = k.reshape(B, nb, BLOCK, N_KV_HEADS, HEAD_DIM)
    vb = v.reshape(B, nb, BLOCK, N_KV_HEADS, HEAD_DIM)

    def with_prev(t):
        prev = jnp.pad(t[:, :-1], ((0, 0), (1, 0), (0, 0), (0, 0), (0, 0)))
        return jnp.concatenate([prev, t], axis=2)

    kk, vv = with_prev(kb), with_prev(vb)
    scores = jnp.einsum('bnqkgd,bnskd->bnkgqs', qb, kk).astype(jnp.float32) * (HEAD_DIM ** -0.5)
    qi = jnp.arange(BLOCK)[:, None]
    sj = jnp.arange(2 * BLOCK)[None, :]
    dist = (qi + BLOCK - sj).astype(jnp.float32)
    key_pos = jnp.arange(nb)[:, None] * BLOCK - BLOCK + jnp.arange(2 * BLOCK)[None, :]
    valid = ((dist >= 0) & (dist < WINDOW))[None, :, :] & (key_pos >= 0)[:, None, :]
    slopes = alibi_slopes().reshape(N_KV_HEADS, GROUP)
    scores = scores - slopes[:, :, None, None] * dist
    scores = jnp.where(valid[None, :, None, None], scores, jnp.finfo(jnp.float32).min)
    sink = jnp.broadcast_to(sinks.astype(jnp.float32).reshape(N_KV_HEADS, GROUP)[None, None, :, :, None, None],
                            scores.shape[:-1] + (1,))
    probs = jax.nn.softmax(jnp.concatenate([scores, sink], axis=-1), axis=-1)[..., :-1]
    out = jnp.einsum('bnkgqs,bnskd->bnqkgd', probs.astype(v.dtype), vv)
    return out.reshape(B, S, D_ATTN)


def swiglu(h, w_in, w_out):
    gate, up = jnp.split(h @ w_in, 2, axis=-1)
    return (jax.nn.silu(gate) * up) @ w_out


def moe_swiglu(h, w_router, w_in, w_out):
    logits = (h @ w_router).astype(jnp.float32)
    top_v, top_i = lax.top_k(logits, TOP_K)
    probs = jax.nn.softmax(top_v, axis=-1)
    combine = jnp.sum(jax.nn.one_hot(top_i, N_EXPERTS, dtype=jnp.float32) * probs[..., None], axis=-2)
    out = jnp.zeros_like(h)
    for e in range(N_EXPERTS):
        out = out + combine[..., e:e + 1].astype(h.dtype) * swiglu(h, w_in[e], w_out[e])
    return out


def setup_inputs(seed: int = 0) -> dict:
    key = jax.random.key(seed)
    ks = jax.random.split(key, 24)
    f32 = jnp.float32
    L = DEPTH
    nrm = lambda k, shape, scale: jax.random.normal(k, shape, f32) * scale
    u = jax.random.uniform(ks[13], (L, D_RNN), f32, 0.9, 0.999) ** (1.0 / LRU_C)
    return {
        'x': nrm(ks[0], (BATCH, SEQ, D_MODEL), 1.0),
        'c': nrm(ks[1], (BATCH, D_MODEL), 1.0),
        'w_ada': nrm(ks[2], (L, D_MODEL, 6 * D_MODEL), 0.5 * D_MODEL ** -0.5),
        'b_ada': nrm(ks[3], (L, 6 * D_MODEL), 0.01),
        'pre_mix_gain': 1.0 + nrm(ks[4], (L, D_MODEL), 0.02),
        'post_mix_gain': 1.0 + nrm(ks[5], (L, D_MODEL), 0.02),
        'pre_ffn_gain': 1.0 + nrm(ks[6], (L, D_MODEL), 0.02),
        'post_ffn_gain': 1.0 + nrm(ks[7], (L, D_MODEL), 0.02),
        'w_in': nrm(ks[8], (L, D_MODEL, D_IN), D_MODEL ** -0.5),
        'conv_w': nrm(ks[9], (L, CONV_WIDTH, D_RNN), CONV_WIDTH ** -0.5),
        'conv_b': nrm(ks[10], (L, D_RNN), 0.01),
        'w_rg_a': nrm(ks[11], (L, N_RNN_BLOCKS, RNN_BLOCK, RNN_BLOCK), RNN_BLOCK ** -0.5),
        'b_rg_a': nrm(ks[12], (L, D_RNN), 0.01),
        'w_rg_x': nrm(ks[14], (L, N_RNN_BLOCKS, RNN_BLOCK, RNN_BLOCK), RNN_BLOCK ** -0.5),
        'b_rg_x': nrm(ks[15], (L, D_RNN), 0.01),
        'lru_lambda': jnp.log(u) - jnp.log1p(-u),
        'attn_sinks': nrm(ks[16], (L, N_HEADS), 1.0),
        'w_branch': nrm(ks[17], (L, N_BRANCH, D_BRANCH, D_MODEL), D_BRANCH ** -0.5),
        'w_out': nrm(ks[18], (L, D_MODEL, D_MODEL), D_MODEL ** -0.5),
        'w_ffn_in': nrm(ks[19], (N_DENSE, D_MODEL, 2 * D_FF), D_MODEL ** -0.5),
        'w_ffn_out': nrm(ks[20], (N_DENSE, D_FF, D_MODEL), D_FF ** -0.5),
        'w_router': nrm(ks[21], (N_MOE, D_MODEL, N_EXPERTS), D_MODEL ** -0.5),
        'w_moe_in': nrm(ks[22], (N_MOE, N_EXPERTS, D_MODEL, 2 * D_FF_EXPERT), D_MODEL ** -0.5),
        'w_moe_out': nrm(ks[23], (N_MOE, N_EXPERTS, D_FF_EXPERT, D_MODEL), D_FF_EXPERT ** -0.5),
    }


def reference(x, c, w_ada, b_ada, pre_mix_gain, post_mix_gain, pre_ffn_gain, post_ffn_gain,
              w_in, conv_w, conv_b, w_rg_a, b_rg_a, w_rg_x, b_rg_x, lru_lambda, attn_sinks,
              w_branch, w_out, w_ffn_in, w_ffn_out, w_router, w_moe_in, w_moe_out):
    B, S, _ = x.shape
    c_act = jax.nn.silu(c)
    for l in range(DEPTH):
        ada = c_act @ w_ada[l] + b_ada[l]
        sh_m, sc_m, g_m, sh_f, sc_f, g_f = [t[:, None, :] for t in jnp.split(ada, 6, axis=-1)]

        h = rms_norm(x, pre_mix_gain[l]) * (1.0 + sc_m) + sh_m
        proj = h @ w_in[l]
        x_r = proj[..., OFF_XR:OFF_GR]
        g_r = proj[..., OFF_GR:OFF_Q]
        q = proj[..., OFF_Q:OFF_K].reshape(B, S, N_HEADS, HEAD_DIM)
        k = proj[..., OFF_K:OFF_V].reshape(B, S, N_KV_HEADS, HEAD_DIM)
        v = proj[..., OFF_V:OFF_G].reshape(B, S, N_KV_HEADS, HEAD_DIM)
        gates = jax.nn.sigmoid(proj[..., OFF_G:].astype(jnp.float32)).reshape(B, S, N_BRANCH, D_MODEL)

        x_r = causal_depthwise_conv(x_r, conv_w[l], conv_b[l])
        rnn_out = rg_lru(x_r, w_rg_a[l], b_rg_a[l], w_rg_x[l], b_rg_x[l], lru_lambda[l]) * jax.nn.gelu(g_r)
        attn_out = sliding_window_attention(q, k, v, attn_sinks[l])

        branches = jnp.stack([rnn_out, attn_out], axis=2)
        branch_proj = jnp.einsum('bsnk,nkd->bsnd', branches, w_branch[l])
        merged = jnp.sum(gates.astype(branch_proj.dtype) * branch_proj, axis=2)
        mix = merged @ w_out[l]
        x = x + g_m * rms_norm(mix, post_mix_gain[l])

        h = rms_norm(x, pre_ffn_gain[l]) * (1.0 + sc_f) + sh_f
        if l % 2 == 0:
            f = swiglu(h, w_ffn_in[l // 2], w_ffn_out[l // 2])
        else:
            f = moe_swiglu(h, w_router[l // 2], w_moe_in[l // 2], w_moe_out[l // 2])
        x = x + g_f * rms_norm(f, post_ffn_gain[l])
    return x
```

```cpp
#include <hip/hip_runtime.h>
#include <cstdio>
#include <cstdint>

#ifndef MK_ONE_LAUNCH
#define MK_ONE_LAUNCH 1
#endif
#ifndef NAIVE_GEMM
#define NAIVE_GEMM 0
#endif

#ifndef FP8_LAYERS
#define FP8_LAYERS 0xEu
#endif
#define DI __device__ __forceinline__
#define GAS __attribute__((address_space(1)))
#define LAS __attribute__((address_space(3)))
typedef unsigned short bf16;
typedef short bf16x8 __attribute__((ext_vector_type(8)));
typedef short s16x4 __attribute__((ext_vector_type(4)));
typedef float f32x2 __attribute__((ext_vector_type(2)));
typedef float f32x4 __attribute__((ext_vector_type(4)));
typedef float f32x16 __attribute__((ext_vector_type(16)));
typedef unsigned u32x2 __attribute__((ext_vector_type(2)));
typedef unsigned u32x4 __attribute__((ext_vector_type(4)));
typedef __bf16 bf16x2_t __attribute__((ext_vector_type(2)));
typedef GAS unsigned gu32;

constexpr int BATCH = 2, SEQ = 8192, D = 1024, DEPTH = 4, M = BATCH * SEQ;
constexpr int D_IN = 5632, D_FF = 3072, NE = 8, D_FFE = 1536, ECAP = 16384;
constexpr float EPS = 1e-6f;
constexpr float LOG2E = 1.4426950408889634f;
constexpr float QSCALE = 0.08838834764831845f * 1.4426950408889634f;

DI unsigned pk2(float lo, float hi) { f32x2 v = {lo, hi}; return __builtin_bit_cast(unsigned, __builtin_convertvector(v, bf16x2_t)); }
DI float bflo(unsigned w) { return __uint_as_float(w << 16); }
DI float bfhi(unsigned w) { return __uint_as_float(w & 0xffff0000u); }
DI float fexp2(float x) { return __builtin_amdgcn_exp2f(x); }
DI float frcp(float x) { return __builtin_amdgcn_rcpf(x); }
DI float sigmoidf_(float v) { return frcp(1.0f + fexp2(-LOG2E * v)); }
DI float siluf_(float v) { return v * sigmoidf_(v); }
DI float gelu_tanh_(float v) { const float t = v + 0.044715f * v * v * v; return v * frcp(1.0f + fexp2(-2.0f * 0.7978845608028654f * LOG2E * t)); }
DI float wave_sum(float v) {
#pragma unroll
    for (int o = 1; o < 64; o <<= 1) v += __shfl_xor(v, o);
    return v;
}
#define LDS_WAIT() asm volatile("s_waitcnt lgkmcnt(0)" ::: "memory")
#define VM_WAIT() asm volatile("s_waitcnt vmcnt(0)" ::: "memory")
#define RLX_AGENT __ATOMIC_RELAXED, __HIP_MEMORY_SCOPE_AGENT
namespace pg8 {
#define PG8_LAS __attribute__((address_space(3)))
typedef unsigned short bf16_t;
constexpr int BM = 256, BK = 64, HALF = 128, HTB = HALF * BK * 2  , STAGE_BYTES = 8 * HTB, NXCD = 8, WGM = 8;

__host__ __device__ __forceinline__ int lds_byte(int r, int c) { const int st = (r >> 4) * 2 + (c >> 5), rr = r & 15, cc = c & 31, ob = rr * 64 + cc * 2; return st * 1024 + (ob ^ (((ob >> 9) & 1) << 5)); }
__host__ __device__ __forceinline__ void stage_rc(int b, int& R, int& C) { const int st = b / 1024, sb = b % 1024, swz = sb ^ (((sb >> 9) & 1) << 5); R = (st >> 1) * 16 + swz / 64; C = (st & 1) * 32 + (swz % 64) / 2; }
__host__ __device__ __forceinline__ int perm32(int rho) { const int n = rho >> 4, i = rho & 15; return 8 * (i >> 2) + 4 * n + (i & 3); }

struct Unit { int pm, pn, po; };
struct Gemm { const bf16_t* A; const bf16_t* Bt; int M, N, K; int sw, sa; };
typedef int i32x8 __attribute__((ext_vector_type(8)));
typedef int i32x4v __attribute__((ext_vector_type(4)));
__device__ __forceinline__ i32x8 cat8(bf16x8 lo, bf16x8 hi) { return __builtin_shufflevector(__builtin_bit_cast(i32x4v, lo), __builtin_bit_cast(i32x4v, hi), 0, 1, 2, 3, 4, 5, 6, 7); }
__device__ __forceinline__ unsigned pk4fp8(f32x4 v) { int w = __builtin_amdgcn_cvt_pk_fp8_f32(v[0], v[1], 0, false); w = __builtin_amdgcn_cvt_pk_fp8_f32(v[2], v[3], w, true); return (unsigned)w; }

struct StaticOrder {
    int nM, nN, nwg, G, c;
    __host__ __device__ void init(int M, int N, int G_, int c_) { nM = M / BM; nN = N / BM; nwg = nM * nN; G = G_; c = c_; }
    __host__ __device__ bool next(int i, Unit& u) const {
        const long L = (long)i * G + c; if (L >= nwg) return false;
        int wgid = (int)L; { const int q = nwg / NXCD, r = nwg % NXCD, xcd = wgid % NXCD, off = wgid / NXCD; wgid = (xcd < r ? xcd * (q + 1) : r * (q + 1) + (xcd - r) * q) + off; }
        const int nig = WGM * nN, gid = wgid / nig, fm = gid * WGM, gsz = (nM - fm) < WGM ? (nM - fm) : WGM;
        u.pm = fm + ((wgid % nig) % gsz); u.pn = (wgid % nig) / gsz; u.po = u.pm; return true;
    }
    __device__ __forceinline__ void a_ready(const Unit&) const {}
    __device__ __forceinline__ void done(const Unit&) const {}
};
struct MoeOrder {
    int pp[9]; int nM, nN, nwg, G, c, astride;
    __device__ __forceinline__ void init(const unsigned* cnt, int NT, int G_, int c_, int astride_) {
        int a = 0;
#pragma unroll
        for (int e = 0; e < 8; ++e) { pp[e] = a; const unsigned n = (unsigned)__builtin_amdgcn_readfirstlane((int)__hip_atomic_load(cnt + e, RLX_AGENT)); a += (int)((n + 255u) >> 8); }
        pp[8] = a; nM = a; nN = NT; nwg = nM * nN; G = G_; c = c_; astride = astride_;
    }
    __device__ __forceinline__ bool next(int i, Unit& u) const {
        const long L = (long)i * G + c; if (L >= nwg) return false;
        int wgid = (int)L; { const int q = nwg / NXCD, r = nwg % NXCD, xcd = wgid % NXCD, off = wgid / NXCD; wgid = (xcd < r ? xcd * (q + 1) : r * (q + 1) + (xcd - r) * q) + off; }
        const int nig = WGM * nN, gid = wgid / nig, fm = gid * WGM, gsz = (nM - fm) < WGM ? (nM - fm) : WGM;
        const int vp = fm + ((wgid % nig) % gsz), t = (wgid % nig) / gsz;
        int e = 0, base = 0;
#pragma unroll
        for (int k = 1; k < 8; ++k) if (vp >= pp[k]) { e = k; base = pp[k]; }
        u.pm = astride ? e * astride + (vp - base) : vp; u.pn = e * nN + t; u.po = vp; return true;
    }
    __device__ __forceinline__ void a_ready(const Unit&) const {}
    __device__ __forceinline__ void done(const Unit&) const {}
};

template <class E> __device__ __forceinline__ void epi_rows(const E& e, const f32x4 (&acc)[2][2][4][2], const Unit& u, int wr, int wc, int fr, int fq) {
    asm volatile("" : "+v"(fr), "+v"(fq));
#pragma unroll
    for (int ai = 0; ai < 2; ++ai)
#pragma unroll
        for (int m = 0; m < 4; ++m) e.row8(u, ai * HALF + wr * 64 + m * 16 + fr, wc * 32 + 8 * fq, acc[ai][0][m][0], acc[ai][0][m][1], acc[ai][1][m][0], acc[ai][1][m][1]);
}
#define PG8_EPI_COMMON static constexpr bool PERM = true, AFTER_DRAIN = false; \
    __device__ __forceinline__ void operator()(const f32x4 (&acc)[2][2][4][2], const Unit& u, int wr, int wc, int fr, int fq) const { epi_rows(*this, acc, u, wr, wc, fr, fq); }
__device__ __forceinline__ void st8bf(bf16_t* p, f32x4 a, f32x4 b) { u32x4 w; w.x = pk2(a[0], a[1]); w.y = pk2(a[2], a[3]); w.z = pk2(b[0], b[1]); w.w = pk2(b[2], b[3]); *(u32x4*)p = w; }
__device__ __forceinline__ void ld8bf(const bf16_t* p, f32x4& a, f32x4& b) { const u32x4 w = *(const u32x4*)p; a = (f32x4){bflo(w.x), bfhi(w.x), bflo(w.y), bfhi(w.y)}; b = (f32x4){bflo(w.z), bfhi(w.z), bflo(w.w), bfhi(w.w)}; }
__device__ __forceinline__ f32x4 gelu4(f32x4 v) { return (f32x4){gelu_tanh_(v[0]), gelu_tanh_(v[1]), gelu_tanh_(v[2]), gelu_tanh_(v[3])}; }
__device__ __forceinline__ f32x4 sig4(f32x4 v) { return (f32x4){sigmoidf_(v[0]), sigmoidf_(v[1]), sigmoidf_(v[2]), sigmoidf_(v[3])}; }
__device__ __forceinline__ f32x4 silu4(f32x4 v) { return (f32x4){siluf_(v[0]), siluf_(v[1]), siluf_(v[2]), siluf_(v[3])}; }

struct EpiWin { PG8_EPI_COMMON
    unsigned char* R;
    __device__ __forceinline__ void row8(const Unit& u, int r, int cit, f32x4 a0, f32x4 a1, f32x4 b0, f32x4 b1) const {
        const size_t row = (size_t)u.po * BM + r; const int pn = u.pn;
        bf16_t* XR = (bf16_t*)R; bf16_t* GG = (bf16_t*)(R + (32u << 20)); bf16_t* Q = (bf16_t*)(R + (64u << 20)); bf16_t* KB = (bf16_t*)(R + (96u << 20)); bf16_t* VB = (bf16_t*)(R + (104u << 20)); bf16_t* GT = (bf16_t*)(R + (112u << 20));
        if (pn < 4)       { bf16_t* o = XR + row * 1024 + 256 * pn + cit; st8bf(o, a0, a1); st8bf(o + HALF, b0, b1); }
        else if (pn < 8)  { bf16_t* o = GG + row * 1024 + 256 * (pn - 4) + cit; st8bf(o, gelu4(a0), gelu4(a1)); st8bf(o + HALF, gelu4(b0), gelu4(b1)); }
        else if (pn < 12) { bf16_t* o = Q + row * 1024 + 256 * (pn - 8) + cit; st8bf(o, a0 * QSCALE, a1 * QSCALE); st8bf(o + HALF, b0 * QSCALE, b1 * QSCALE); }
        else if (pn == 12) { bf16_t* o = KB + row * 256 + cit; st8bf(o, a0, a1); st8bf(o + HALF, b0, b1); }
        else if (pn == 13) { bf16_t* o = VB + row * 256 + cit; st8bf(o, a0, a1); st8bf(o + HALF, b0, b1); }
        else { bf16_t* o = GT + row * 2048 + 256 * (pn - 14) + cit; st8bf(o, sig4(a0), sig4(a1)); st8bf(o + HALF, sig4(b0), sig4(b1)); }
    }
};
struct EpiBranch0 { PG8_EPI_COMMON
    unsigned char* R;
    __device__ __forceinline__ void row8(const Unit& u, int r, int cit, f32x4 a0, f32x4 a1, f32x4 b0, f32x4 b1) const {
        const size_t row = (size_t)u.po * BM + r; const int c = 256 * u.pn + cit;
        const bf16_t* GT = (const bf16_t*)(R + (112u << 20)); bf16_t* MGP = (bf16_t*)(R + (240u << 20));
        f32x4 g0, g1; ld8bf(GT + row * 2048 + c, g0, g1); bf16_t* o = MGP + row * 1024 + c; st8bf(o, g0 * a0, g1 * a1);
        ld8bf(GT + row * 2048 + c + HALF, g0, g1); st8bf(o + HALF, g0 * b0, g1 * b1);
    }
};
struct EpiBranch1 { PG8_EPI_COMMON
    unsigned char* R;
    __device__ __forceinline__ void row8(const Unit& u, int r, int cit, f32x4 a0, f32x4 a1, f32x4 b0, f32x4 b1) const {
        const size_t row = (size_t)u.po * BM + r; const int c = 256 * u.pn + cit;
        const bf16_t* GT = (const bf16_t*)(R + (112u << 20)); const bf16_t* MGP = (const bf16_t*)(R + (240u << 20)); bf16_t* MG = (bf16_t*)(R + (304u << 20));
        f32x4 g0, g1, p0, p1; ld8bf(GT + row * 2048 + 1024 + c, g0, g1); const bf16_t* pm_ = MGP + row * 1024 + c; ld8bf(pm_, p0, p1);
        st8bf(MG + row * 1024 + c, p0 + g0 * a0, p1 + g1 * a1);
        ld8bf(GT + row * 2048 + 1024 + c + HALF, g0, g1); ld8bf(pm_ + HALF, p0, p1);
        st8bf(MG + row * 1024 + c + HALF, p0 + g0 * b0, p1 + g1 * b1);
    }
};
struct EpiBf16N { PG8_EPI_COMMON
    bf16_t* O;
    __device__ __forceinline__ void row8(const Unit& u, int r, int cit, f32x4 a0, f32x4 a1, f32x4 b0, f32x4 b1) const {
        bf16_t* o = O + ((size_t)u.po * BM + r) * 1024 + 256 * u.pn + cit; st8bf(o, a0, a1); st8bf(o + HALF, b0, b1);
    }
};
struct EpiF32 { PG8_EPI_COMMON
    float* O;
    __device__ __forceinline__ void row8(const Unit& u, int r, int cit, f32x4 a0, f32x4 a1, f32x4 b0, f32x4 b1) const {
        float* o = O + ((size_t)u.po * BM + r) * 1024 + 256 * u.pn + cit; *(f32x4*)o = a0; *(f32x4*)(o + 4) = a1; *(f32x4*)(o + HALF) = b0; *(f32x4*)(o + HALF + 4) = b1;
    }
};
struct EpiSwiglu { PG8_EPI_COMMON
    bf16_t* O; int ldc, ntile;
    __device__ __forceinline__ void row8(const Unit& u, int r, int cit, f32x4 a0, f32x4 a1, f32x4 b0, f32x4 b1) const {
        st8bf(O + ((size_t)u.po * BM + r) * ldc + HALF * (u.pn % ntile) + cit, silu4(a0) * b0, silu4(a1) * b1);
    }
};
struct EpiSwiglu8 { PG8_EPI_COMMON
    unsigned char* O; int ldc, ntile;
    __device__ __forceinline__ void row8(const Unit& u, int r, int cit, f32x4 a0, f32x4 a1, f32x4 b0, f32x4 b1) const {
        u32x2 w; w.x = pk4fp8(silu4(a0) * b0); w.y = pk4fp8(silu4(a1) * b1); *(u32x2*)(O + ((size_t)u.po * BM + r) * ldc + HALF * (u.pn % ntile) + cit) = w;
    }
};
struct EpiBf16Mod4 { PG8_EPI_COMMON
    bf16_t* O;
    __device__ __forceinline__ void row8(const Unit& u, int r, int cit, f32x4 a0, f32x4 a1, f32x4 b0, f32x4 b1) const {
        bf16_t* o = O + ((size_t)u.po * BM + r) * 1024 + 256 * (u.pn & 3) + cit; st8bf(o, a0, a1); st8bf(o + HALF, b0, b1);
    }
};

template <class Epi, class Sched>
__device__ __forceinline__ void gemm_phase_naive(const Gemm g, const Sched& S, const Epi& E) {
    Unit u;
    for (int i = 0; S.next(i, u); ++i) {
        for (int idx = threadIdx.x; idx < 256 * 16; idx += blockDim.x) {
            const int r = idx >> 4, cit = (idx & 15) * 8;
            const bf16_t* a = g.A + ((size_t)u.pm * BM + r) * g.K;
            float o[16];
#pragma unroll
            for (int j = 0; j < 16; ++j) o[j] = 0.f;
            for (int k = 0; k < g.K; k += 8) {
                f32x4 x0, x1; ld8bf(a + k, x0, x1);
#pragma unroll
                for (int j = 0; j < 16; ++j) { const bf16_t* b = g.Bt + ((size_t)u.pn * BM + (j >> 3) * HALF + cit + (j & 7)) * g.K + k; f32x4 y0, y1; ld8bf(b, y0, y1);
                    o[j] += x0[0] * y0[0] + x0[1] * y0[1] + x0[2] * y0[2] + x0[3] * y0[3] + x1[0] * y1[0] + x1[1] * y1[1] + x1[2] * y1[2] + x1[3] * y1[3]; }
            }
            E.row8(u, r, cit, (f32x4){o[0], o[1], o[2], o[3]}, (f32x4){o[4], o[5], o[6], o[7]}, (f32x4){o[8], o[9], o[10], o[11]}, (f32x4){o[12], o[13], o[14], o[15]});
        }
    }
}

template <class Epi, class Sched, bool ALIGN_EPI = false, bool SP2 = false, bool FP8 = false>
__device__ __forceinline__ void gemm_phase(PG8_LAS unsigned char* lds, const Gemm g, const Sched& S, const Epi& E) {
    int tid_ = threadIdx.x; asm volatile("" : "+v"(tid_));
    const int tid = tid_, wid = __builtin_amdgcn_readfirstlane(tid >> 6), lane = tid & 63, wr = wid >> 2, wc = wid & 3, fr = lane & 15, fq = lane >> 4;
    constexpr int ESZ = FP8 ? 1 : 2;
    const int K = g.K, nt = K * ESZ / (BK * 2);
    unsigned voffA[2], voffB[2];
#pragma unroll
    for (int i = 0; i < 2; ++i) { int R, C; stage_rc(tid * 16 + i * 8192, R, C); const int Rb = Epi::PERM ? ((R & ~31) + perm32(R & 31)) : R;
        voffA[i] = (unsigned)(R * K * ESZ + C * 2); voffB[i] = (unsigned)(Rb * K * ESZ + C * 2); }
    const size_t kstep = (size_t)(BK * 2);
    const size_t hstep = (size_t)HALF * K * ESZ;
    const size_t tstep = 2 * hstep;
    const unsigned ldsw = (unsigned)wid * 1024u;
    const int aoff = lds_byte(wr * 64 + fr, FP8 ? fq * 16 : fq * 8), boff = lds_byte(wc * 32 + fr, FP8 ? fq * 16 : fq * 8);
#define PG8_SA(b, h) (((b) * 2 + (h)) * HTB)
#define PG8_SB(b, h) ((4 + (b) * 2 + (h)) * HTB)
#define PG8_STAGE(bufoff, gbase, voff) do { _Pragma("unroll") for (int _i = 0; _i < 2; ++_i) \
        __builtin_amdgcn_global_load_lds((const unsigned*)((const char*)(gbase) + (voff)[_i]), (PG8_LAS unsigned*)(lds + (bufoff) + ldsw + _i * 8192), 16, 0, 0); } while (0)
#define PG8_LDA(dst, b, h) do { _Pragma("unroll") for (int m = 0; m < 4; ++m) { if constexpr (FP8) dst##8[m] = cat8(*(const PG8_LAS bf16x8*)(lds + PG8_SA(b, h) + aoff + m * 2048), *(const PG8_LAS bf16x8*)(lds + PG8_SA(b, h) + aoff + m * 2048 + 16)); \
        else { _Pragma("unroll") for (int k = 0; k < 2; ++k) dst[m][k] = *(const PG8_LAS bf16x8*)(lds + PG8_SA(b, h) + aoff + m * 2048 + k * 1024); } } } while (0)
#define PG8_LDB(dst, b, h) do { _Pragma("unroll") for (int n = 0; n < 2; ++n) { if constexpr (FP8) dst##8[n] = cat8(*(const PG8_LAS bf16x8*)(lds + PG8_SB(b, h) + boff + n * 2048), *(const PG8_LAS bf16x8*)(lds + PG8_SB(b, h) + boff + n * 2048 + 16)); \
        else { _Pragma("unroll") for (int k = 0; k < 2; ++k) dst[n][k] = *(const PG8_LAS bf16x8*)(lds + PG8_SB(b, h) + boff + n * 2048 + k * 1024); } } } while (0)
#define PG8_MMA(ai, bj, At, Bt) do { __builtin_amdgcn_s_setprio(1); _Pragma("unroll") for (int m = 0; m < 4; ++m) _Pragma("unroll") for (int n = 0; n < 2; ++n) { \
        if constexpr (FP8) asm volatile("v_mfma_scale_f32_16x16x128_f8f6f4 %0, %1, %2, %0, %3, %4 op_sel_hi:[0,0,0]" : "+v"(acc[ai][bj][m][n]) : "v"(Bt##8[n]), "v"(At##8[m]), "v"(sw_), "v"(sa_)); \
        else { _Pragma("unroll") for (int k = 0; k < 2; ++k) acc[ai][bj][m][n] = __builtin_amdgcn_mfma_f32_16x16x32_bf16(Bt[n][k], At[m][k], acc[ai][bj][m][n], 0, 0, 0); } } \
        __builtin_amdgcn_s_setprio(0); } while (0)
#define PG8_WAIT_V(n) asm volatile("s_waitcnt vmcnt(" #n ")" ::: "memory")
#define PG8_WAIT_L(n) asm volatile("s_waitcnt lgkmcnt(" #n ")" ::: "memory")
#define PG8_BAR __builtin_amdgcn_s_barrier()
#define PG8_SCHED __builtin_amdgcn_sched_barrier(0)
    Unit cur, nxt; int ui = 0;
    if (!S.next(0, cur)) return;
    f32x4 acc[2][2][4][2];
#pragma unroll
    for (int a = 0; a < 2; ++a)
#pragma unroll
        for (int b = 0; b < 2; ++b)
#pragma unroll
            for (int m = 0; m < 4; ++m)
#pragma unroll
                for (int n = 0; n < 2; ++n) acc[a][b][m][n] = (f32x4){0.f, 0.f, 0.f, 0.f};
    const int sw_ = g.sw, sa_ = g.sa;
    bf16x8 At[4][2], B0[2][2], B1[2][2]; i32x8 At8[4], B08[2], B18[2];
    const char* cA = (const char*)g.A + (size_t)cur.pm * tstep; const char* cB = (const char*)g.Bt + (size_t)cur.pn * tstep;
    S.a_ready(cur);
    if constexpr (SP2) {
        PG8_STAGE(PG8_SB(0, 0), cB, voffB); PG8_STAGE(PG8_SB(0, 1), cB + hstep, voffB); PG8_STAGE(PG8_SA(0, 0), cA, voffA); PG8_STAGE(PG8_SA(0, 1), cA + hstep, voffA);
        if (wr == 1) PG8_BAR;
        PG8_WAIT_V(2); PG8_BAR;
        PG8_STAGE(PG8_SB(1, 0), cB + kstep, voffB); PG8_STAGE(PG8_SA(1, 0), cA + kstep, voffA); PG8_STAGE(PG8_SB(1, 1), cB + hstep + kstep, voffB);
        PG8_WAIT_V(6); PG8_BAR;
    } else {
        PG8_STAGE(PG8_SB(0, 0), cB, voffB); PG8_STAGE(PG8_SA(0, 0), cA, voffA); PG8_STAGE(PG8_SB(0, 1), cB + hstep, voffB); PG8_STAGE(PG8_SA(0, 1), cA + hstep, voffA);
        if (wr == 1) PG8_BAR;
        PG8_WAIT_V(4); PG8_BAR;
        PG8_STAGE(PG8_SB(1, 0), cB + kstep, voffB); PG8_STAGE(PG8_SA(1, 0), cA + kstep, voffA); PG8_STAGE(PG8_SB(1, 1), cB + hstep + kstep, voffB);
        PG8_WAIT_V(6); PG8_BAR;
    }
    for (;;) {
        const bool has_next = S.next(ui + 1, nxt);
        const char* nA = has_next ? (const char*)g.A + (size_t)nxt.pm * tstep : cA; const char* nB = has_next ? (const char*)g.Bt + (size_t)nxt.pn * tstep : cB;
        for (int t = 0; t < nt; t += 2) {
            const bool last = (t == nt - 2);
            const char* a1 = cA + (size_t)(t + 1) * kstep;
            const char* a2 = last ? nA : cA + (size_t)(t + 2) * kstep; const char* b2 = last ? nB : cB + (size_t)(t + 2) * kstep;
            const char* a3 = a2 + kstep; const char* b3 = b2 + kstep;
            if (last && has_next) S.a_ready(nxt);
            if constexpr (SP2) {
            PG8_LDB(B0, 0, 0); PG8_LDB(B1, 0, 1); PG8_SCHED; PG8_LDA(At, 0, 0); PG8_STAGE(PG8_SA(1, 1), a1 + hstep, voffA);
            PG8_WAIT_V(8); PG8_WAIT_L(0); PG8_BAR; PG8_MMA(0, 0, At, B0); PG8_MMA(0, 1, At, B1); PG8_BAR; PG8_SCHED;
            PG8_LDA(At, 0, 1); PG8_STAGE(PG8_SB(0, 0), b2, voffB); PG8_STAGE(PG8_SB(0, 1), b2 + hstep, voffB); PG8_STAGE(PG8_SA(0, 0), a2, voffA);
            PG8_WAIT_V(8); PG8_WAIT_L(0); PG8_BAR; PG8_MMA(1, 0, At, B0); PG8_MMA(1, 1, At, B1); PG8_BAR; PG8_SCHED;
            PG8_LDB(B0, 1, 0); PG8_LDB(B1, 1, 1); PG8_SCHED; PG8_LDA(At, 1, 0); PG8_STAGE(PG8_SA(0, 1), a2 + hstep, voffA);
            PG8_WAIT_V(8); PG8_WAIT_L(0); PG8_BAR; PG8_MMA(0, 0, At, B0); PG8_MMA(0, 1, At, B1); PG8_BAR; PG8_SCHED;
            PG8_LDA(At, 1, 1); PG8_STAGE(PG8_SB(1, 0), b3, voffB); PG8_STAGE(PG8_SB(1, 1), b3 + hstep, voffB); PG8_STAGE(PG8_SA(1, 0), a3, voffA);
            PG8_WAIT_V(8); PG8_WAIT_L(0); PG8_BAR; PG8_MMA(1, 0, At, B0); PG8_MMA(1, 1, At, B1); PG8_BAR; PG8_SCHED;
            } else {
            PG8_LDB(B0, 0, 0); PG8_SCHED; PG8_LDA(At, 0, 0); PG8_STAGE(PG8_SA(1, 1), a1 + hstep, voffA);
            PG8_WAIT_L(8); PG8_BAR; PG8_WAIT_L(0); PG8_MMA(0, 0, At, B0); PG8_BAR; PG8_SCHED;
            PG8_LDB(B1, 0, 1); PG8_STAGE(PG8_SB(0, 0), b2, voffB);
            PG8_BAR; PG8_WAIT_L(0); PG8_MMA(0, 1, At, B1); PG8_BAR;
            PG8_LDA(At, 0, 1); PG8_STAGE(PG8_SA(0, 0), a2, voffA);
            PG8_BAR; PG8_WAIT_L(0); PG8_MMA(1, 0, At, B0); PG8_BAR; PG8_SCHED;
            PG8_STAGE(PG8_SB(0, 1), b2 + hstep, voffB);
            PG8_WAIT_V(6); PG8_BAR; PG8_MMA(1, 1, At, B1); PG8_BAR;
            PG8_LDB(B0, 1, 0); PG8_SCHED; PG8_LDA(At, 1, 0); PG8_STAGE(PG8_SA(0, 1), a2 + hstep, voffA);
            PG8_WAIT_L(8); PG8_BAR; PG8_WAIT_L(0); PG8_MMA(0, 0, At, B0); PG8_BAR; PG8_SCHED;
            PG8_LDB(B1, 1, 1); PG8_STAGE(PG8_SB(1, 0), b3, voffB);
            PG8_BAR; PG8_WAIT_L(0); PG8_MMA(0, 1, At, B1); PG8_BAR;
            PG8_LDA(At, 1, 1); PG8_STAGE(PG8_SA(1, 0), a3, voffA);
            PG8_BAR; PG8_WAIT_L(0); PG8_MMA(1, 0, At, B0); PG8_BAR; PG8_SCHED;
            PG8_STAGE(PG8_SB(1, 1), b3 + hstep, voffB);
            PG8_WAIT_V(6); PG8_BAR; PG8_MMA(1, 1, At, B1); PG8_BAR;
            }
        }
        if constexpr (ALIGN_EPI) { if (wr == 0) PG8_BAR; }
        if constexpr (FP8) asm volatile("s_nop 15\n\ts_nop 15" ::: "memory");
        if constexpr (!Epi::AFTER_DRAIN) { E(acc, cur, wr, wc, fr, fq); S.done(cur); }
        if (!has_next) break;
#pragma unroll
        for (int a = 0; a < 2; ++a)
#pragma unroll
            for (int b = 0; b < 2; ++b)
#pragma unroll
                for (int m = 0; m < 4; ++m)
#pragma unroll
                    for (int n = 0; n < 2; ++n) acc[a][b][m][n] = (f32x4){0.f, 0.f, 0.f, 0.f};
        cur = nxt; cA = nA; cB = nB; ++ui;
        if constexpr (ALIGN_EPI) { if (wr == 1) PG8_BAR; }
    }
    PG8_WAIT_V(0);
    if constexpr (!ALIGN_EPI) { if (wr == 0) PG8_BAR; }
    PG8_BAR;
    if constexpr (Epi::AFTER_DRAIN) { E.fused(acc, cur, wr, wc, fr, fq, lds, wid, lane); S.done(cur); }
#undef PG8_SA
#undef PG8_SB
#undef PG8_STAGE
#undef PG8_LDA
#undef PG8_LDB
#undef PG8_MMA
#undef PG8_WAIT_V
#undef PG8_WAIT_L
#undef PG8_BAR
#undef PG8_SCHED
}
}

constexpr int NWAVES = 8;
constexpr size_t MiB = 1u << 20;
constexpr size_t WS_CTL = 0, CTL_ZERO_BYTES = 1 * MiB;
constexpr size_t WS_ADA = 1 * MiB;
constexpr size_t WS_RAGG = 2 * MiB;
constexpr size_t WS_MIX = 288 * MiB; constexpr size_t WS_T16 = WS_MIX;
constexpr size_t WS_TOK = 3 * MiB;
constexpr size_t WS_WL = 4 * MiB, WL_STRIDE = 18 * MiB;
constexpr size_t WL_WIN = 0, WL_WB = 11 * MiB, WL_WO = 15 * MiB, WL_WRA = 17 * MiB, WL_WRX = 17 * MiB + 256 * 1024;
constexpr size_t WS_WD = 76 * MiB, WD_STRIDE = 18 * MiB;
constexpr size_t WD_FIN = 0, WD_FOUT = 12 * MiB;
constexpr size_t WS_WM = 112 * MiB, WM_STRIDE = 72 * MiB;
constexpr size_t WM_MIN = 0, WM_MOUT = 48 * MiB;
constexpr size_t WS_XN = 256 * MiB;
constexpr size_t WS_R = 352 * MiB;
constexpr size_t WS_XR = WS_R, WS_GG = WS_R + 32 * MiB, WS_Q = WS_R + 64 * MiB, WS_KB = WS_R + 96 * MiB, WS_VB = WS_R + 104 * MiB, WS_GT = WS_R + 112 * MiB;
constexpr size_t WS_RO = WS_R + 176 * MiB, WS_AO = WS_R + 208 * MiB, WS_MGP = WS_R + 240 * MiB, WS_MG = WS_R + 304 * MiB;
constexpr size_t WS_PS = WS_MGP;
constexpr size_t WS_XC = WS_MG;
constexpr size_t WS_ACT = WS_R;
constexpr size_t WS_AP = WS_R;
constexpr size_t WS_YP = WS_R;
constexpr size_t WS_ACTP = WS_R + 256 * MiB;
constexpr size_t WS_XB = WS_ACTP + 102 * MiB;
constexpr size_t WS_END = WS_XB + 32 * MiB;
constexpr int MAXPANELS = 136;

constexpr int CW_CNT = 64;
constexpr int CW_BAR = 4096;

constexpr int RING_OFF = 0, RING_BYTES = 139264;
constexpr int LDSCTL_OFF = RING_BYTES, MISC_OFF = LDSCTL_OFF + 320;
constexpr int LDS_BYTES = 147456;

#define XB_TMO      128
#define XB_XCNT(j)  (256  + 64 * (j))
#define XB_XSUB(j)  (1280 + 64 * (j))
#define XB_XGEN(j)  (2304 + 64 * (j))
#define XB_TOP      3328
#define XB_TOPGEN   3392
#define XCD_BAR_WORDS 3456
#define XB_SPIN_CAP (1u << 18)

__device__ __forceinline__ unsigned xb_ld(unsigned* p)              { return __hip_atomic_load(p, __ATOMIC_RELAXED, __HIP_MEMORY_SCOPE_AGENT); }
__device__ __forceinline__ unsigned xb_add(unsigned* p, unsigned v) { return __hip_atomic_fetch_add(p, v, __ATOMIC_RELAXED, __HIP_MEMORY_SCOPE_AGENT); }
__device__ __forceinline__ unsigned xb_xcc_id() { return (unsigned)__builtin_amdgcn_s_getreg((3 << 11) | 20) & 0xFu; }
#define XB_SPIN(cond, bar) do { unsigned _sp = 0; while (cond) { __builtin_amdgcn_s_sleep(1); \
    if ((++_sp & 255u) == 0u) { if (xb_ld(&(bar)[XB_TMO])) break; if (_sp > XB_SPIN_CAP) { atomicAdd(&(bar)[XB_TMO], 1u); break; } } } } while (0)

struct XcdBarrier {
    unsigned* bar; unsigned x;
    volatile LAS unsigned* st;
};

__device__ __forceinline__ XcdBarrier xcd_barrier_post(unsigned* bar, volatile LAS unsigned* st) {
    XcdBarrier b; b.bar = bar; b.x = xb_xcc_id(); b.st = st;
    if (threadIdx.x == 0) (void)xb_add(&bar[XB_XCNT(b.x)], 1u);
    return b;
}
__device__ __forceinline__ void xcd_barrier_complete(unsigned* bar, unsigned x, unsigned& nloc, unsigned& nx) {
    const unsigned G = gridDim.x * gridDim.y * gridDim.z;
    unsigned sum, cnt, mine, sp = 0u;
    for (;;) {
        sum = 0u; cnt = 0u; mine = 0u;
#pragma unroll
        for (unsigned j = 0; j < 16; ++j) { const unsigned c = xb_ld(&bar[XB_XCNT(j)]); sum += c; cnt += (c > 0u) ? 1u : 0u; mine = (j == x) ? c : mine; }
        if (sum == G) break;
        __builtin_amdgcn_s_sleep(1);
        if ((++sp & 255u) == 0u) { if (xb_ld(&bar[XB_TMO])) break; if (sp > XB_SPIN_CAP) { atomicAdd(&bar[XB_TMO], 1u); break; } }
    }
    nloc = mine > 0u ? mine : 1u; nx = cnt > 0u ? cnt : 1u;
}

__device__ __forceinline__ void xcd_barrier(const XcdBarrier& b) {
    asm volatile("s_waitcnt vmcnt(0)" ::: "memory");
    __syncthreads();
    if (threadIdx.x == 0) {
        unsigned* bar = b.bar;
        __builtin_amdgcn_s_waitcnt(0);
        unsigned nloc = b.st[0], nx = b.st[1];
        if (nloc == 0u) { xcd_barrier_complete(bar, b.x, nloc, nx); b.st[0] = nloc; b.st[1] = nx; }
        const unsigned old = xb_add(&bar[XB_XSUB(b.x)], 1u);
        const unsigned gen = old / nloc;
        if (old + 1u == (gen + 1u) * nloc) {
            __builtin_amdgcn_fence(__ATOMIC_RELEASE, "agent");
            asm volatile("s_waitcnt vmcnt(0)" ::: "memory");
            const unsigned og = xb_add(&bar[XB_TOP], 1u);
            const unsigned tg = og / nx;
            if (og + 1u == (tg + 1u) * nx) xb_add(&bar[XB_TOPGEN], 1u);
            else XB_SPIN(xb_ld(&bar[XB_TOPGEN]) == tg, bar);
            __builtin_amdgcn_fence(__ATOMIC_ACQUIRE, "agent");
            xb_add(&bar[XB_XGEN(b.x)], 1u);
            asm volatile("s_waitcnt vmcnt(0)" ::: "memory");
        } else {
            XB_SPIN(xb_ld(&bar[XB_XGEN(b.x)]) == gen, bar);
            __builtin_amdgcn_fence(__ATOMIC_ACQUIRE, "agent");
            asm volatile("s_waitcnt vmcnt(0)" ::: "memory");
        }
    }
    __syncthreads();
}
struct Args { const float* in[24]; float* out; unsigned char* ws; int ph_lo, ph_hi; };
typedef const __attribute__((address_space(4))) unsigned char* kargp_t;
DI kargp_t kargs() { kargp_t p = (kargp_t)__builtin_amdgcn_kernarg_segment_ptr(); asm volatile("" : "+s"(p)); return p; }
DI const float* karg_in(kargp_t p, int i) { return *(const float* const __attribute__((address_space(4)))*)(p + 8 * i); }
DI float* karg_out(kargp_t p) { return *(float* const __attribute__((address_space(4)))*)(p + 192); }
DI unsigned char* karg_ws(kargp_t p) { return *(unsigned char* const __attribute__((address_space(4)))*)(p + 200); }
static_assert(sizeof(Args) == 216, "kernarg offsets");

DI void p0_transpose_item(const float* W, int K, int N, bf16* WT, int mode, int H, LAS float* scr, int item, int lane) {
    const int nblk = N / 32, kb = item / nblk, nb = item % nblk, k0 = 64 * kb, n0 = 32 * nb;
    int dr0 = n0;
    if (mode == 1) { if (n0 < H) dr0 = (n0 >> 7) * 256 + (n0 & 127); else { const int n1 = n0 - H; dr0 = (n1 >> 7) * 256 + 128 + (n1 & 127); } }
#pragma unroll 8
    for (int i = 0; i < 32; ++i) { const int kk = 2 * i + (lane >> 5); scr[kk * 33 + (lane & 31)] = W[(size_t)(k0 + kk) * N + n0 + (lane & 31)]; }
    LDS_WAIT(); asm volatile("" ::: "memory");
    const int c = lane & 7;
#pragma unroll
    for (int j = 0; j < 4; ++j) { const int n = (lane >> 3) + 8 * j; const LAS float* s = scr + (8 * c) * 33 + n;
        u32x4 o; o.x = pk2(s[0 * 33], s[1 * 33]); o.y = pk2(s[2 * 33], s[3 * 33]); o.z = pk2(s[4 * 33], s[5 * 33]); o.w = pk2(s[6 * 33], s[7 * 33]);
        *(GAS u32x4*)(WT + (size_t)(dr0 + n) * K + k0 + 8 * c) = o; }
    LDS_WAIT(); asm volatile("" ::: "memory");
}
DI void p0_transpose_item8(const float* W, int K, int N, unsigned char* WT, int mode, int H, float mult, LAS float* scr, int item, int lane) {
    const int nblk = N / 32, kb = item / nblk, nb = item % nblk, k0 = 64 * kb, n0 = 32 * nb;
    int dr0 = n0;
    if (mode == 1) { if (n0 < H) dr0 = (n0 >> 7) * 256 + (n0 & 127); else { const int n1 = n0 - H; dr0 = (n1 >> 7) * 256 + 128 + (n1 & 127); } }
#pragma unroll 8
    for (int i = 0; i < 32; ++i) { const int kk = 2 * i + (lane >> 5); scr[kk * 33 + (lane & 31)] = W[(size_t)(k0 + kk) * N + n0 + (lane & 31)] * mult; }
    LDS_WAIT(); asm volatile("" ::: "memory");
#pragma unroll
    for (int j = 0; j < 2; ++j) { const int idx = lane + 64 * j, n = idx >> 2, c = idx & 3; const LAS float* s = scr + (16 * c) * 33 + n;
        u32x4 o;
        o.x = pg8::pk4fp8((f32x4){s[0 * 33], s[1 * 33], s[2 * 33], s[3 * 33]}); o.y = pg8::pk4fp8((f32x4){s[4 * 33], s[5 * 33], s[6 * 33], s[7 * 33]});
        o.z = pg8::pk4fp8((f32x4){s[8 * 33], s[9 * 33], s[10 * 33], s[11 * 33]}); o.w = pg8::pk4fp8((f32x4){s[12 * 33], s[13 * 33], s[14 * 33], s[15 * 33]});
        *(GAS u32x4*)(WT + (size_t)(dr0 + n) * K + k0 + 16 * c) = o; }
    LDS_WAIT(); asm volatile("" ::: "memory");
}
constexpr int CI_WIN = 16 * 176, CI_SQ = 16 * 32, CI_RG = 64, CI_LAYER = CI_WIN + 3 * CI_SQ + 2 * CI_RG;
constexpr int CI_FIN = 16 * 192, CI_FOUT = 48 * 32, CI_DENSE = CI_FIN + CI_FOUT;
constexpr int CI_MIN = 16 * 96, CI_MOUT = 24 * 32, CI_EXP = CI_MIN + CI_MOUT, CI_MOE = 8 * CI_EXP;
constexpr int CI_TOTAL = 4 * CI_LAYER + 2 * CI_DENSE + 2 * CI_MOE;
DI void p0_convert_item(kargp_t kp, int it, LAS float* scr, int lane) {
    unsigned char* ws = karg_ws(kp);
    if (it < 4 * CI_LAYER) {
        const int l = it / CI_LAYER; int r = it % CI_LAYER; unsigned char* wl = ws + WS_WL + (size_t)l * WL_STRIDE;
        if (r < CI_WIN) { p0_transpose_item(karg_in(kp, 8) + (size_t)l * 1024 * D_IN, 1024, D_IN, (bf16*)(wl + WL_WIN), 0, 0, scr, r, lane); return; } r -= CI_WIN;
        if (r < 2 * CI_SQ) { const int br = r / CI_SQ; p0_transpose_item(karg_in(kp, 17) + (size_t)(l * 2 + br) * 1024 * 1024, 1024, 1024, (bf16*)(wl + WL_WB) + (size_t)br * 1024 * 1024, 0, 0, scr, r % CI_SQ, lane); return; } r -= 2 * CI_SQ;
        if (r < CI_SQ) { p0_transpose_item(karg_in(kp, 18) + (size_t)l * 1024 * 1024, 1024, 1024, (bf16*)(wl + WL_WO), 0, 0, scr, r, lane); return; } r -= CI_SQ;
        if (r < CI_RG) { const int nb = r >> 3; p0_transpose_item(karg_in(kp, 11) + (size_t)(l * 8 + nb) * 16384, 128, 128, (bf16*)(wl + WL_WRA) + nb * 16384, 0, 0, scr, r & 7, lane); return; } r -= CI_RG;
        { const int nb = r >> 3; p0_transpose_item(karg_in(kp, 13) + (size_t)(l * 8 + nb) * 16384, 128, 128, (bf16*)(wl + WL_WRX) + nb * 16384, 0, 0, scr, r & 7, lane); return; }
    }
    it -= 4 * CI_LAYER;
    if (it < 2 * CI_DENSE) {
        const int j = it / CI_DENSE; int r = it % CI_DENSE; unsigned char* wd = ws + WS_WD + (size_t)j * WD_STRIDE;
        const bool f8 = (FP8_LAYERS >> (2 * j)) & 1u;
        if (r < CI_FIN) { if (f8) p0_transpose_item8(karg_in(kp, 19) + (size_t)j * 1024 * 6144, 1024, 6144, wd + WD_FIN, 1, 3072, 32.0f, scr, r, lane); else p0_transpose_item(karg_in(kp, 19) + (size_t)j * 1024 * 6144, 1024, 6144, (bf16*)(wd + WD_FIN), 1, 3072, scr, r, lane); return; } r -= CI_FIN;
        if (f8) p0_transpose_item8(karg_in(kp, 20) + (size_t)j * 3072 * 1024, 3072, 1024, wd + WD_FOUT, 0, 0, 64.0f, scr, r, lane); else p0_transpose_item(karg_in(kp, 20) + (size_t)j * 3072 * 1024, 3072, 1024, (bf16*)(wd + WD_FOUT), 0, 0, scr, r, lane); return;
    }
    it -= 2 * CI_DENSE;
    {
        const int j = it / CI_MOE; int r = it % CI_MOE; const int e = r / CI_EXP; r %= CI_EXP; unsigned char* wm = ws + WS_WM + (size_t)j * WM_STRIDE;
        const bool f8 = (FP8_LAYERS >> (2 * j + 1)) & 1u;
        if (r < CI_MIN) { if (f8) p0_transpose_item8(karg_in(kp, 22) + (size_t)(j * 8 + e) * 1024 * 3072, 1024, 3072, wm + WM_MIN + (size_t)e * 3072 * 1024, 1, 1536, 32.0f, scr, r, lane); else p0_transpose_item(karg_in(kp, 22) + (size_t)(j * 8 + e) * 1024 * 3072, 1024, 3072, (bf16*)(wm + WM_MIN) + (size_t)e * 3072 * 1024, 1, 1536, scr, r, lane); return; } r -= CI_MIN;
        if (f8) p0_transpose_item8(karg_in(kp, 23) + (size_t)(j * 8 + e) * 1536 * 1024, 1536, 1024, wm + WM_MOUT + (size_t)e * 1024 * 1536, 0, 0, 32.0f, scr, r, lane); else p0_transpose_item(karg_in(kp, 23) + (size_t)(j * 8 + e) * 1536 * 1024, 1536, 1024, (bf16*)(wm + WM_MOUT) + (size_t)e * 1024 * 1536, 0, 0, scr, r, lane);
    }
}
DI void p0_prologue(LAS unsigned char* lds, int tid, int wave, int lane) {
    const kargp_t kp = kargs();
    LAS float* cact = (LAS float*)lds; LAS float* red = (LAS float*)(lds + 8192);
    float* ADA = (float*)(karg_ws(kp) + WS_ADA);
    for (int i = tid; i < 2 * D; i += NWAVES * 64) { const float c = karg_in(kp, 1)[i]; cact[i] = c / (1.0f + expf(-c)); }
    __syncthreads();
    const int col = tid & 63, ks = tid >> 6;
    for (int it = blockIdx.x; it < 4 * 96; it += gridDim.x) {
        const int l = it / 96, n0 = (it % 96) * 64;
        const float* w = karg_in(kp, 2) + (size_t)l * 1024 * 6144 + (size_t)(ks * 128) * 6144 + n0 + col;
        float s0 = 0.f, s1 = 0.f;
#pragma unroll 8
        for (int k = 0; k < 128; ++k) { const float wv = w[(size_t)k * 6144]; s0 += cact[ks * 128 + k] * wv; s1 += cact[1024 + ks * 128 + k] * wv; }
        red[(ks * 2 + 0) * 64 + col] = s0; red[(ks * 2 + 1) * 64 + col] = s1;
        __syncthreads();
        if (tid < 128) { const int b = tid >> 6, c2 = tid & 63; float s = karg_in(kp, 3)[l * 6144 + n0 + c2];
#pragma unroll
            for (int k2 = 0; k2 < 8; ++k2) s += red[(k2 * 2 + b) * 64 + c2];
            ADA[(l * 2 + b) * 6144 + n0 + c2] = s; }
        __syncthreads();
    }
    __syncthreads();
    LAS float* scr = (LAS float*)(lds + wave * 16384);
    const int gw = blockIdx.x * NWAVES + wave, NGW = gridDim.x * NWAVES;
    for (int it = gw; it < CI_TOTAL; it += NGW) p0_convert_item(kp, it, scr, lane);
}

DI float row_ss(const f32x4 (&v)[4]) { float s = 0.f;
#pragma unroll
    for (int j = 0; j < 4; ++j) s += (v[j].x * v[j].x + v[j].y * v[j].y) + (v[j].z * v[j].z + v[j].w * v[j].w);
    return wave_sum(s); }
DI void ld_row(const float* p, int lane, f32x4 (&v)[4]) {
#pragma unroll
    for (int j = 0; j < 4; ++j) v[j] = *(const f32x4*)(p + 256 * j + 4 * lane); }
DI void st_row(float* p, int lane, const f32x4 (&v)[4]) {
#pragma unroll
    for (int j = 0; j < 4; ++j) *(f32x4*)(p + 256 * j + 4 * lane) = v[j]; }
DI void st_row_f8(unsigned char* p, int lane, const f32x4 (&v)[4]) {
#pragma unroll
    for (int j = 0; j < 4; ++j) *(unsigned*)(p + 256 * j + 4 * lane) = pg8::pk4fp8(v[j]); }
DI void st_row_bf(bf16* p, int lane, const f32x4 (&v)[4]) {
#pragma unroll
    for (int j = 0; j < 4; ++j) { u32x2 w; w.x = pk2(v[j].x, v[j].y); w.y = pk2(v[j].z, v[j].w); *(u32x2*)(p + 256 * j + 4 * lane) = w; } }
DI void ld_row_bfraw(const bf16* p, int lane, u32x2 (&w)[4]) {
#pragma unroll
    for (int j = 0; j < 4; ++j) w[j] = *(const u32x2*)(p + 256 * j + 4 * lane); }
DI void cvt_row_bf(const u32x2 (&w)[4], f32x4 (&v)[4]) {
#pragma unroll
    for (int j = 0; j < 4; ++j) v[j] = (f32x4){bflo(w[j].x), bfhi(w[j].x), bflo(w[j].y), bfhi(w[j].y)}; }
DI void ld_row_bf(const bf16* p, int lane, f32x4 (&v)[4]) {
#pragma unroll
    for (int j = 0; j < 4; ++j) { const u32x2 w = *(const u32x2*)(p + 256 * j + 4 * lane); v[j] = (f32x4){bflo(w.x), bfhi(w.x), bflo(w.y), bfhi(w.y)}; } }

DI void thin_start(int wave, int lane) {
    const kargp_t kp = kargs(); unsigned char* ws = karg_ws(kp);
    const float* ADA = (const float*)(ws + WS_ADA); bf16* XN = (bf16*)(ws + WS_XN);
    const int NGW = gridDim.x * NWAVES, gw = blockIdx.x * NWAVES + wave;
    for (int base = gw * 8; base < M; base += NGW * 8) {
        const int b = base >> 13; const float* ada = ADA + (size_t)b * 6144;
        f32x4 g[4], sc[4], sh[4]; ld_row(karg_in(kp, 4), lane, g); ld_row(ada + 1024, lane, sc); ld_row(ada, lane, sh);
#pragma unroll
        for (int j = 0; j < 4; ++j) sc[j] = g[j] * (sc[j] + 1.0f);
        const float* xin = karg_in(kp, 0);
        f32x4 xn[4]; ld_row(xin + (size_t)base * D, lane, xn);
#pragma unroll
        for (int i = 0; i < 8; ++i) { const size_t m = (size_t)(base + i);
            f32x4 x[4];
#pragma unroll
            for (int j = 0; j < 4; ++j) x[j] = xn[j];
            if (i < 7) ld_row(xin + (m + 1) * D, lane, xn);
            const float rs = rsqrtf(row_ss(x) * (1.0f / D) + EPS);
#pragma unroll
            for (int j = 0; j < 4; ++j) x[j] = x[j] * rs * sc[j] + sh[j];
            st_row_bf(XN + m * D, lane, x); }
    }
}
DI void thin_mid_dense(int l, int wave, int lane) {
    const kargp_t kp = kargs(); unsigned char* ws = karg_ws(kp); bf16* XB = (bf16*)(ws + WS_XB);
    const float* ADA = (const float*)(ws + WS_ADA); bf16* XN = (bf16*)(ws + WS_XN); const bf16* MIX = (const bf16*)(ws + WS_MIX);
    const float* xin = karg_in(kp, 0); const bool l0 = (l == 0);
    const int NGW = gridDim.x * NWAVES, gw = blockIdx.x * NWAVES + wave;
    for (int base = gw * 8; base < M; base += NGW * 8) {
        const int b = base >> 13; const float* ada = ADA + (size_t)(l * 2 + b) * 6144;
        f32x4 pg[4], fg[4], fs[4], t[4];
        ld_row(karg_in(kp, 5) + l * D, lane, pg); ld_row(ada + 2048, lane, t);
#pragma unroll
        for (int j = 0; j < 4; ++j) pg[j] = pg[j] * t[j];
        ld_row(karg_in(kp, 6) + l * D, lane, fg); ld_row(ada + 4096, lane, t); ld_row(ada + 3072, lane, fs);
#pragma unroll
        for (int j = 0; j < 4; ++j) fg[j] = fg[j] * (t[j] + 1.0f);
        u32x2 yn[4], xr[4]; f32x4 xn[4]; ld_row_bfraw(MIX + (size_t)base * D, lane, yn); if (l0) ld_row(xin + (size_t)base * D, lane, xn); else ld_row_bfraw(XB + (size_t)base * D, lane, xr);
#pragma unroll
        for (int i = 0; i < 8; ++i) { const size_t m = (size_t)(base + i);
            f32x4 y[4], x[4]; cvt_row_bf(yn, y);
            if (l0) {
#pragma unroll
                for (int j = 0; j < 4; ++j) x[j] = xn[j];
            } else cvt_row_bf(xr, x);
            if (i < 7) { ld_row_bfraw(MIX + (m + 1) * D, lane, yn); if (l0) ld_row(xin + (m + 1) * D, lane, xn); else ld_row_bfraw(XB + (m + 1) * D, lane, xr); }
            const float rs = rsqrtf(row_ss(y) * (1.0f / D) + EPS);
#pragma unroll
            for (int j = 0; j < 4; ++j) x[j] = x[j] + pg[j] * (y[j] * rs);
            st_row_bf(XB + m * D, lane, x);
            const float rs2 = rsqrtf(row_ss(x) * (1.0f / D) + EPS);
#pragma unroll
            for (int j = 0; j < 4; ++j) x[j] = x[j] * rs2 * fg[j] + fs[j];
            if ((FP8_LAYERS >> l) & 1u) st_row_f8((unsigned char*)XN + m * D, lane, x); else st_row_bf(XN + m * D, lane, x); }
    }
}
DI void thin_mid_moe(LAS unsigned char* lds, int l, int tid, int wave, int lane) {
    const kargp_t kp = kargs(); unsigned char* ws = karg_ws(kp); bf16* XB = (bf16*)(ws + WS_XB);
    const float* ADA = (const float*)(ws + WS_ADA); const bf16* MIX = (const bf16*)(ws + WS_MIX);
    unsigned char* AP = ws + WS_AP; int* TOK = (int*)(ws + WS_TOK);
    unsigned* cntg = (unsigned*)(ws + WS_CTL) + CW_CNT + 64 * (l >> 1);
    const float* wr = karg_in(kp, 21) + (size_t)(l >> 1) * D * NE;
    LAS float* RT = (LAS float*)lds;
    LAS unsigned* cntL = (LAS unsigned*)(lds + 32768);
    for (int i = tid; i < D * NE; i += NWAVES * 64) RT[i] = wr[i];
    for (int rb = blockIdx.x; rb < M / 64; rb += gridDim.x) {
        if (tid < 16) cntL[tid] = 0u;
        __syncthreads();
        const int base = rb * 64 + wave * 8; const int b = base >> 13; const float* ada = ADA + (size_t)(l * 2 + b) * 6144;
        f32x4 pg[4], fg[4], fs[4], t[4];
        ld_row(karg_in(kp, 5) + l * D, lane, pg); ld_row(ada + 2048, lane, t);
#pragma unroll
        for (int j = 0; j < 4; ++j) pg[j] = pg[j] * t[j];
        ld_row(karg_in(kp, 6) + l * D, lane, fg); ld_row(ada + 4096, lane, t); ld_row(ada + 3072, lane, fs);
#pragma unroll
        for (int j = 0; j < 4; ++j) fg[j] = fg[j] * (t[j] + 1.0f);
        int e0s[8], e1s[8], lp0[8], lp1[8]; float w0s[8], rs2s[8];
        u32x2 yn[4], xr[4]; ld_row_bfraw(MIX + (size_t)base * D, lane, yn); ld_row_bfraw(XB + (size_t)base * D, lane, xr);
#pragma unroll
        for (int i = 0; i < 8; ++i) { const size_t m = (size_t)(base + i);
            f32x4 y[4], x[4]; cvt_row_bf(yn, y);
            cvt_row_bf(xr, x);
            if (i < 7) { ld_row_bfraw(MIX + (m + 1) * D, lane, yn); ld_row_bfraw(XB + (m + 1) * D, lane, xr); }
            const float rs = rsqrtf(row_ss(y) * (1.0f / D) + EPS);
#pragma unroll
            for (int j = 0; j < 4; ++j) x[j] = x[j] + pg[j] * (y[j] * rs);
            st_row_bf(XB + m * D, lane, x);
            const float rs2 = rsqrtf(row_ss(x) * (1.0f / D) + EPS);
            float lg[8];
#pragma unroll
            for (int e = 0; e < 8; ++e) lg[e] = 0.f;
#pragma unroll
            for (int j = 0; j < 4; ++j) { x[j] = x[j] * rs2 * fg[j] + fs[j];
#pragma unroll
                for (int q = 0; q < 4; ++q) { const LAS f32x4* tr = (const LAS f32x4*)(RT + (256 * j + 4 * lane + q) * 8); const f32x4 t0 = tr[0], t1 = tr[1]; const float hv = x[j][q];
                    lg[0] += hv * t0.x; lg[1] += hv * t0.y; lg[2] += hv * t0.z; lg[3] += hv * t0.w; lg[4] += hv * t1.x; lg[5] += hv * t1.y; lg[6] += hv * t1.z; lg[7] += hv * t1.w; } }
#pragma unroll
            for (int e = 0; e < 8; ++e) lg[e] = wave_sum(lg[e]);
            int e0 = 0; float v0 = lg[0];
#pragma unroll
            for (int e = 1; e < 8; ++e) if (lg[e] > v0) { v0 = lg[e]; e0 = e; }
            int e1 = -1; float v1 = -INFINITY;
#pragma unroll
            for (int e = 0; e < 8; ++e) if (e != e0 && lg[e] > v1) { v1 = lg[e]; e1 = e; }
            e0 = __builtin_amdgcn_readfirstlane(e0); e1 = __builtin_amdgcn_readfirstlane(e1);
            const float w0 = 1.0f / (1.0f + expf(v1 - v0));
            unsigned q0 = 0u, q1 = 0u;
            if (lane == 0) { q0 = __hip_atomic_fetch_add(cntL + e0, 1u, __ATOMIC_RELAXED, __HIP_MEMORY_SCOPE_WORKGROUP); q1 = __hip_atomic_fetch_add(cntL + e1, 1u, __ATOMIC_RELAXED, __HIP_MEMORY_SCOPE_WORKGROUP); }
            e0s[i] = e0; e1s[i] = e1; lp0[i] = __builtin_amdgcn_readfirstlane((int)q0); lp1[i] = __builtin_amdgcn_readfirstlane((int)q1); w0s[i] = w0; rs2s[i] = rs2;
        }
        __syncthreads();
        if (tid < 8) cntL[8 + tid] = __hip_atomic_fetch_add(cntg + tid, cntL[tid], RLX_AGENT);
        __syncthreads();
#pragma unroll
        for (int i = 0; i < 8; ++i) { const size_t m = (size_t)(base + i);
            const int p0 = (int)cntL[8 + e0s[i]] + lp0[i], p1 = (int)cntL[8 + e1s[i]] + lp1[i];
            const int esz = ((FP8_LAYERS >> l) & 1u) ? 1 : 2; unsigned char* r0 = AP + ((size_t)e0s[i] * ECAP + p0) * D * esz; unsigned char* r1 = AP + ((size_t)e1s[i] * ECAP + p1) * D * esz;
            f32x4 x[4]; ld_row_bf(XB + m * D, lane, x);
#pragma unroll
            for (int j = 0; j < 4; ++j) { x[j] = x[j] * rs2s[i] * fg[j] + fs[j];
                if (esz == 1) { const unsigned hpk = pg8::pk4fp8(x[j]); *(unsigned*)(r0 + 256 * j + 4 * lane) = hpk; *(unsigned*)(r1 + 256 * j + 4 * lane) = hpk; }
                else { u32x2 hpk; hpk.x = pk2(x[j].x, x[j].y); hpk.y = pk2(x[j].z, x[j].w); *(u32x2*)(r0 + 512 * j + 8 * lane) = hpk; *(u32x2*)(r1 + 512 * j + 8 * lane) = hpk; } }
            if (lane == 0) { int4 ti; ti.x = e0s[i] | (e1s[i] << 8); ti.y = p0; ti.z = p1; ti.w = __float_as_int(w0s[i]); *(int4*)(TOK + 4 * m) = ti; }
        }
        __syncthreads();
    }
}
DI void thin_end(int l, int wave, int lane) {
    const kargp_t kp = kargs(); unsigned char* ws = karg_ws(kp); float* outp = karg_out(kp); bf16* XB = (bf16*)(ws + WS_XB);
    const float* ADA = (const float*)(ws + WS_ADA); bf16* XN = (bf16*)(ws + WS_XN); const bf16* MIX = (const bf16*)(ws + WS_MIX);
    const bf16* YP = (const bf16*)(ws + WS_YP); const int* TOK = (const int*)(ws + WS_TOK);
    const bool moe = (l & 1) != 0; const bool last = (l == DEPTH - 1);
    int pp[8];
    { const unsigned* cntg = (const unsigned*)(ws + WS_CTL) + CW_CNT + 64 * (l >> 1); int acc = 0;
#pragma unroll
      for (int e = 0; e < 8; ++e) { pp[e] = acc; const unsigned n = moe ? (unsigned)__builtin_amdgcn_readfirstlane((int)__hip_atomic_load(cntg + e, RLX_AGENT)) : 0u; acc += (int)((n + 255u) >> 8); } }
    const int NGW = gridDim.x * NWAVES, gw = blockIdx.x * NWAVES + wave;
    for (int base = gw * 8; base < M; base += NGW * 8) {
        const int b = base >> 13; const float* ada = ADA + (size_t)(l * 2 + b) * 6144; const float* adan = ADA + (size_t)((last ? l : l + 1) * 2 + b) * 6144;
        f32x4 pg[4], ng[4], ns[4], t[4];
        ld_row(karg_in(kp, 7) + l * D, lane, pg); ld_row(ada + 5120, lane, t);
#pragma unroll
        for (int j = 0; j < 4; ++j) pg[j] = pg[j] * t[j];
        ld_row(karg_in(kp, 4) + (last ? l : l + 1) * D, lane, ng); ld_row(adan + 1024, lane, t); ld_row(adan, lane, ns);
#pragma unroll
        for (int j = 0; j < 4; ++j) ng[j] = ng[j] * (t[j] + 1.0f);
        u32x2 yn[4], zn[4], xr[4]; float w0n = 1.0f;
#define TE_LOAD(mm) do { if (moe) { const int4 ti = *(const int4*)(TOK + 4 * (mm)); const int e0 = ti.x & 255, e1 = (ti.x >> 8) & 255; int b0 = 0, b1 = 0; \
                _Pragma("unroll") for (int e = 1; e < 8; ++e) { if (e0 == e) b0 = pp[e]; if (e1 == e) b1 = pp[e]; } \
                w0n = __int_as_float(ti.w); ld_row_bfraw(YP + ((size_t)b0 * 256 + ti.y) * D, lane, yn); ld_row_bfraw(YP + ((size_t)b1 * 256 + ti.z) * D, lane, zn); } \
            else ld_row_bfraw(MIX + (mm) * D, lane, yn); \
            ld_row_bfraw(XB + (mm) * D, lane, xr); } while (0)
        TE_LOAD((size_t)base);
#pragma unroll
        for (int i = 0; i < 8; ++i) { const size_t m = (size_t)(base + i);
            f32x4 y[4], x[4]; cvt_row_bf(yn, y);
            if (moe) { f32x4 y1[4]; cvt_row_bf(zn, y1); const float w0 = w0n, w1 = 1.0f - w0n;
#pragma unroll
                for (int j = 0; j < 4; ++j) y[j] = y[j] * w0 + y1[j] * w1; }
            cvt_row_bf(xr, x);
            if (i < 7) TE_LOAD(m + 1);
            const float rs = rsqrtf(row_ss(y) * (1.0f / D) + EPS);
#pragma unroll
            for (int j = 0; j < 4; ++j) x[j] = x[j] + pg[j] * (y[j] * rs);
            if (last) st_row(outp + m * D, lane, x); else st_row_bf(XB + m * D, lane, x);
            if (!last) { const float rs2 = rsqrtf(row_ss(x) * (1.0f / D) + EPS);
#pragma unroll
                for (int j = 0; j < 4; ++j) x[j] = x[j] * rs2 * ng[j] + ns[j];
                st_row_bf(XN + m * D, lane, x); }
        }
#undef TE_LOAD
    }
}
constexpr int L_WA = 0, L_WX = 34816, L_XC = 69632, L_PAR = 104448, L_AGG = 108544, L_HST = 116736, L_HINT = 108544;
template <int N> DI float dpp_shr(float oldv, float x) { return __builtin_bit_cast(float, __builtin_amdgcn_update_dpp(__builtin_bit_cast(int, oldv), __builtin_bit_cast(int, x), 0x110 + N, 0xf, 0xf, false)); }
template <int N> DI void scan_step(f32x4& a, f32x4& u) {
#pragma unroll
    for (int q = 0; q < 4; ++q) { const float ap = dpp_shr<N>(1.0f, a[q]), up = dpp_shr<N>(0.0f, u[q]); u[q] = a[q] * up + u[q]; a[q] = a[q] * ap; }
}
DI f32x4 mfma16(bf16x8 a, bf16x8 b, f32x4 c) { return __builtin_amdgcn_mfma_f32_16x16x32_bf16(a, b, c, 0, 0, 0); }
DI f32x4 bf4lo(u32x4 v) { return (f32x4){bflo(v.x), bfhi(v.x), bflo(v.y), bfhi(v.y)}; }
DI f32x4 bf4hi(u32x4 v) { return (f32x4){bflo(v.z), bfhi(v.z), bflo(v.w), bfhi(v.w)}; }
DI void rnn_pass1(LAS unsigned char* lds, int l, int tid, int wave, int lane) {
    const int fr = lane & 15, fq = lane >> 4;
    LAS float* PAR = (LAS float*)(lds + L_PAR); LAS float* AGG = (LAS float*)(lds + L_AGG); LAS float* HST = (LAS float*)(lds + L_HST);
    const int cc = tid & 15, tg4 = (tid >> 4) * 4;
    for (int it = blockIdx.x; it < 256; it += gridDim.x) {
        const int nb = it & 7, seg = it >> 3, sidx = seg & 15; const int m0 = seg * 512;
        const kargp_t kp = kargs(); unsigned char* ws = karg_ws(kp);
        const bf16* XRp = (const bf16*)(ws + WS_XR);
        __syncthreads();
        u32x4 pre[7];
        f32x4 cw0[4], cw1[4], cb0, cb1;
#define RNN_PREFETCH(stn) do { _Pragma("unroll") for (int j = 0; j < 7; ++j) { const int rl = 128 * (stn) + tg4 - 3 + j; pre[j] = (u32x4){0u, 0u, 0u, 0u}; \
                if (!(sidx == 0 && rl < 0)) pre[j] = *(const u32x4*)(XRp + (size_t)(m0 + rl) * 1024 + nb * 128 + cc * 8); } } while (0)
        RNN_PREFETCH(0);
        { const bf16* WA = (const bf16*)(ws + WS_WL + (size_t)l * WL_STRIDE + WL_WRA) + nb * 16384; const bf16* WX = (const bf16*)(ws + WS_WL + (size_t)l * WL_STRIDE + WL_WRX) + nb * 16384;
          u32x4 wreg[8];
#pragma unroll
          for (int i = 0; i < 4; ++i) { const int q = tid + 512 * i; wreg[i] = *(const u32x4*)(WA + (q >> 4) * 128 + (q & 15) * 8); wreg[4 + i] = *(const u32x4*)(WX + (q >> 4) * 128 + (q & 15) * 8); }
          { const float* cwp = karg_in(kp, 9) + (size_t)l * 4096 + nb * 128 + cc * 8; const float* cbp = karg_in(kp, 10) + l * 1024 + nb * 128 + cc * 8;
#pragma unroll
              for (int k = 0; k < 4; ++k) { cw0[k] = *(const f32x4*)(cwp + k * 1024); cw1[k] = *(const f32x4*)(cwp + k * 1024 + 4); }
              cb0 = *(const f32x4*)cbp; cb1 = *(const f32x4*)(cbp + 4); }
          if (tid < 128) { const int ch = l * 1024 + nb * 128 + tid;
            PAR[0 * 128 + tid] = karg_in(kp, 12)[ch]; PAR[1 * 128 + tid] = karg_in(kp, 14)[ch]; PAR[2 * 128 + tid] = 8.0f * log1pf(expf(-karg_in(kp, 15)[ch])) * LOG2E;
            *(LAS f32x2*)(HST + 2 * tid) = (f32x2){1.0f, 0.0f}; }
#pragma unroll
          for (int i = 0; i < 4; ++i) { const int q = tid + 512 * i; *(LAS u32x4*)(lds + L_WA + (q >> 4) * 272 + (q & 15) * 16) = wreg[i]; *(LAS u32x4*)(lds + L_WX + (q >> 4) * 272 + (q & 15) * 16) = wreg[4 + i]; } }
        for (int st = 0; st < 4; ++st) {
#pragma unroll
            for (int i = 0; i < 4; ++i) { f32x4 o0 = cb0, o1 = cb1;
#pragma unroll
                for (int k = 0; k < 4; ++k) { o0 += cw0[k] * bf4lo(pre[i + k]); o1 += cw1[k] * bf4hi(pre[i + k]); }
                u32x4 pk; pk.x = pk2(o0[0], o0[1]); pk.y = pk2(o0[2], o0[3]); pk.z = pk2(o1[0], o1[1]); pk.w = pk2(o1[2], o1[3]);
                *(LAS u32x4*)(lds + L_XC + (tg4 + i) * 272 + cc * 16) = pk; }
            __syncthreads();
            if (st < 3) RNN_PREFETCH(st + 1);
            const int tl = 16 * wave + fr;
            bf16x8 xb[4];
#pragma unroll
            for (int s = 0; s < 4; ++s) xb[s] = *(const LAS bf16x8*)(lds + L_XC + tl * 272 + (32 * s + 8 * fq) * 2);
            unsigned* PSw = (unsigned*)(ws + WS_PS); float* T16w = (float*)(ws + WS_T16);
#pragma unroll
            for (int n = 0; n < 8; ++n) { const int ch0 = 16 * n + 4 * fq;
                f32x4 ca = (f32x4){0.f, 0.f, 0.f, 0.f}, cx = ca;
#pragma unroll
                for (int s = 0; s < 4; ++s) { const bf16x8 af = *(const LAS bf16x8*)(lds + L_WA + (16 * n + fr) * 272 + (32 * s + 8 * fq) * 2), xf = *(const LAS bf16x8*)(lds + L_WX + (16 * n + fr) * 272 + (32 * s + 8 * fq) * 2);
                    ca = mfma16(af, xb[s], ca); cx = mfma16(xf, xb[s], cx); }
                const u32x2 xv = *(const LAS u32x2*)(lds + L_XC + tl * 272 + ch0 * 2); const f32x4 xc = (f32x4){bflo(xv.x), bfhi(xv.x), bflo(xv.y), bfhi(xv.y)};
                const f32x4 r = pg8::sig4(ca + *(const LAS f32x4*)(PAR + ch0)), ig = pg8::sig4(cx + *(const LAS f32x4*)(PAR + 128 + ch0)), sp = *(const LAS f32x4*)(PAR + 256 + ch0);
                f32x4 av, uv;
#pragma unroll
                for (int q = 0; q < 4; ++q) { const float aa = fexp2(-r[q] * sp[q]); av[q] = aa; uv[q] = __builtin_amdgcn_sqrtf(1.0f - aa * aa) * ig[q] * xc[q]; }
                scan_step<1>(av, uv); scan_step<2>(av, uv); scan_step<4>(av, uv); scan_step<8>(av, uv);
                { u32x4 ps; ps.x = pk2(av[0], uv[0]); ps.y = pk2(av[1], uv[1]); ps.z = pk2(av[2], uv[2]); ps.w = pk2(av[3], uv[3]);
                  *(u32x4*)(PSw + (size_t)(m0 + 128 * st + tl) * 1024 + nb * 128 + ch0) = ps; }
                if (fr == 15) { const f32x4 g0 = (f32x4){av[0], uv[0], av[1], uv[1]}, g1 = (f32x4){av[2], uv[2], av[3], uv[3]};
                    *(LAS f32x4*)(AGG + (wave * 128 + ch0) * 2) = g0; *(LAS f32x4*)(AGG + (wave * 128 + ch0) * 2 + 4) = g1;
                    float* o = T16w + ((size_t)(seg * 32 + st * 8 + wave) * 1024 + nb * 128 + ch0) * 2; *(f32x4*)o = g0; *(f32x4*)(o + 4) = g1; }
            }
            __syncthreads();
            LAS float* HS0 = HST + 256 * (st & 1); LAS float* HS1 = HST + 256 * ((st + 1) & 1);
            if (fr == 0) { const int ch0 = 16 * wave + 4 * fq;
                const f32x4 h0 = *(const LAS f32x4*)(HS0 + 2 * ch0), h1 = *(const LAS f32x4*)(HS0 + 2 * ch0 + 4);
                f32x4 A = (f32x4){h0[0], h0[2], h1[0], h1[2]}, U = (f32x4){h0[1], h0[3], h1[1], h1[3]};
#pragma unroll
                for (int w2 = 0; w2 < 8; ++w2) { const f32x4 g0 = *(const LAS f32x4*)(AGG + (w2 * 128 + ch0) * 2), g1 = *(const LAS f32x4*)(AGG + (w2 * 128 + ch0) * 2 + 4);
                    const f32x4 a2 = (f32x4){g0[0], g0[2], g1[0], g1[2]}, u2 = (f32x4){g0[1], g0[3], g1[1], g1[3]}; U = a2 * U + u2; A = A * a2; }
                const f32x4 o0 = (f32x4){A[0], U[0], A[1], U[1]}, o1 = (f32x4){A[2], U[2], A[3], U[3]};
                *(LAS f32x4*)(HS1 + 2 * ch0) = o0; *(LAS f32x4*)(HS1 + 2 * ch0 + 4) = o1;
                if (st == 3) { float* o = (float*)(ws + WS_RAGG) + ((size_t)seg * 1024 + nb * 128 + ch0) * 2; *(f32x4*)o = o0; *(f32x4*)(o + 4) = o1; } }
        }
#undef RNN_PREFETCH
    }
}
DI void rnn_pass2(LAS unsigned char* lds, int tid) {
    LAS float* HINT = (LAS float*)lds;
    for (int it = blockIdx.x; it < 256; it += gridDim.x) {
        const int nb = it & 7, seg = it >> 3, sidx = seg & 15; const int m0 = seg * 512;
        unsigned char* ws = karg_ws(kargs());
        __syncthreads();
        if (tid < 128) { const float* RAGG = (const float*)(ws + WS_RAGG) + ((size_t)(seg - sidx) * 1024 + nb * 128 + tid) * 2; const float* T16 = (const float*)(ws + WS_T16) + ((size_t)(seg * 32) * 1024 + nb * 128 + tid) * 2;
            f32x2 sa[15], ta[32];
#pragma unroll
            for (int s2 = 0; s2 < 15; ++s2) sa[s2] = *(const f32x2*)(RAGG + (size_t)s2 * 2048);
#pragma unroll
            for (int t2 = 0; t2 < 32; ++t2) ta[t2] = *(const f32x2*)(T16 + (size_t)t2 * 2048);
            float h = 0.f;
#pragma unroll
            for (int s2 = 0; s2 < 15; ++s2) h = (s2 < sidx) ? sa[s2].x * h + sa[s2].y : h;
#pragma unroll
            for (int t2 = 0; t2 < 32; ++t2) { HINT[t2 * 128 + tid] = h; h = ta[t2].x * h + ta[t2].y; } }
        __syncthreads();
        const unsigned* PS = (const unsigned*)(ws + WS_PS); const bf16* GGp = (const bf16*)(ws + WS_GG); bf16* ROp = (bf16*)(ws + WS_RO);
        const int c4 = (tid & 31) * 4, r0 = tid >> 5;
#pragma unroll 4
        for (int i = 0; i < 32; ++i) { const int row = r0 + 16 * i; const size_t off = (size_t)(m0 + row) * 1024 + nb * 128 + c4;
            const u32x4 ps = *(const u32x4*)(PS + off); const u32x2 gv = *(const u32x2*)(GGp + off); const f32x4 hin = *(const LAS f32x4*)(HINT + (row >> 4) * 128 + c4);
            const float h0 = bflo(ps.x) * hin[0] + bfhi(ps.x), h1 = bflo(ps.y) * hin[1] + bfhi(ps.y), h2 = bflo(ps.z) * hin[2] + bfhi(ps.z), h3 = bflo(ps.w) * hin[3] + bfhi(ps.w);
            u32x2 o; o.x = pk2(h0 * bflo(gv.x), h1 * bfhi(gv.x)); o.y = pk2(h2 * bflo(gv.y), h3 * bfhi(gv.y)); *(u32x2*)(ROp + off) = o; }
    }
}

constexpr int L_K = 0, L_V = 69632;
DI f32x16 mfma32(bf16x8 a, bf16x8 b, f32x16 c) { return __builtin_amdgcn_mfma_f32_32x32x16_bf16(a, b, c, 0, 0, 0); }
DI void attn_phase(LAS unsigned char* lds, int l, int tid, int wave, int lane) {
    const int r = lane & 31, h = lane >> 5;
    const kargp_t kp = kargs(); unsigned char* ws = karg_ws(kp);
    const bf16* Q = (const bf16*)(ws + WS_Q); const bf16* KB = (const bf16*)(ws + WS_KB); const bf16* VB = (const bf16*)(ws + WS_VB); bf16* AO = (bf16*)(ws + WS_AO); const float* sinks = karg_in(kp, 16) + l * 8;
    for (int it = blockIdx.x; it < 256; it += gridDim.x) {
        const int b = it >> 7, qblk = (it >> 1) & 63, kvh = it & 1; const int rowbase = b * SEQ + qblk * 128;
        __syncthreads();
#pragma unroll
        for (int i = 0; i < 8; ++i) { const int idx = tid + 512 * i, j = idx >> 4, c = idx & 15; u32x4 v = (u32x4){0u, 0u, 0u, 0u};
            if (qblk > 0 || j >= 128) v = *(const u32x4*)(KB + (size_t)(rowbase - 128 + j) * 256 + kvh * 128 + c * 8);
            *(LAS u32x4*)(lds + L_K + j * 272 + c * 16) = v; }
#pragma unroll
        for (int i = 0; i < 8; ++i) { const int idx = tid + 512 * i, c = idx >> 8, j = idx & 255; u32x4 v = (u32x4){0u, 0u, 0u, 0u};
            if (qblk > 0 || j >= 128) v = *(const u32x4*)(VB + (size_t)(rowbase - 128 + j) * 256 + kvh * 128 + c * 8);
            LAS unsigned short* vt = (LAS unsigned short*)(lds + L_V) + (8 * c) * 264 + j;
            vt[0 * 264] = (unsigned short)(v.x & 0xffffu); vt[1 * 264] = (unsigned short)(v.x >> 16); vt[2 * 264] = (unsigned short)(v.y & 0xffffu); vt[3 * 264] = (unsigned short)(v.y >> 16);
            vt[4 * 264] = (unsigned short)(v.z & 0xffffu); vt[5 * 264] = (unsigned short)(v.z >> 16); vt[6 * 264] = (unsigned short)(v.w & 0xffffu); vt[7 * 264] = (unsigned short)(v.w >> 16); }
        __syncthreads();
        const int g = wave >> 1, head = kvh * 4 + g;
        const float slope2 = exp2f(-(float)(head + 1)) * LOG2E, sink2 = sinks[head] * LOG2E;
#pragma unroll 1
        for (int si = 0; si < 2; ++si) {
            const int q0 = 64 * (wave & 1) + 32 * si, kt0 = q0 >> 5; const size_t qrow = (size_t)(rowbase + q0 + r);
            bf16x8 qf[8];
#pragma unroll
            for (int ks = 0; ks < 8; ++ks) qf[ks] = *(const bf16x8*)(Q + qrow * 1024 + head * 128 + 16 * ks + 8 * h);
            const LAS unsigned char* kbase = lds + L_K + (32 * kt0 + r) * 272 + 16 * h;
            const LAS unsigned char* vbase = lds + L_V + r * 528 + 64 * kt0 + 8 * h;
            const int d0 = (q0 + r) + 128 - (32 * kt0 + 4 * h);
            const int jlim = qblk > 0 ? -100000 : 128 - (32 * kt0 + 4 * h);
            const float fd0 = (float)d0, fjl = (float)jlim;
            f32x16 p[5];
#pragma unroll
            for (int t = 0; t < 5; ++t) {
#pragma unroll
                for (int e = 0; e < 16; ++e) p[t][e] = 0.f;
#pragma unroll
                for (int ks = 0; ks < 8; ++ks) { const bf16x8 kf = *(const LAS bf16x8*)(kbase + t * 8704 + ks * 32); p[t] = mfma32(kf, qf[ks], p[t]); } }
            float mx = sink2;
#pragma unroll
            for (int t = 0; t < 5; ++t)
#pragma unroll
                for (int e = 0; e < 16; ++e) { const float cte = (float)(32 * t + (e & 3) + 8 * (e >> 2)); const float fd = fd0 - cte;
                    const float bad = fmaxf(fmaxf(-fd, fd - 127.0f), fjl - cte);
                    p[t][e] = p[t][e] - slope2 * fd + fminf(0.f, -1e30f * bad); mx = fmaxf(mx, p[t][e]); }
            mx = fmaxf(mx, __shfl_xor(mx, 32));
            float sum = 0.f;
#pragma unroll
            for (int t = 0; t < 5; ++t)
#pragma unroll
                for (int e = 0; e < 16; ++e) { const float ev = fexp2(p[t][e] - mx); p[t][e] = ev; sum += ev; }
            sum += __shfl_xor(sum, 32); sum += fexp2(sink2 - mx);
            const float inv = 1.0f / sum;
            f32x16 o[4];
#pragma unroll
            for (int dt = 0; dt < 4; ++dt)
#pragma unroll
                for (int e = 0; e < 16; ++e) o[dt][e] = 0.f;
#pragma unroll
            for (int t = 0; t < 5; ++t) {
#pragma unroll
                for (int s = 0; s < 2; ++s) { u32x4 pk; pk.x = pk2(p[t][8 * s + 0], p[t][8 * s + 1]); pk.y = pk2(p[t][8 * s + 2], p[t][8 * s + 3]); pk.z = pk2(p[t][8 * s + 4], p[t][8 * s + 5]); pk.w = pk2(p[t][8 * s + 6], p[t][8 * s + 7]);
                    const bf16x8 pf = __builtin_bit_cast(bf16x8, pk);
#pragma unroll
                    for (int dt = 0; dt < 4; ++dt) { const LAS unsigned char* va = vbase + dt * 16896 + t * 64 + s * 32;
                        const s16x4 lo = *(const LAS s16x4*)va, hi = *(const LAS s16x4*)(va + 16);
                        const bf16x8 vf = __builtin_shufflevector(lo, hi, 0, 1, 2, 3, 4, 5, 6, 7); o[dt] = mfma32(vf, pf, o[dt]); } } }
#pragma unroll
            for (int dt = 0; dt < 4; ++dt)
#pragma unroll
                for (int gg = 0; gg < 4; ++gg) { u32x2 w; w.x = pk2(o[dt][4 * gg] * inv, o[dt][4 * gg + 1] * inv); w.y = pk2(o[dt][4 * gg + 2] * inv, o[dt][4 * gg + 3] * inv);
                    *(u32x2*)(AO + qrow * 1024 + head * 128 + 32 * dt + 8 * gg + 4 * h) = w; }
        }
    }
}

constexpr int N_PHASES = 2 + 9 * DEPTH;
__global__ void __launch_bounds__(NWAVES * 64, 2) trunk_fwd(Args args) {
    extern __shared__ __attribute__((aligned(16))) unsigned char lds_raw[];
    LAS unsigned char* lds = (LAS unsigned char*)lds_raw;
    volatile LAS unsigned* MISC = (volatile LAS unsigned*)(lds + MISC_OFF);
    const int tid0 = threadIdx.x;
#define TID_DEFS int tid = tid0; asm volatile("" : "+v"(tid)); const int lane = tid & 63, wave = __builtin_amdgcn_readfirstlane(tid >> 6); (void)lane; (void)wave;
    const int G = gridDim.x;
    gu32* ctl = (gu32*)(args.ws + WS_CTL);
    for (int u = tid0; u < (LDS_BYTES - LDSCTL_OFF) / 4; u += NWAVES * 64) ((LAS unsigned*)(lds + LDSCTL_OFF))[u] = 0u;
    __syncthreads();
    XcdBarrier bar = xcd_barrier_post((unsigned*)ctl + CW_BAR, MISC + 8);
    const int lo = args.ph_lo, hi = args.ph_hi;
#ifndef PH_MASK
#define PH_MASK 0xffffffffu
#endif
#define EN(b) ((PH_MASK >> (b)) & 1u)
#ifndef PH_REPEAT
#define PH_REPEAT 0u
#endif
#ifndef PH_NREP
#define PH_NREP 2
#endif
#define REPS(b) (((PH_REPEAT >> (b)) & 1u) ? PH_NREP : 1)
#define REP_BEGIN(b) for (int rep_ = 0; rep_ < REPS(b); ++rep_) { if (rep_) xcd_barrier(bar);
#define REP_END }
#define IN(k) (lo <= (k) && (k) < hi)
#ifndef BAR_TWICE
#define BAR_TWICE 0
#endif
#define SEAM(k) do { if (IN(k) && IN((k) + 1)) { xcd_barrier(bar); if (BAR_TWICE) xcd_barrier(bar); } } while (0)
#if NAIVE_GEMM
#define RUN_GEMM(EPI, SCHED, ALIGN, g, S, E) pg8::gemm_phase_naive<EPI, SCHED>(g, S, E)
#else
#ifndef BF_SP2
#define BF_SP2 true
#endif
#define RUN_GEMM(EPI, SCHED, ALIGN, g, S, E) pg8::gemm_phase<EPI, SCHED, ALIGN, BF_SP2>(lds + RING_OFF, g, S, E)
#endif
#ifndef F8_ALIGN
#define F8_ALIGN(a) (a)
#endif
#ifndef F8_SP2
#define F8_SP2 false
#endif
#define RUN_GEMM8(EPI, SCHED, ALIGN, g, S, E) pg8::gemm_phase<EPI, SCHED, F8_ALIGN(ALIGN), F8_SP2, true>(lds + RING_OFF, g, S, E)
#define SC_ONE 0x7f7f7f7f
#define SC_M5 0x7a7a7a7a
#define SC_M6 0x79797979
    if (EN(0) && IN(0)) { REP_BEGIN(0) TID_DEFS p0_prologue(lds, tid, wave, lane); REP_END } SEAM(0);
    if (EN(1) && IN(1)) { REP_BEGIN(1) TID_DEFS thin_start(wave, lane); REP_END } SEAM(1);

    for (int l = 0; l < DEPTH; ++l) {
        const int pb = 2 + 9 * l;
        if (EN(2) && IN(pb + 0)) { REP_BEGIN(2)
            unsigned char* ws = karg_ws(kargs());
            pg8::Gemm g{(const bf16*)(ws + WS_XN), (const bf16*)(ws + WS_WL + (size_t)l * WL_STRIDE + WL_WIN), M, D_IN, D}; pg8::StaticOrder S; S.init(M, D_IN, G, (int)blockIdx.x);
            pg8::EpiWin E; E.R = ws + WS_R;
            RUN_GEMM(pg8::EpiWin, pg8::StaticOrder, true, g, S, E);
         REP_END } SEAM(pb + 0);
        if (IN(pb + 1)) {
            if (EN(3)) { REP_BEGIN(3) TID_DEFS rnn_pass1(lds, l, tid, wave, lane); REP_END }
            if (EN(4)) { REP_BEGIN(4) TID_DEFS attn_phase(lds, l, tid, wave, lane); REP_END }
        } SEAM(pb + 1);
        if (EN(5) && IN(pb + 2)) { REP_BEGIN(5) TID_DEFS rnn_pass2(lds, tid); REP_END } SEAM(pb + 2);
        if (EN(6) && IN(pb + 3)) { REP_BEGIN(6)
            { unsigned char* ws = karg_ws(kargs());
              pg8::Gemm g{(const bf16*)(ws + WS_RO), (const bf16*)(ws + WS_WL + (size_t)l * WL_STRIDE + WL_WB), M, D, D}; pg8::StaticOrder S; S.init(M, D, G, (int)blockIdx.x);
              pg8::EpiBranch0 E; E.R = ws + WS_R; RUN_GEMM(pg8::EpiBranch0, pg8::StaticOrder, false, g, S, E); }
            VM_WAIT();
            { unsigned char* ws = karg_ws(kargs());
              pg8::Gemm g{(const bf16*)(ws + WS_AO), (const bf16*)(ws + WS_WL + (size_t)l * WL_STRIDE + WL_WB) + (size_t)D * D, M, D, D}; pg8::StaticOrder S; S.init(M, D, G, (int)blockIdx.x);
              pg8::EpiBranch1 E; E.R = ws + WS_R; RUN_GEMM(pg8::EpiBranch1, pg8::StaticOrder, false, g, S, E); }
         REP_END } SEAM(pb + 3);
        if (EN(7) && IN(pb + 4)) { REP_BEGIN(7)
            unsigned char* ws = karg_ws(kargs());
            pg8::Gemm g{(const bf16*)(ws + WS_MG), (const bf16*)(ws + WS_WL + (size_t)l * WL_STRIDE + WL_WO), M, D, D}; pg8::StaticOrder S; S.init(M, D, G, (int)blockIdx.x);
            pg8::EpiBf16N E; E.O = (bf16*)(ws + WS_MIX); RUN_GEMM(pg8::EpiBf16N, pg8::StaticOrder, false, g, S, E);
         REP_END } SEAM(pb + 4);
        if (IN(pb + 5)) { if (l & 1) { if (EN(9)) { TID_DEFS thin_mid_moe(lds, l, tid, wave, lane); } } else { if (EN(8)) { TID_DEFS thin_mid_dense(l, wave, lane); } } } SEAM(pb + 5);
        if (l & 1) {
            if (EN(10) && IN(pb + 6)) { REP_BEGIN(10)
                unsigned char* ws = karg_ws(kargs()); const unsigned* cntg = (const unsigned*)(ws + WS_CTL) + CW_CNT + 64 * (l >> 1);
                pg8::Gemm g{(const bf16*)(ws + WS_AP), (const bf16*)(ws + WS_WM + (size_t)(l >> 1) * WM_STRIDE + WM_MIN), 0, 0, D, SC_M5, SC_ONE}; pg8::MoeOrder S; S.init(cntg, 12, G, (int)blockIdx.x, ECAP / 256);
                if ((FP8_LAYERS >> l) & 1u) { pg8::EpiSwiglu8 E; E.O = ws + WS_ACTP; E.ldc = D_FFE; E.ntile = 12; RUN_GEMM8(pg8::EpiSwiglu8, pg8::MoeOrder, true, g, S, E); }
                else { pg8::EpiSwiglu E; E.O = (bf16*)(ws + WS_ACTP); E.ldc = D_FFE; E.ntile = 12; RUN_GEMM(pg8::EpiSwiglu, pg8::MoeOrder, true, g, S, E); }
             REP_END } SEAM(pb + 6);
            if (EN(11) && IN(pb + 7)) { REP_BEGIN(11)
                unsigned char* ws = karg_ws(kargs()); const unsigned* cntg = (const unsigned*)(ws + WS_CTL) + CW_CNT + 64 * (l >> 1);
                pg8::Gemm g{(const bf16*)(ws + WS_ACTP), (const bf16*)(ws + WS_WM + (size_t)(l >> 1) * WM_STRIDE + WM_MOUT), 0, 0, D_FFE, SC_M5, SC_ONE}; pg8::MoeOrder S; S.init(cntg, 4, G, (int)blockIdx.x, 0);
                pg8::EpiBf16Mod4 E; E.O = (bf16*)(ws + WS_YP);
                if ((FP8_LAYERS >> l) & 1u) RUN_GEMM8(pg8::EpiBf16Mod4, pg8::MoeOrder, true, g, S, E); else RUN_GEMM(pg8::EpiBf16Mod4, pg8::MoeOrder, true, g, S, E);
             REP_END } SEAM(pb + 7);
        } else {
            if (EN(12) && IN(pb + 6)) { REP_BEGIN(12)
                unsigned char* ws = karg_ws(kargs());
                pg8::Gemm g{(const bf16*)(ws + WS_XN), (const bf16*)(ws + WS_WD + (size_t)(l >> 1) * WD_STRIDE + WD_FIN), M, 2 * D_FF, D, SC_M5, SC_ONE}; pg8::StaticOrder S; S.init(M, 2 * D_FF, G, (int)blockIdx.x);
                if ((FP8_LAYERS >> l) & 1u) { pg8::EpiSwiglu8 E; E.O = ws + WS_ACT; E.ldc = D_FF; E.ntile = 24; RUN_GEMM8(pg8::EpiSwiglu8, pg8::StaticOrder, true, g, S, E); }
                else { pg8::EpiSwiglu E; E.O = (bf16*)(ws + WS_ACT); E.ldc = D_FF; E.ntile = 24; RUN_GEMM(pg8::EpiSwiglu, pg8::StaticOrder, true, g, S, E); }
             REP_END } SEAM(pb + 6);
            if (EN(13) && IN(pb + 7)) { REP_BEGIN(13)
                unsigned char* ws = karg_ws(kargs());
                pg8::Gemm g{(const bf16*)(ws + WS_ACT), (const bf16*)(ws + WS_WD + (size_t)(l >> 1) * WD_STRIDE + WD_FOUT), M, D, D_FF, SC_M6, SC_ONE}; pg8::StaticOrder S; S.init(M, D, G, (int)blockIdx.x);
                pg8::EpiBf16N E; E.O = (bf16*)(ws + WS_MIX);
                if ((FP8_LAYERS >> l) & 1u) RUN_GEMM8(pg8::EpiBf16N, pg8::StaticOrder, false, g, S, E); else RUN_GEMM(pg8::EpiBf16N, pg8::StaticOrder, false, g, S, E);
             REP_END } SEAM(pb + 7);
        }
        if (EN(14) && IN(pb + 8)) { TID_DEFS thin_end(l, wave, lane); } SEAM(pb + 8);
    }
#undef IN
#undef SEAM
}

extern "C" void kernel_launch(void* const* d_in, const int* in_sizes, int n_in, void* d_out, int out_size, void* d_ws, size_t ws_size, hipStream_t stream) {
    static int grid = 0;
    if (grid == 0) {
        if (n_in != 24 || in_sizes[0] != M * D || out_size != M * D || ws_size < WS_END) { fprintf(stderr, "kernel_launch: unexpected shapes or workspace (n_in %d, in0 %d, out %d, ws %zu < %zu); nothing launched\n", n_in, n_in > 0 ? in_sizes[0] : -1, out_size, ws_size, (size_t)WS_END); grid = -1; return; }
        int dev = 0, cus = 0, per_cu = 0;
        if (hipGetDevice(&dev) != hipSuccess || hipDeviceGetAttribute(&cus, hipDeviceAttributeMultiprocessorCount, dev) != hipSuccess) { grid = -1; return; }
        if (hipFuncSetAttribute((const void*)trunk_fwd, hipFuncAttributeMaxDynamicSharedMemorySize, LDS_BYTES) != hipSuccess) { fprintf(stderr, "kernel_launch: hipFuncSetAttribute failed\n"); grid = -1; return; }
        if (hipOccupancyMaxActiveBlocksPerMultiprocessor(&per_cu, (const void*)trunk_fwd, NWAVES * 64, LDS_BYTES) != hipSuccess || per_cu < 1)
            fprintf(stderr, "kernel_launch: note: occupancy query reports %d workgroups per CU\n", per_cu);
        (void)hipGetLastError();
        grid = cus;
    }
    if (grid < 0) return;
    if (hipMemsetAsync((char*)d_ws + WS_CTL, 0, CTL_ZERO_BYTES, stream) != hipSuccess) return;
    Args a{};
    for (int i = 0; i < 24; ++i) a.in[i] = (const float*)d_in[i];
    a.out = (float*)d_out; a.ws = (unsigned char*)d_ws;
#if MK_ONE_LAUNCH
    a.ph_lo = 0; a.ph_hi = N_PHASES;
    hipLaunchKernelGGL(trunk_fwd, dim3(grid), dim3(NWAVES * 64), LDS_BYTES, stream, a);
#else
    for (int p = 0; p < N_PHASES; ++p) { a.ph_lo = p; a.ph_hi = p + 1; hipLaunchKernelGGL(trunk_fwd, dim3(grid), dim3(NWAVES * 64), LDS_BYTES, stream, a); }
#endif
}
```

```cpp
#include <hip/hip_runtime.h>
#include <cstdio>
#include <cstdint>

#ifndef MK_ONE_LAUNCH
#define MK_ONE_LAUNCH 1
#endif
#ifndef NAIVE_GEMM
#define NAIVE_GEMM 0
#endif

#ifndef FP8_LAYERS
#define FP8_LAYERS 0xEu
#endif
#define DI __device__ __forceinline__
#define GAS __attribute__((address_space(1)))
#define LAS __attribute__((address_space(3)))
typedef unsigned short bf16;
typedef short bf16x8 __attribute__((ext_vector_type(8)));
typedef short s16x4 __attribute__((ext_vector_type(4)));
typedef float f32x2 __attribute__((ext_vector_type(2)));
typedef float f32x4 __attribute__((ext_vector_type(4)));
typedef float f32x16 __attribute__((ext_vector_type(16)));
typedef unsigned u32x2 __attribute__((ext_vector_type(2)));
typedef unsigned u32x4 __attribute__((ext_vector_type(4)));
typedef __bf16 bf16x2_t __attribute__((ext_vector_type(2)));
typedef GAS unsigned gu32;

constexpr int BATCH = 2, SEQ = 8192, D = 1024, DEPTH = 4, M = BATCH * SEQ;
constexpr int D_IN = 5632, D_FF = 3072, NE = 8, D_FFE = 1536, ECAP = 16384;
constexpr float EPS = 1e-6f;
constexpr float LOG2E = 1.4426950408889634f;
constexpr float QSCALE = 0.08838834764831845f * 1.4426950408889634f;

DI unsigned pk2(float lo, float hi) { f32x2 v = {lo, hi}; return __builtin_bit_cast(unsigned, __builtin_convertvector(v, bf16x2_t)); }
DI float bflo(unsigned w) { return __uint_as_float(w << 16); }
DI float bfhi(unsigned w) { return __uint_as_float(w & 0xffff0000u); }
DI float fexp2(float x) { return __builtin_amdgcn_exp2f(x); }
DI float frcp(float x) { return __builtin_amdgcn_rcpf(x); }
DI float sigmoidf_(float v) { return frcp(1.0f + fexp2(-LOG2E * v)); }
DI float siluf_(float v) { return v * sigmoidf_(v); }
DI float gelu_tanh_(float v) { const float t = v + 0.044715f * v * v * v; return v * frcp(1.0f + fexp2(-2.0f * 0.7978845608028654f * LOG2E * t)); }
DI float wave_sum(float v) {
#pragma unroll
    for (int o = 1; o < 64; o <<= 1) v += __shfl_xor(v, o);
    return v;
}
#define LDS_WAIT() asm volatile("s_waitcnt lgkmcnt(0)" ::: "memory")
#define VM_WAIT() asm volatile("s_waitcnt vmcnt(0)" ::: "memory")
#define RLX_AGENT __ATOMIC_RELAXED, __HIP_MEMORY_SCOPE_AGENT
#ifndef HOOK_ON
#define HOOK_ON 1
#endif
namespace pg8 {
#define PG8_LAS __attribute__((address_space(3)))
typedef unsigned short bf16_t;
constexpr int BM = 256, BK = 64, HALF = 128, HTB = HALF * BK * 2  , STAGE_BYTES = 8 * HTB, NXCD = 8, WGM = 8;

__host__ __device__ __forceinline__ int lds_byte(int r, int c) { const int st = (r >> 4) * 2 + (c >> 5), rr = r & 15, cc = c & 31, ob = rr * 64 + cc * 2; return st * 1024 + (ob ^ (((ob >> 9) & 1) << 5)); }
__host__ __device__ __forceinline__ void stage_rc(int b, int& R, int& C) { const int st = b / 1024, sb = b % 1024, swz = sb ^ (((sb >> 9) & 1) << 5); R = (st >> 1) * 16 + swz / 64; C = (st & 1) * 32 + (swz % 64) / 2; }
__host__ __device__ __forceinline__ int perm32(int rho) { const int n = rho >> 4, i = rho & 15; return 8 * (i >> 2) + 4 * n + (i & 3); }

struct Unit { int pm, pn, po; };
struct Gemm { const bf16_t* A; const bf16_t* Bt; int M, N, K; int sw, sa; };
typedef int i32x8 __attribute__((ext_vector_type(8)));
typedef int i32x4v __attribute__((ext_vector_type(4)));
__device__ __forceinline__ i32x8 cat8(bf16x8 lo, bf16x8 hi) { return __builtin_shufflevector(__builtin_bit_cast(i32x4v, lo), __builtin_bit_cast(i32x4v, hi), 0, 1, 2, 3, 4, 5, 6, 7); }
__device__ __forceinline__ unsigned pk4fp8(f32x4 v) { int w = __builtin_amdgcn_cvt_pk_fp8_f32(v[0], v[1], 0, false); w = __builtin_amdgcn_cvt_pk_fp8_f32(v[2], v[3], w, true); return (unsigned)w; }

struct StaticOrder {
    int nM, nN, nwg, G, c;
    __host__ __device__ void init(int M, int N, int G_, int c_) { nM = M / BM; nN = N / BM; nwg = nM * nN; G = G_; c = c_; }
    __host__ __device__ bool next(int i, Unit& u) const {
        const long L = (long)i * G + c; if (L >= nwg) return false;
        int wgid = (int)L; { const int q = nwg / NXCD, r = nwg % NXCD, xcd = wgid % NXCD, off = wgid / NXCD; wgid = (xcd < r ? xcd * (q + 1) : r * (q + 1) + (xcd - r) * q) + off; }
        const int nig = WGM * nN, gid = wgid / nig, fm = gid * WGM, gsz = (nM - fm) < WGM ? (nM - fm) : WGM;
        u.pm = fm + ((wgid % nig) % gsz); u.pn = (wgid % nig) / gsz; u.po = u.pm; return true;
    }
    __device__ __forceinline__ void a_ready(const Unit&) const {}
    __device__ __forceinline__ void done(const Unit&) const {}
};
struct MoeOrder {
    int pp[9]; int nM, nN, nwg, G, c, astride;
    __device__ __forceinline__ void init(const unsigned* cnt, int NT, int G_, int c_, int astride_) {
        int a = 0;
#pragma unroll
        for (int e = 0; e < 8; ++e) { pp[e] = a; const unsigned n = (unsigned)__builtin_amdgcn_readfirstlane((int)__hip_atomic_load(cnt + e, RLX_AGENT)); a += (int)((n + 255u) >> 8); }
        pp[8] = a; nM = a; nN = NT; nwg = nM * nN; G = G_; c = c_; astride = astride_;
    }
    __device__ __forceinline__ bool next(int i, Unit& u) const {
        const long L = (long)i * G + c; if (L >= nwg) return false;
        int wgid = (int)L; { const int q = nwg / NXCD, r = nwg % NXCD, xcd = wgid % NXCD, off = wgid / NXCD; wgid = (xcd < r ? xcd * (q + 1) : r * (q + 1) + (xcd - r) * q) + off; }
        const int nig = WGM * nN, gid = wgid / nig, fm = gid * WGM, gsz = (nM - fm) < WGM ? (nM - fm) : WGM;
        const int vp = fm + ((wgid % nig) % gsz), t = (wgid % nig) / gsz;
        int e = 0, base = 0;
#pragma unroll
        for (int k = 1; k < 8; ++k) if (vp >= pp[k]) { e = k; base = pp[k]; }
        u.pm = astride ? e * astride + (vp - base) : vp; u.pn = e * nN + t; u.po = vp; return true;
    }
    __device__ __forceinline__ void a_ready(const Unit&) const {}
    __device__ __forceinline__ void done(const Unit&) const {}
};

template <class E> __device__ __forceinline__ void epi_rows(const E& e, const f32x4 (&acc)[2][2][4][2], const Unit& u, int wr, int wc, int fr, int fq) {
    asm volatile("" : "+v"(fr), "+v"(fq));
#pragma unroll
    for (int ai = 0; ai < 2; ++ai)
#pragma unroll
        for (int m = 0; m < 4; ++m) e.row8(u, ai * HALF + wr * 64 + m * 16 + fr, wc * 32 + 8 * fq, acc[ai][0][m][0], acc[ai][0][m][1], acc[ai][1][m][0], acc[ai][1][m][1]);
}
#define PG8_EPI_COMMON static constexpr bool PERM = true, AFTER_DRAIN = false, MID_HOOK = false; \
    __device__ __forceinline__ void operator()(const f32x4 (&acc)[2][2][4][2], const Unit& u, int wr, int wc, int fr, int fq) const { epi_rows(*this, acc, u, wr, wc, fr, fq); }
__device__ __forceinline__ void st8bf(bf16_t* p, f32x4 a, f32x4 b) { u32x4 w; w.x = pk2(a[0], a[1]); w.y = pk2(a[2], a[3]); w.z = pk2(b[0], b[1]); w.w = pk2(b[2], b[3]); *(u32x4*)p = w; }
__device__ __forceinline__ void ld8bf(const bf16_t* p, f32x4& a, f32x4& b) { const u32x4 w = *(const u32x4*)p; a = (f32x4){bflo(w.x), bfhi(w.x), bflo(w.y), bfhi(w.y)}; b = (f32x4){bflo(w.z), bfhi(w.z), bflo(w.w), bfhi(w.w)}; }
__device__ __forceinline__ f32x4 gelu4(f32x4 v) { return (f32x4){gelu_tanh_(v[0]), gelu_tanh_(v[1]), gelu_tanh_(v[2]), gelu_tanh_(v[3])}; }
__device__ __forceinline__ f32x4 sig4(f32x4 v) { return (f32x4){sigmoidf_(v[0]), sigmoidf_(v[1]), sigmoidf_(v[2]), sigmoidf_(v[3])}; }
__device__ __forceinline__ f32x4 silu4(f32x4 v) { return (f32x4){siluf_(v[0]), siluf_(v[1]), siluf_(v[2]), siluf_(v[3])}; }

struct EpiWin { PG8_EPI_COMMON
    unsigned char* R;
    __device__ __forceinline__ void row8(const Unit& u, int r, int cit, f32x4 a0, f32x4 a1, f32x4 b0, f32x4 b1) const {
        const size_t row = (size_t)u.po * BM + r; const int pn = u.pn;
        bf16_t* XR = (bf16_t*)R; bf16_t* GG = (bf16_t*)(R + (32u << 20)); bf16_t* Q = (bf16_t*)(R + (64u << 20)); bf16_t* KB = (bf16_t*)(R + (96u << 20)); bf16_t* VB = (bf16_t*)(R + (104u << 20)); bf16_t* GT = (bf16_t*)(R + (112u << 20));
        if (pn < 4)       { bf16_t* o = XR + row * 1024 + 256 * pn + cit; st8bf(o, a0, a1); st8bf(o + HALF, b0, b1); }
        else if (pn < 8)  { bf16_t* o = GG + row * 1024 + 256 * (pn - 4) + cit; st8bf(o, gelu4(a0), gelu4(a1)); st8bf(o + HALF, gelu4(b0), gelu4(b1)); }
        else if (pn < 12) { bf16_t* o = Q + row * 1024 + 256 * (pn - 8) + cit; st8bf(o, a0 * QSCALE, a1 * QSCALE); st8bf(o + HALF, b0 * QSCALE, b1 * QSCALE); }
        else if (pn == 12) { bf16_t* o = KB + row * 256 + cit; st8bf(o, a0, a1); st8bf(o + HALF, b0, b1); }
        else if (pn == 13) { bf16_t* o = VB + row * 256 + cit; st8bf(o, a0, a1); st8bf(o + HALF, b0, b1); }
        else { bf16_t* o = GT + row * 2048 + 256 * (pn - 14) + cit; st8bf(o, sig4(a0), sig4(a1)); st8bf(o + HALF, sig4(b0), sig4(b1)); }
    }
};
struct EpiMerge {
    static constexpr bool PERM = true, AFTER_DRAIN = false, MID_HOOK = true;
    unsigned char* R;
    __device__ __forceinline__ void operator()(const f32x4 (&acc)[2][2][4][2], const Unit& u, int wr, int wc, int fr, int fq) const { epi_rows(*this, acc, u, wr, wc, fr, fq); }
    __device__ __forceinline__ void mid(f32x4 (&acc)[2][2][4][2], const Unit& u, int wr, int wc, int fr, int fq) const {
        asm volatile("" : "+v"(fr), "+v"(fq));
        const bf16_t* GT = (const bf16_t*)(R + (112u << 20));
#pragma unroll
        for (int ai = 0; ai < 2; ++ai)
#pragma unroll
            for (int m = 0; m < 4; ++m) { const size_t row = (size_t)u.po * BM + ai * HALF + wr * 64 + m * 16 + fr;
#pragma unroll
                for (int bj = 0; bj < 2; ++bj) { const int c = 256 * u.pn + bj * HALF + wc * 32 + 8 * fq; f32x4 g0a, g0b, g1a, g1b; ld8bf(GT + row * 2048 + c, g0a, g0b); ld8bf(GT + row * 2048 + 1024 + c, g1a, g1b);
#pragma unroll
                    for (int i = 0; i < 4; ++i) { acc[ai][bj][m][0][i] *= g0a[i] * frcp(fmaxf(g1a[i], 1e-30f)); acc[ai][bj][m][1][i] *= g0b[i] * frcp(fmaxf(g1b[i], 1e-30f)); } } }
    }
    __device__ __forceinline__ void row8(const Unit& u, int r, int cit, f32x4 a0, f32x4 a1, f32x4 b0, f32x4 b1) const {
        const size_t row = (size_t)u.po * BM + r; const int c = 256 * u.pn + cit;
        const bf16_t* GT = (const bf16_t*)(R + (112u << 20)); bf16_t* MG = (bf16_t*)(R + (304u << 20));
        f32x4 g0, g1; ld8bf(GT + row * 2048 + 1024 + c, g0, g1); st8bf(MG + row * 1024 + c, g0 * a0, g1 * a1);
        ld8bf(GT + row * 2048 + 1024 + c + HALF, g0, g1); st8bf(MG + row * 1024 + c + HALF, g0 * b0, g1 * b1);
    }
};
struct EpiBf16N { PG8_EPI_COMMON
    bf16_t* O;
    __device__ __forceinline__ void row8(const Unit& u, int r, int cit, f32x4 a0, f32x4 a1, f32x4 b0, f32x4 b1) const {
        bf16_t* o = O + ((size_t)u.po * BM + r) * 1024 + 256 * u.pn + cit; st8bf(o, a0, a1); st8bf(o + HALF, b0, b1);
    }
};
struct EpiF32 { PG8_EPI_COMMON
    float* O;
    __device__ __forceinline__ void row8(const Unit& u, int r, int cit, f32x4 a0, f32x4 a1, f32x4 b0, f32x4 b1) const {
        float* o = O + ((size_t)u.po * BM + r) * 1024 + 256 * u.pn + cit; *(f32x4*)o = a0; *(f32x4*)(o + 4) = a1; *(f32x4*)(o + HALF) = b0; *(f32x4*)(o + HALF + 4) = b1;
    }
};
struct EpiSwiglu { PG8_EPI_COMMON
    bf16_t* O; int ldc, ntile;
    __device__ __forceinline__ void row8(const Unit& u, int r, int cit, f32x4 a0, f32x4 a1, f32x4 b0, f32x4 b1) const {
        st8bf(O + ((size_t)u.po * BM + r) * ldc + HALF * (u.pn % ntile) + cit, silu4(a0) * b0, silu4(a1) * b1);
    }
};
struct EpiSwiglu8 { PG8_EPI_COMMON
    unsigned char* O; int ldc, ntile;
    __device__ __forceinline__ void row8(const Unit& u, int r, int cit, f32x4 a0, f32x4 a1, f32x4 b0, f32x4 b1) const {
        u32x2 w; w.x = pk4fp8(silu4(a0) * b0); w.y = pk4fp8(silu4(a1) * b1); *(u32x2*)(O + ((size_t)u.po * BM + r) * ldc + HALF * (u.pn % ntile) + cit) = w;
    }
};
struct EpiBf16Mod4 { PG8_EPI_COMMON
    bf16_t* O;
    __device__ __forceinline__ void row8(const Unit& u, int r, int cit, f32x4 a0, f32x4 a1, f32x4 b0, f32x4 b1) const {
        bf16_t* o = O + ((size_t)u.po * BM + r) * 1024 + 256 * (u.pn & 3) + cit; st8bf(o, a0, a1); st8bf(o + HALF, b0, b1);
    }
};

template <class Epi, class Sched>
__device__ __forceinline__ void gemm_phase_naive(const Gemm g, const Sched& S, const Epi& E) {
    Unit u;
    for (int i = 0; S.next(i, u); ++i) {
        for (int idx = threadIdx.x; idx < 256 * 16; idx += blockDim.x) {
            const int r = idx >> 4, cit = (idx & 15) * 8;
            const bf16_t* a = g.A + ((size_t)u.pm * BM + r) * g.K;
            float o[16];
#pragma unroll
            for (int j = 0; j < 16; ++j) o[j] = 0.f;
            for (int k = 0; k < g.K; k += 8) {
                f32x4 x0, x1; ld8bf(a + k, x0, x1);
#pragma unroll
                for (int j = 0; j < 16; ++j) { const bf16_t* b = g.Bt + ((size_t)u.pn * BM + (j >> 3) * HALF + cit + (j & 7)) * g.K + k; f32x4 y0, y1; ld8bf(b, y0, y1);
                    o[j] += x0[0] * y0[0] + x0[1] * y0[1] + x0[2] * y0[2] + x0[3] * y0[3] + x1[0] * y1[0] + x1[1] * y1[1] + x1[2] * y1[2] + x1[3] * y1[3]; }
            }
            E.row8(u, r, cit, (f32x4){o[0], o[1], o[2], o[3]}, (f32x4){o[4], o[5], o[6], o[7]}, (f32x4){o[8], o[9], o[10], o[11]}, (f32x4){o[12], o[13], o[14], o[15]});
        }
    }
}

template <class Epi, class Sched, bool ALIGN_EPI = false, bool SP2 = false, bool FP8 = false>
__device__ __forceinline__ void gemm_phase(PG8_LAS unsigned char* lds, const Gemm g, const Sched& S, const Epi& E) {
    int tid_ = threadIdx.x; asm volatile("" : "+v"(tid_));
    const int tid = tid_, wid = __builtin_amdgcn_readfirstlane(tid >> 6), lane = tid & 63, wr = wid >> 2, wc = wid & 3, fr = lane & 15, fq = lane >> 4;
    constexpr int ESZ = FP8 ? 1 : 2;
    const int K = g.K, nt = K * ESZ / (BK * 2);
    unsigned voffA[2], voffB[2];
#pragma unroll
    for (int i = 0; i < 2; ++i) { int R, C; stage_rc(tid * 16 + i * 8192, R, C); const int Rb = Epi::PERM ? ((R & ~31) + perm32(R & 31)) : R;
        voffA[i] = (unsigned)(R * K * ESZ + C * 2); voffB[i] = (unsigned)(Rb * K * ESZ + C * 2); }
    const size_t kstep = (size_t)(BK * 2);
    const size_t hstep = (size_t)HALF * K * ESZ;
    const size_t tstep = 2 * hstep;
    const unsigned ldsw = (unsigned)wid * 1024u;
    const int aoff = lds_byte(wr * 64 + fr, FP8 ? fq * 16 : fq * 8), boff = lds_byte(wc * 32 + fr, FP8 ? fq * 16 : fq * 8);
#define PG8_SA(b, h) (((b) * 2 + (h)) * HTB)
#define PG8_SB(b, h) ((4 + (b) * 2 + (h)) * HTB)
#define PG8_STAGE(bufoff, gbase, voff) do { _Pragma("unroll") for (int _i = 0; _i < 2; ++_i) \
        __builtin_amdgcn_global_load_lds((const unsigned*)((const char*)(gbase) + (voff)[_i]), (PG8_LAS unsigned*)(lds + (bufoff) + ldsw + _i * 8192), 16, 0, 0); } while (0)
#define PG8_LDA(dst, b, h) do { _Pragma("unroll") for (int m = 0; m < 4; ++m) { if constexpr (FP8) dst##8[m] = cat8(*(const PG8_LAS bf16x8*)(lds + PG8_SA(b, h) + aoff + m * 2048), *(const PG8_LAS bf16x8*)(lds + PG8_SA(b, h) + aoff + m * 2048 + 16)); \
        else { _Pragma("unroll") for (int k = 0; k < 2; ++k) dst[m][k] = *(const PG8_LAS bf16x8*)(lds + PG8_SA(b, h) + aoff + m * 2048 + k * 1024); } } } while (0)
#define PG8_LDB(dst, b, h) do { _Pragma("unroll") for (int n = 0; n < 2; ++n) { if constexpr (FP8) dst##8[n] = cat8(*(const PG8_LAS bf16x8*)(lds + PG8_SB(b, h) + boff + n * 2048), *(const PG8_LAS bf16x8*)(lds + PG8_SB(b, h) + boff + n * 2048 + 16)); \
        else { _Pragma("unroll") for (int k = 0; k < 2; ++k) dst[n][k] = *(const PG8_LAS bf16x8*)(lds + PG8_SB(b, h) + boff + n * 2048 + k * 1024); } } } while (0)
#define PG8_MMA(ai, bj, At, Bt) do { __builtin_amdgcn_s_setprio(1); _Pragma("unroll") for (int m = 0; m < 4; ++m) _Pragma("unroll") for (int n = 0; n < 2; ++n) { \
        if constexpr (FP8) asm volatile("v_mfma_scale_f32_16x16x128_f8f6f4 %0, %1, %2, %0, %3, %4 op_sel_hi:[0,0,0]" : "+v"(acc[ai][bj][m][n]) : "v"(Bt##8[n]), "v"(At##8[m]), "v"(sw_), "v"(sa_)); \
        else { _Pragma("unroll") for (int k = 0; k < 2; ++k) acc[ai][bj][m][n] = __builtin_amdgcn_mfma_f32_16x16x32_bf16(Bt[n][k], At[m][k], acc[ai][bj][m][n], 0, 0, 0); } } \
        __builtin_amdgcn_s_setprio(0); } while (0)
#define PG8_WAIT_V(n) asm volatile("s_waitcnt vmcnt(" #n ")" ::: "memory")
#define PG8_WAIT_L(n) asm volatile("s_waitcnt lgkmcnt(" #n ")" ::: "memory")
#define PG8_BAR __builtin_amdgcn_s_barrier()
#define PG8_SCHED __builtin_amdgcn_sched_barrier(0)
    Unit cur, nxt; int ui = 0;
    if (!S.next(0, cur)) return;
    f32x4 acc[2][2][4][2];
#pragma unroll
    for (int a = 0; a < 2; ++a)
#pragma unroll
        for (int b = 0; b < 2; ++b)
#pragma unroll
            for (int m = 0; m < 4; ++m)
#pragma unroll
                for (int n = 0; n < 2; ++n) acc[a][b][m][n] = (f32x4){0.f, 0.f, 0.f, 0.f};
    const int sw_ = g.sw, sa_ = g.sa;
    bf16x8 At[4][2], B0[2][2], B1[2][2]; i32x8 At8[4], B08[2], B18[2];
    const char* cA = (const char*)g.A + (size_t)cur.pm * tstep; const char* cB = (const char*)g.Bt + (size_t)cur.pn * tstep;
    S.a_ready(cur);
    if constexpr (SP2) {
        PG8_STAGE(PG8_SB(0, 0), cB, voffB); PG8_STAGE(PG8_SB(0, 1), cB + hstep, voffB); PG8_STAGE(PG8_SA(0, 0), cA, voffA); PG8_STAGE(PG8_SA(0, 1), cA + hstep, voffA);
        if (wr == 1) PG8_BAR;
        PG8_WAIT_V(2); PG8_BAR;
        PG8_STAGE(PG8_SB(1, 0), cB + kstep, voffB); PG8_STAGE(PG8_SA(1, 0), cA + kstep, voffA); PG8_STAGE(PG8_SB(1, 1), cB + hstep + kstep, voffB);
        PG8_WAIT_V(6); PG8_BAR;
    } else {
        PG8_STAGE(PG8_SB(0, 0), cB, voffB); PG8_STAGE(PG8_SA(0, 0), cA, voffA); PG8_STAGE(PG8_SB(0, 1), cB + hstep, voffB); PG8_STAGE(PG8_SA(0, 1), cA + hstep, voffA);
        if (wr == 1) PG8_BAR;
        PG8_WAIT_V(4); PG8_BAR;
        PG8_STAGE(PG8_SB(1, 0), cB + kstep, voffB); PG8_STAGE(PG8_SA(1, 0), cA + kstep, voffA); PG8_STAGE(PG8_SB(1, 1), cB + hstep + kstep, voffB);
        PG8_WAIT_V(6); PG8_BAR;
    }
    for (;;) {
        const bool has_next = S.next(ui + 1, nxt);
        const char* nA = has_next ? (const char*)g.A + (size_t)nxt.pm * tstep : cA; const char* nB = has_next ? (const char*)g.Bt + (size_t)nxt.pn * tstep : cB;
        for (int t = 0; t < nt; t += 2) {
            if constexpr (Epi::MID_HOOK && HOOK_ON) { if (t == (nt >> 1)) E.mid(acc, cur, wr, wc, fr, fq); }
            const bool last = (t == nt - 2);
            const char* a1 = cA + (size_t)(t + 1) * kstep;
            const char* a2 = last ? nA : cA + (size_t)(t + 2) * kstep; const char* b2 = last ? nB : cB + (size_t)(t + 2) * kstep;
            const char* a3 = a2 + kstep; const char* b3 = b2 + kstep;
            if (last && has_next) S.a_ready(nxt);
            if constexpr (SP2) {
            PG8_LDB(B0, 0, 0); PG8_LDB(B1, 0, 1); PG8_SCHED; PG8_LDA(At, 0, 0); PG8_STAGE(PG8_SA(1, 1), a1 + hstep, voffA);
            PG8_WAIT_V(8); PG8_WAIT_L(0); PG8_BAR; PG8_MMA(0, 0, At, B0); PG8_MMA(0, 1, At, B1); PG8_BAR; PG8_SCHED;
            PG8_LDA(At, 0, 1); PG8_STAGE(PG8_SB(0, 0), b2, voffB); PG8_STAGE(PG8_SB(0, 1), b2 + hstep, voffB); PG8_STAGE(PG8_SA(0, 0), a2, voffA);
            PG8_WAIT_V(8); PG8_WAIT_L(0); PG8_BAR; PG8_MMA(1, 0, At, B0); PG8_MMA(1, 1, At, B1); PG8_BAR; PG8_SCHED;
            PG8_LDB(B0, 1, 0); PG8_LDB(B1, 1, 1); PG8_SCHED; PG8_LDA(At, 1, 0); PG8_STAGE(PG8_SA(0, 1), a2 + hstep, voffA);
            PG8_WAIT_V(8); PG8_WAIT_L(0); PG8_BAR; PG8_MMA(0, 0, At, B0); PG8_MMA(0, 1, At, B1); PG8_BAR; PG8_SCHED;
            PG8_LDA(At, 1, 1); PG8_STAGE(PG8_SB(1, 0), b3, voffB); PG8_STAGE(PG8_SB(1, 1), b3 + hstep, voffB); PG8_STAGE(PG8_SA(1, 0), a3, voffA);
            PG8_WAIT_V(8); PG8_WAIT_L(0); PG8_BAR; PG8_MMA(1, 0, At, B0); PG8_MMA(1, 1, At, B1); PG8_BAR; PG8_SCHED;
            } else {
            PG8_LDB(B0, 0, 0); PG8_SCHED; PG8_LDA(At, 0, 0); PG8_STAGE(PG8_SA(1, 1), a1 + hstep, voffA);
            PG8_WAIT_L(8); PG8_BAR; PG8_WAIT_L(0); PG8_MMA(0, 0, At, B0); PG8_BAR; PG8_SCHED;
            PG8_LDB(B1, 0, 1); PG8_STAGE(PG8_SB(0, 0), b2, voffB);
            PG8_BAR; PG8_WAIT_L(0); PG8_MMA(0, 1, At, B1); PG8_BAR;
            PG8_LDA(At, 0, 1); PG8_STAGE(PG8_SA(0, 0), a2, voffA);
            PG8_BAR; PG8_WAIT_L(0); PG8_MMA(1, 0, At, B0); PG8_BAR; PG8_SCHED;
            PG8_STAGE(PG8_SB(0, 1), b2 + hstep, voffB);
            PG8_WAIT_V(6); PG8_BAR; PG8_MMA(1, 1, At, B1); PG8_BAR;
            PG8_LDB(B0, 1, 0); PG8_SCHED; PG8_LDA(At, 1, 0); PG8_STAGE(PG8_SA(0, 1), a2 + hstep, voffA);
            PG8_WAIT_L(8); PG8_BAR; PG8_WAIT_L(0); PG8_MMA(0, 0, At, B0); PG8_BAR; PG8_SCHED;
            PG8_LDB(B1, 1, 1); PG8_STAGE(PG8_SB(1, 0), b3, voffB);
            PG8_BAR; PG8_WAIT_L(0); PG8_MMA(0, 1, At, B1); PG8_BAR;
            PG8_LDA(At, 1, 1); PG8_STAGE(PG8_SA(1, 0), a3, voffA);
            PG8_BAR; PG8_WAIT_L(0); PG8_MMA(1, 0, At, B0); PG8_BAR; PG8_SCHED;
            PG8_STAGE(PG8_SB(1, 1), b3 + hstep, voffB);
            PG8_WAIT_V(6); PG8_BAR; PG8_MMA(1, 1, At, B1); PG8_BAR;
            }
        }
        if constexpr (ALIGN_EPI) { if (wr == 0) PG8_BAR; }
        if constexpr (FP8) asm volatile("s_nop 15\n\ts_nop 15" ::: "memory");
        if constexpr (!Epi::AFTER_DRAIN) { E(acc, cur, wr, wc, fr, fq); S.done(cur); }
        if (!has_next) break;
#pragma unroll
        for (int a = 0; a < 2; ++a)
#pragma unroll
            for (int b = 0; b < 2; ++b)
#pragma unroll
                for (int m = 0; m < 4; ++m)
#pragma unroll
                    for (int n = 0; n < 2; ++n) acc[a][b][m][n] = (f32x4){0.f, 0.f, 0.f, 0.f};
        cur = nxt; cA = nA; cB = nB; ++ui;
        if constexpr (ALIGN_EPI) { if (wr == 1) PG8_BAR; }
    }
    PG8_WAIT_V(0);
    if constexpr (!ALIGN_EPI) { if (wr == 0) PG8_BAR; }
    PG8_BAR;
    if constexpr (Epi::AFTER_DRAIN) { E.fused(acc, cur, wr, wc, fr, fq, lds, wid, lane); S.done(cur); }
#undef PG8_SA
#undef PG8_SB
#undef PG8_STAGE
#undef PG8_LDA
#undef PG8_LDB
#undef PG8_MMA
#undef PG8_WAIT_V
#undef PG8_WAIT_L
#undef PG8_BAR
#undef PG8_SCHED
}
}

constexpr int NWAVES = 8;
constexpr size_t MiB = 1u << 20;
constexpr size_t WS_CTL = 0, CTL_ZERO_BYTES = 1 * MiB;
constexpr size_t WS_ADA = 1 * MiB;
constexpr size_t WS_RAGG = 2 * MiB;
constexpr size_t WS_MIX = 288 * MiB; constexpr size_t WS_T16 = WS_MIX;
constexpr size_t WS_TOK = 3 * MiB;
constexpr size_t WS_WL = 4 * MiB, WL_STRIDE = 18 * MiB;
constexpr size_t WL_WIN = 0, WL_WB = 11 * MiB, WL_WO = 15 * MiB, WL_WRA = 17 * MiB, WL_WRX = 17 * MiB + 256 * 1024;
constexpr size_t WS_WD = 76 * MiB, WD_STRIDE = 18 * MiB;
constexpr size_t WD_FIN = 0, WD_FOUT = 12 * MiB;
constexpr size_t WS_WM = 112 * MiB, WM_STRIDE = 72 * MiB;
constexpr size_t WM_MIN = 0, WM_MOUT = 48 * MiB;
constexpr size_t WS_XN = 256 * MiB;
constexpr size_t WS_R = 352 * MiB;
constexpr size_t WS_XR = WS_R, WS_GG = WS_R + 32 * MiB, WS_Q = WS_R + 64 * MiB, WS_KB = WS_R + 96 * MiB, WS_VB = WS_R + 104 * MiB, WS_GT = WS_R + 112 * MiB;
constexpr size_t WS_RO = WS_R + 176 * MiB, WS_AO = WS_R + 208 * MiB, WS_MGP = WS_R + 240 * MiB, WS_MG = WS_R + 304 * MiB;
constexpr size_t WS_PS = WS_MGP;
constexpr size_t WS_XC = WS_MG;
constexpr size_t WS_ACT = WS_R;
constexpr size_t WS_AP = WS_R;
constexpr size_t WS_YP = WS_R;
constexpr size_t WS_ACTP = WS_R + 256 * MiB;
constexpr size_t WS_XB = WS_ACTP + 102 * MiB;
constexpr size_t WS_END = WS_XB + 32 * MiB;
constexpr int MAXPANELS = 136;

constexpr int CW_CNT = 64;
constexpr int CW_BAR = 4096;

constexpr int RING_OFF = 0, RING_BYTES = 139264;
constexpr int LDSCTL_OFF = RING_BYTES, MISC_OFF = LDSCTL_OFF + 320;
constexpr int LDS_BYTES = 147456;

#define XB_TMO      128
#define XB_XCNT(j)  (256  + 64 * (j))
#define XB_XSUB(j)  (1280 + 64 * (j))
#define XB_XGEN(j)  (2304 + 64 * (j))
#define XB_TOP      3328
#define XB_TOPGEN   3392
#define XCD_BAR_WORDS 3456
#define XB_SPIN_CAP (1u << 18)

__device__ __forceinline__ unsigned xb_ld(unsigned* p)              { return __hip_atomic_load(p, __ATOMIC_RELAXED, __HIP_MEMORY_SCOPE_AGENT); }
__device__ __forceinline__ unsigned xb_add(unsigned* p, unsigned v) { return __hip_atomic_fetch_add(p, v, __ATOMIC_RELAXED, __HIP_MEMORY_SCOPE_AGENT); }
__device__ __forceinline__ unsigned xb_xcc_id() { return (unsigned)__builtin_amdgcn_s_getreg((3 << 11) | 20) & 0xFu; }
#define XB_SPIN(cond, bar) do { unsigned _sp = 0; while (cond) { __builtin_amdgcn_s_sleep(1); \
    if ((++_sp & 255u) == 0u) { if (xb_ld(&(bar)[XB_TMO])) break; if (_sp > XB_SPIN_CAP) { atomicAdd(&(bar)[XB_TMO], 1u); break; } } } } while (0)

struct XcdBarrier {
    unsigned* bar; unsigned x;
    volatile LAS unsigned* st;
};

__device__ __forceinline__ XcdBarrier xcd_barrier_post(unsigned* bar, volatile LAS unsigned* st) {
    XcdBarrier b; b.bar = bar; b.x = xb_xcc_id(); b.st = st;
    if (threadIdx.x == 0) (void)xb_add(&bar[XB_XCNT(b.x)], 1u);
    return b;
}
__device__ __forceinline__ void xcd_barrier_complete(unsigned* bar, unsigned x, unsigned& nloc, unsigned& nx) {
    const unsigned G = gridDim.x * gridDim.y * gridDim.z;
    unsigned sum, cnt, mine, sp = 0u;
    for (;;) {
        sum = 0u; cnt = 0u; mine = 0u;
#pragma unroll
        for (unsigned j = 0; j < 16; ++j) { const unsigned c = xb_ld(&bar[XB_XCNT(j)]); sum += c; cnt += (c > 0u) ? 1u : 0u; mine = (j == x) ? c : mine; }
        if (sum == G) break;
        __builtin_amdgcn_s_sleep(1);
        if ((++sp & 255u) == 0u) { if (xb_ld(&bar[XB_TMO])) break; if (sp > XB_SPIN_CAP) { atomicAdd(&bar[XB_TMO], 1u); break; } }
    }
    nloc = mine > 0u ? mine : 1u; nx = cnt > 0u ? cnt : 1u;
}

__device__ __forceinline__ void xcd_barrier(const XcdBarrier& b) {
    asm volatile("s_waitcnt vmcnt(0)" ::: "memory");
    __syncthreads();
    if (threadIdx.x == 0) {
        unsigned* bar = b.bar;
        __builtin_amdgcn_s_waitcnt(0);
        unsigned nloc = b.st[0], nx = b.st[1];
        if (nloc == 0u) { xcd_barrier_complete(bar, b.x, nloc, nx); b.st[0] = nloc; b.st[1] = nx; }
        const unsigned old = xb_add(&bar[XB_XSUB(b.x)], 1u);
        const unsigned gen = old / nloc;
        if (old + 1u == (gen + 1u) * nloc) {
            __builtin_amdgcn_fence(__ATOMIC_RELEASE, "agent");
            asm volatile("s_waitcnt vmcnt(0)" ::: "memory");
            const unsigned og = xb_add(&bar[XB_TOP], 1u);
            const unsigned tg = og / nx;
            if (og + 1u == (tg + 1u) * nx) xb_add(&bar[XB_TOPGEN], 1u);
            else XB_SPIN(xb_ld(&bar[XB_TOPGEN]) == tg, bar);
            __builtin_amdgcn_fence(__ATOMIC_ACQUIRE, "agent");
            xb_add(&bar[XB_XGEN(b.x)], 1u);
            asm volatile("s_waitcnt vmcnt(0)" ::: "memory");
        } else {
            XB_SPIN(xb_ld(&bar[XB_XGEN(b.x)]) == gen, bar);
            __builtin_amdgcn_fence(__ATOMIC_ACQUIRE, "agent");
            asm volatile("s_waitcnt vmcnt(0)" ::: "memory");
        }
    }
    __syncthreads();
}
struct Args { const float* in[24]; float* out; unsigned char* ws; int ph_lo, ph_hi; };
typedef const __attribute__((address_space(4))) unsigned char* kargp_t;
DI kargp_t kargs() { kargp_t p = (kargp_t)__builtin_amdgcn_kernarg_segment_ptr(); asm volatile("" : "+s"(p)); return p; }
DI const float* karg_in(kargp_t p, int i) { return *(const float* const __attribute__((address_space(4)))*)(p + 8 * i); }
DI float* karg_out(kargp_t p) { return *(float* const __attribute__((address_space(4)))*)(p + 192); }
DI unsigned char* karg_ws(kargp_t p) { return *(unsigned char* const __attribute__((address_space(4)))*)(p + 200); }
static_assert(sizeof(Args) == 216, "kernarg offsets");

DI void p0_transpose_item(const float* W, int K, int N, bf16* WT, int mode, int H, LAS float* scr, int item, int lane, int ldk = 0) {
    if (ldk == 0) ldk = K;
    const int nblk = N / 32, kb = item / nblk, nb = item % nblk, k0 = 64 * kb, n0 = 32 * nb;
    int dr0 = n0;
    if (mode == 1) { if (n0 < H) dr0 = (n0 >> 7) * 256 + (n0 & 127); else { const int n1 = n0 - H; dr0 = (n1 >> 7) * 256 + 128 + (n1 & 127); } }
#pragma unroll 8
    for (int i = 0; i < 32; ++i) { const int kk = 2 * i + (lane >> 5); scr[kk * 33 + (lane & 31)] = W[(size_t)(k0 + kk) * N + n0 + (lane & 31)]; }
    LDS_WAIT(); asm volatile("" ::: "memory");
    const int c = lane & 7;
#pragma unroll
    for (int j = 0; j < 4; ++j) { const int n = (lane >> 3) + 8 * j; const LAS float* s = scr + (8 * c) * 33 + n;
        u32x4 o; o.x = pk2(s[0 * 33], s[1 * 33]); o.y = pk2(s[2 * 33], s[3 * 33]); o.z = pk2(s[4 * 33], s[5 * 33]); o.w = pk2(s[6 * 33], s[7 * 33]);
        *(GAS u32x4*)(WT + (size_t)(dr0 + n) * ldk + k0 + 8 * c) = o; }
    LDS_WAIT(); asm volatile("" ::: "memory");
}
DI void p0_transpose_item8(const float* W, int K, int N, unsigned char* WT, int mode, int H, float mult, LAS float* scr, int item, int lane) {
    const int nblk = N / 32, kb = item / nblk, nb = item % nblk, k0 = 64 * kb, n0 = 32 * nb;
    int dr0 = n0;
    if (mode == 1) { if (n0 < H) dr0 = (n0 >> 7) * 256 + (n0 & 127); else { const int n1 = n0 - H; dr0 = (n1 >> 7) * 256 + 128 + (n1 & 127); } }
#pragma unroll 8
    for (int i = 0; i < 32; ++i) { const int kk = 2 * i + (lane >> 5); scr[kk * 33 + (lane & 31)] = W[(size_t)(k0 + kk) * N + n0 + (lane & 31)] * mult; }
    LDS_WAIT(); asm volatile("" ::: "memory");
#pragma unroll
    for (int j = 0; j < 2; ++j) { const int idx = lane + 64 * j, n = idx >> 2, c = idx & 3; const LAS float* s = scr + (16 * c) * 33 + n;
        u32x4 o;
        o.x = pg8::pk4fp8((f32x4){s[0 * 33], s[1 * 33], s[2 * 33], s[3 * 33]}); o.y = pg8::pk4fp8((f32x4){s[4 * 33], s[5 * 33], s[6 * 33], s[7 * 33]});
        o.z = pg8::pk4fp8((f32x4){s[8 * 33], s[9 * 33], s[10 * 33], s[11 * 33]}); o.w = pg8::pk4fp8((f32x4){s[12 * 33], s[13 * 33], s[14 * 33], s[15 * 33]});
        *(GAS u32x4*)(WT + (size_t)(dr0 + n) * K + k0 + 16 * c) = o; }
    LDS_WAIT(); asm volatile("" ::: "memory");
}
constexpr int CI_WIN = 16 * 176, CI_SQ = 16 * 32, CI_RG = 64, CI_LAYER = CI_WIN + 3 * CI_SQ + 2 * CI_RG;
constexpr int CI_FIN = 16 * 192, CI_FOUT = 48 * 32, CI_DENSE = CI_FIN + CI_FOUT;
constexpr int CI_MIN = 16 * 96, CI_MOUT = 24 * 32, CI_EXP = CI_MIN + CI_MOUT, CI_MOE = 8 * CI_EXP;
constexpr int CI_TOTAL = 4 * CI_LAYER + 2 * CI_DENSE + 2 * CI_MOE;
DI void p0_convert_item(kargp_t kp, int it, LAS float* scr, int lane) {
    unsigned char* ws = karg_ws(kp);
    if (it < 4 * CI_LAYER) {
        const int l = it / CI_LAYER; int r = it % CI_LAYER; unsigned char* wl = ws + WS_WL + (size_t)l * WL_STRIDE;
        if (r < CI_WIN) { p0_transpose_item(karg_in(kp, 8) + (size_t)l * 1024 * D_IN, 1024, D_IN, (bf16*)(wl + WL_WIN), 0, 0, scr, r, lane); return; } r -= CI_WIN;
        if (r < 2 * CI_SQ) { const int br = r / CI_SQ; p0_transpose_item(karg_in(kp, 17) + (size_t)(l * 2 + br) * 1024 * 1024, 1024, 1024, (bf16*)(wl + WL_WB) + (size_t)br * 1024, 0, 0, scr, r % CI_SQ, lane, 2048); return; }   r -= 2 * CI_SQ;
        if (r < CI_SQ) { p0_transpose_item(karg_in(kp, 18) + (size_t)l * 1024 * 1024, 1024, 1024, (bf16*)(wl + WL_WO), 0, 0, scr, r, lane); return; } r -= CI_SQ;
        if (r < CI_RG) { const int nb = r >> 3; p0_transpose_item(karg_in(kp, 11) + (size_t)(l * 8 + nb) * 16384, 128, 128, (bf16*)(wl + WL_WRA) + nb * 16384, 0, 0, scr, r & 7, lane); return; } r -= CI_RG;
        { const int nb = r >> 3; p0_transpose_item(karg_in(kp, 13) + (size_t)(l * 8 + nb) * 16384, 128, 128, (bf16*)(wl + WL_WRX) + nb * 16384, 0, 0, scr, r & 7, lane); return; }
    }
    it -= 4 * CI_LAYER;
    if (it < 2 * CI_DENSE) {
        const int j = it / CI_DENSE; int r = it % CI_DENSE; unsigned char* wd = ws + WS_WD + (size_t)j * WD_STRIDE;
        const bool f8 = (FP8_LAYERS >> (2 * j)) & 1u;
        if (r < CI_FIN) { if (f8) p0_transpose_item8(karg_in(kp, 19) + (size_t)j * 1024 * 6144, 1024, 6144, wd + WD_FIN, 1, 3072, 32.0f, scr, r, lane); else p0_transpose_item(karg_in(kp, 19) + (size_t)j * 1024 * 6144, 1024, 6144, (bf16*)(wd + WD_FIN), 1, 3072, scr, r, lane); return; } r -= CI_FIN;
        if (f8) p0_transpose_item8(karg_in(kp, 20) + (size_t)j * 3072 * 1024, 3072, 1024, wd + WD_FOUT, 0, 0, 64.0f, scr, r, lane); else p0_transpose_item(karg_in(kp, 20) + (size_t)j * 3072 * 1024, 3072, 1024, (bf16*)(wd + WD_FOUT), 0, 0, scr, r, lane); return;
    }
    it -= 2 * CI_DENSE;
    {
        const int j = it / CI_MOE; int r = it % CI_MOE; const int e = r / CI_EXP; r %= CI_EXP; unsigned char* wm = ws + WS_WM + (size_t)j * WM_STRIDE;
        const bool f8 = (FP8_LAYERS >> (2 * j + 1)) & 1u;
        if (r < CI_MIN) { if (f8) p0_transpose_item8(karg_in(kp, 22) + (size_t)(j * 8 + e) * 1024 * 3072, 1024, 3072, wm + WM_MIN + (size_t)e * 3072 * 1024, 1, 1536, 32.0f, scr, r, lane); else p0_transpose_item(karg_in(kp, 22) + (size_t)(j * 8 + e) * 1024 * 3072, 1024, 3072, (bf16*)(wm + WM_MIN) + (size_t)e * 3072 * 1024, 1, 1536, scr, r, lane); return; } r -= CI_MIN;
        if (f8) p0_transpose_item8(karg_in(kp, 23) + (size_t)(j * 8 + e) * 1536 * 1024, 1536, 1024, wm + WM_MOUT + (size_t)e * 1024 * 1536, 0, 0, 32.0f, scr, r, lane); else p0_transpose_item(karg_in(kp, 23) + (size_t)(j * 8 + e) * 1536 * 1024, 1536, 1024, (bf16*)(wm + WM_MOUT) + (size_t)e * 1024 * 1536, 0, 0, scr, r, lane);
    }
}
DI void p0_prologue(LAS unsigned char* lds, int tid, int wave, int lane) {
    const kargp_t kp = kargs();
    LAS float* cact = (LAS float*)lds; LAS float* red = (LAS float*)(lds + 8192);
    float* ADA = (float*)(karg_ws(kp) + WS_ADA);
    for (int i = tid; i < 2 * D; i += NWAVES * 64) { const float c = karg_in(kp, 1)[i]; cact[i] = c / (1.0f + expf(-c)); }
    __syncthreads();
    const int col = tid & 63, ks = tid >> 6;
    for (int it = blockIdx.x; it < 4 * 96; it += gridDim.x) {
        const int l = it / 96, n0 = (it % 96) * 64;
        const float* w = karg_in(kp, 2) + (size_t)l * 1024 * 6144 + (size_t)(ks * 128) * 6144 + n0 + col;
        float s0 = 0.f, s1 = 0.f;
#pragma unroll 8
        for (int k = 0; k < 128; ++k) { const float wv = w[(size_t)k * 6144]; s0 += cact[ks * 128 + k] * wv; s1 += cact[1024 + ks * 128 + k] * wv; }
        red[(ks * 2 + 0) * 64 + col] = s0; red[(ks * 2 + 1) * 64 + col] = s1;
        __syncthreads();
        if (tid < 128) { const int b = tid >> 6, c2 = tid & 63; float s = karg_in(kp, 3)[l * 6144 + n0 + c2];
#pragma unroll
            for (int k2 = 0; k2 < 8; ++k2) s += red[(k2 * 2 + b) * 64 + c2];
            ADA[(l * 2 + b) * 6144 + n0 + c2] = s; }
        __syncthreads();
    }
    __syncthreads();
    LAS float* scr = (LAS float*)(lds + wave * 16384);
    const int gw = blockIdx.x * NWAVES + wave, NGW = gridDim.x * NWAVES;
    for (int it = gw; it < CI_TOTAL; it += NGW) p0_convert_item(kp, it, scr, lane);
}

DI float row_ss(const f32x4 (&v)[4]) { float s = 0.f;
#pragma unroll
    for (int j = 0; j < 4; ++j) s += (v[j].x * v[j].x + v[j].y * v[j].y) + (v[j].z * v[j].z + v[j].w * v[j].w);
    return wave_sum(s); }
DI void ld_row(const float* p, int lane, f32x4 (&v)[4]) {
#pragma unroll
    for (int j = 0; j < 4; ++j) v[j] = *(const f32x4*)(p + 256 * j + 4 * lane); }
DI void st_row(float* p, int lane, const f32x4 (&v)[4]) {
#pragma unroll
    for (int j = 0; j < 4; ++j) *(f32x4*)(p + 256 * j + 4 * lane) = v[j]; }
DI void st_row_f8(unsigned char* p, int lane, const f32x4 (&v)[4]) {
#pragma unroll
    for (int j = 0; j < 4; ++j) *(unsigned*)(p + 256 * j + 4 * lane) = pg8::pk4fp8(v[j]); }
DI void st_row_bf(bf16* p, int lane, const f32x4 (&v)[4]) {
#pragma unroll
    for (int j = 0; j < 4; ++j) { u32x2 w; w.x = pk2(v[j].x, v[j].y); w.y = pk2(v[j].z, v[j].w); *(u32x2*)(p + 256 * j + 4 * lane) = w; } }
DI void ld_row_bfraw(const bf16* p, int lane, u32x2 (&w)[4]) {
#pragma unroll
    for (int j = 0; j < 4; ++j) w[j] = *(const u32x2*)(p + 256 * j + 4 * lane); }
DI void cvt_row_bf(const u32x2 (&w)[4], f32x4 (&v)[4]) {
#pragma unroll
    for (int j = 0; j < 4; ++j) v[j] = (f32x4){bflo(w[j].x), bfhi(w[j].x), bflo(w[j].y), bfhi(w[j].y)}; }
DI void ld_row_bf(const bf16* p, int lane, f32x4 (&v)[4]) {
#pragma unroll
    for (int j = 0; j < 4; ++j) { const u32x2 w = *(const u32x2*)(p + 256 * j + 4 * lane); v[j] = (f32x4){bflo(w.x), bfhi(w.x), bflo(w.y), bfhi(w.y)}; } }

DI void thin_start(int wave, int lane) {
    const kargp_t kp = kargs(); unsigned char* ws = karg_ws(kp);
    const float* ADA = (const float*)(ws + WS_ADA); bf16* XN = (bf16*)(ws + WS_XN);
    const int NGW = gridDim.x * NWAVES, gw = blockIdx.x * NWAVES + wave;
    for (int base = gw * 8; base < M; base += NGW * 8) {
        const int b = base >> 13; const float* ada = ADA + (size_t)b * 6144;
        f32x4 g[4], sc[4], sh[4]; ld_row(karg_in(kp, 4), lane, g); ld_row(ada + 1024, lane, sc); ld_row(ada, lane, sh);
#pragma unroll
        for (int j = 0; j < 4; ++j) sc[j] = g[j] * (sc[j] + 1.0f);
        const float* xin = karg_in(kp, 0);
        f32x4 xn[4]; ld_row(xin + (size_t)base * D, lane, xn);
#pragma unroll
        for (int i = 0; i < 8; ++i) { const size_t m = (size_t)(base + i);
            f32x4 x[4];
#pragma unroll
            for (int j = 0; j < 4; ++j) x[j] = xn[j];
            if (i < 7) ld_row(xin + (m + 1) * D, lane, xn);
            const float rs = rsqrtf(row_ss(x) * (1.0f / D) + EPS);
#pragma unroll
            for (int j = 0; j < 4; ++j) x[j] = x[j] * rs * sc[j] + sh[j];
            st_row_bf(XN + m * D, lane, x); }
    }
}
DI void thin_mid_dense(int l, int wave, int lane) {
    const kargp_t kp = kargs(); unsigned char* ws = karg_ws(kp); bf16* XB = (bf16*)(ws + WS_XB);
    const float* ADA = (const float*)(ws + WS_ADA); bf16* XN = (bf16*)(ws + WS_XN); const bf16* MIX = (const bf16*)(ws + WS_MIX);
    const float* xin = karg_in(kp, 0); const bool l0 = (l == 0);
    const int NGW = gridDim.x * NWAVES, gw = blockIdx.x * NWAVES + wave;
    for (int base = gw * 8; base < M; base += NGW * 8) {
        const int b = base >> 13; const float* ada = ADA + (size_t)(l * 2 + b) * 6144;
        f32x4 pg[4], fg[4], fs[4], t[4];
        ld_row(karg_in(kp, 5) + l * D, lane, pg); ld_row(ada + 2048, lane, t);
#pragma unroll
        for (int j = 0; j < 4; ++j) pg[j] = pg[j] * t[j];
        ld_row(karg_in(kp, 6) + l * D, lane, fg); ld_row(ada + 4096, lane, t); ld_row(ada + 3072, lane, fs);
#pragma unroll
        for (int j = 0; j < 4; ++j) fg[j] = fg[j] * (t[j] + 1.0f);
        u32x2 yn[4], xr[4]; f32x4 xn[4]; ld_row_bfraw(MIX + (size_t)base * D, lane, yn); if (l0) ld_row(xin + (size_t)base * D, lane, xn); else ld_row_bfraw(XB + (size_t)base * D, lane, xr);
#pragma unroll
        for (int i = 0; i < 8; ++i) { const size_t m = (size_t)(base + i);
            f32x4 y[4], x[4]; cvt_row_bf(yn, y);
            if (l0) {
#pragma unroll
                for (int j = 0; j < 4; ++j) x[j] = xn[j];
            } else cvt_row_bf(xr, x);
            if (i < 7) { ld_row_bfraw(MIX + (m + 1) * D, lane, yn); if (l0) ld_row(xin + (m + 1) * D, lane, xn); else ld_row_bfraw(XB + (m + 1) * D, lane, xr); }
            const float rs = rsqrtf(row_ss(y) * (1.0f / D) + EPS);
#pragma unroll
            for (int j = 0; j < 4; ++j) x[j] = x[j] + pg[j] * (y[j] * rs);
            st_row_bf(XB + m * D, lane, x);
            const float rs2 = rsqrtf(row_ss(x) * (1.0f / D) + EPS);
#pragma unroll
            for (int j = 0; j < 4; ++j) x[j] = x[j] * rs2 * fg[j] + fs[j];
            if ((FP8_LAYERS >> l) & 1u) st_row_f8((unsigned char*)XN + m * D, lane, x); else st_row_bf(XN + m * D, lane, x); }
    }
}
DI void thin_mid_moe(LAS unsigned char* lds, int l, int tid, int wave, int lane) {
    const kargp_t kp = kargs(); unsigned char* ws = karg_ws(kp); bf16* XB = (bf16*)(ws + WS_XB);
    const float* ADA = (const float*)(ws + WS_ADA); const bf16* MIX = (const bf16*)(ws + WS_MIX);
    unsigned char* AP = ws + WS_AP; int* TOK = (int*)(ws + WS_TOK);
    unsigned* cntg = (unsigned*)(ws + WS_CTL) + CW_CNT + 64 * (l >> 1);
    const float* wr = karg_in(kp, 21) + (size_t)(l >> 1) * D * NE;
    LAS float* RT = (LAS float*)lds;
    LAS unsigned* cntL = (LAS unsigned*)(lds + 32768);
    for (int i = tid; i < D * NE; i += NWAVES * 64) RT[i] = wr[i];
    for (int rb = blockIdx.x; rb < M / 64; rb += gridDim.x) {
        if (tid < 16) cntL[tid] = 0u;
        __syncthreads();
        const int base = rb * 64 + wave * 8; const int b = base >> 13; const float* ada = ADA + (size_t)(l * 2 + b) * 6144;
        f32x4 pg[4], fg[4], fs[4], t[4];
        ld_row(karg_in(kp, 5) + l * D, lane, pg); ld_row(ada + 2048, lane, t);
#pragma unroll
        for (int j = 0; j < 4; ++j) pg[j] = pg[j] * t[j];
        ld_row(karg_in(kp, 6) + l * D, lane, fg); ld_row(ada + 4096, lane, t); ld_row(ada + 3072, lane, fs);
#pragma unroll
        for (int j = 0; j < 4; ++j) fg[j] = fg[j] * (t[j] + 1.0f);
        int e0s[8], e1s[8], lp0[8], lp1[8]; float w0s[8], rs2s[8];
        u32x2 yn[4], xr[4]; ld_row_bfraw(MIX + (size_t)base * D, lane, yn); ld_row_bfraw(XB + (size_t)base * D, lane, xr);
#pragma unroll
        for (int i = 0; i < 8; ++i) { const size_t m = (size_t)(base + i);
            f32x4 y[4], x[4]; cvt_row_bf(yn, y);
            cvt_row_bf(xr, x);
            if (i < 7) { ld_row_bfraw(MIX + (m + 1) * D, lane, yn); ld_row_bfraw(XB + (m + 1) * D, lane, xr); }
            const float rs = rsqrtf(row_ss(y) * (1.0f / D) + EPS);
#pragma unroll
            for (int j = 0; j < 4; ++j) x[j] = x[j] + pg[j] * (y[j] * rs);
            st_row_bf(XB + m * D, lane, x);
            const float rs2 = rsqrtf(row_ss(x) * (1.0f / D) + EPS);
            float lg[8];
#pragma unroll
            for (int e = 0; e < 8; ++e) lg[e] = 0.f;
#pragma unroll
            for (int j = 0; j < 4; ++j) { x[j] = x[j] * rs2 * fg[j] + fs[j];
#pragma unroll
                for (int q = 0; q < 4; ++q) { const LAS f32x4* tr = (const LAS f32x4*)(RT + (256 * j + 4 * lane + q) * 8); const f32x4 t0 = tr[0], t1 = tr[1]; const float hv = x[j][q];
                    lg[0] += hv * t0.x; lg[1] += hv * t0.y; lg[2] += hv * t0.z; lg[3] += hv * t0.w; lg[4] += hv * t1.x; lg[5] += hv * t1.y; lg[6] += hv * t1.z; lg[7] += hv * t1.w; } }
#pragma unroll
            for (int e = 0; e < 8; ++e) lg[e] = wave_sum(lg[e]);
            int e0 = 0; float v0 = lg[0];
#pragma unroll
            for (int e = 1; e < 8; ++e) if (lg[e] > v0) { v0 = lg[e]; e0 = e; }
            int e1 = (e0 == 0) ? 1 : 0; float v1 = -INFINITY;
#pragma unroll
            for (int e = 0; e < 8; ++e) if (e != e0 && lg[e] > v1) { v1 = lg[e]; e1 = e; }
            e0 = __builtin_amdgcn_readfirstlane(e0); e1 = __builtin_amdgcn_readfirstlane(e1);
            const float w0 = 1.0f / (1.0f + expf(v1 - v0));
            unsigned q0 = 0u, q1 = 0u;
            if (lane == 0) { q0 = __hip_atomic_fetch_add(cntL + e0, 1u, __ATOMIC_RELAXED, __HIP_MEMORY_SCOPE_WORKGROUP); q1 = __hip_atomic_fetch_add(cntL + e1, 1u, __ATOMIC_RELAXED, __HIP_MEMORY_SCOPE_WORKGROUP); }
            e0s[i] = e0; e1s[i] = e1; lp0[i] = __builtin_amdgcn_readfirstlane((int)q0); lp1[i] = __builtin_amdgcn_readfirstlane((int)q1); w0s[i] = w0; rs2s[i] = rs2;
        }
        __syncthreads();
        if (tid < 8) cntL[8 + tid] = __hip_atomic_fetch_add(cntg + tid, cntL[tid], RLX_AGENT);
        __syncthreads();
#pragma unroll
        for (int i = 0; i < 8; ++i) { const size_t m = (size_t)(base + i);
            const int p0 = (int)cntL[8 + e0s[i]] + lp0[i], p1 = (int)cntL[8 + e1s[i]] + lp1[i];
            const int esz = ((FP8_LAYERS >> l) & 1u) ? 1 : 2; unsigned char* r0 = AP + ((size_t)e0s[i] * ECAP + p0) * D * esz; unsigned char* r1 = AP + ((size_t)e1s[i] * ECAP + p1) * D * esz;
            f32x4 x[4]; ld_row_bf(XB + m * D, lane, x);
#pragma unroll
            for (int j = 0; j < 4; ++j) { x[j] = x[j] * rs2s[i] * fg[j] + fs[j];
                if (esz == 1) { const unsigned hpk = pg8::pk4fp8(x[j]); *(unsigned*)(r0 + 256 * j + 4 * lane) = hpk; *(unsigned*)(r1 + 256 * j + 4 * lane) = hpk; }
                else { u32x2 hpk; hpk.x = pk2(x[j].x, x[j].y); hpk.y = pk2(x[j].z, x[j].w); *(u32x2*)(r0 + 512 * j + 8 * lane) = hpk; *(u32x2*)(r1 + 512 * j + 8 * lane) = hpk; } }
            if (lane == 0) { int4 ti; ti.x = e0s[i] | (e1s[i] << 8); ti.y = p0; ti.z = p1; ti.w = __float_as_int(w0s[i]); *(int4*)(TOK + 4 * m) = ti; }
        }
        __syncthreads();
    }
}
DI void thin_end(int l, int wave, int lane) {
    const kargp_t kp = kargs(); unsigned char* ws = karg_ws(kp); float* outp = karg_out(kp); bf16* XB = (bf16*)(ws + WS_XB);
    const float* ADA = (const float*)(ws + WS_ADA); bf16* XN = (bf16*)(ws + WS_XN); const bf16* MIX = (const bf16*)(ws + WS_MIX);
    const bf16* YP = (const bf16*)(ws + WS_YP); const int* TOK = (const int*)(ws + WS_TOK);
    const bool moe = (l & 1) != 0; const bool last = (l == DEPTH - 1);
    int pp[8];
    { const unsigned* cntg = (const unsigned*)(ws + WS_CTL) + CW_CNT + 64 * (l >> 1); int acc = 0;
#pragma unroll
      for (int e = 0; e < 8; ++e) { pp[e] = acc; const unsigned n = moe ? (unsigned)__builtin_amdgcn_readfirstlane((int)__hip_atomic_load(cntg + e, RLX_AGENT)) : 0u; acc += (int)((n + 255u) >> 8); } }
    const int NGW = gridDim.x * NWAVES, gw = blockIdx.x * NWAVES + wave;
    for (int base = gw * 8; base < M; base += NGW * 8) {
        const int b = base >> 13; const float* ada = ADA + (size_t)(l * 2 + b) * 6144; const float* adan = ADA + (size_t)((last ? l : l + 1) * 2 + b) * 6144;
        f32x4 pg[4], ng[4], ns[4], t[4];
        ld_row(karg_in(kp, 7) + l * D, lane, pg); ld_row(ada + 5120, lane, t);
#pragma unroll
        for (int j = 0; j < 4; ++j) pg[j] = pg[j] * t[j];
        ld_row(karg_in(kp, 4) + (last ? l : l + 1) * D, lane, ng); ld_row(adan + 1024, lane, t); ld_row(adan, lane, ns);
#pragma unroll
        for (int j = 0; j < 4; ++j) ng[j] = ng[j] * (t[j] + 1.0f);
        u32x2 yn[4], zn[4], xr[4]; float w0n = 1.0f;
#define TE_LOAD(mm) do { if (moe) { const int4 ti = *(const int4*)(TOK + 4 * (mm)); const int e0 = ti.x & 255, e1 = (ti.x >> 8) & 255; int b0 = 0, b1 = 0; \
                _Pragma("unroll") for (int e = 1; e < 8; ++e) { if (e0 == e) b0 = pp[e]; if (e1 == e) b1 = pp[e]; } \
                w0n = __int_as_float(ti.w); ld_row_bfraw(YP + ((size_t)b0 * 256 + ti.y) * D, lane, yn); ld_row_bfraw(YP + ((size_t)b1 * 256 + ti.z) * D, lane, zn); } \
            else ld_row_bfraw(MIX + (mm) * D, lane, yn); \
            ld_row_bfraw(XB + (mm) * D, lane, xr); } while (0)
        TE_LOAD((size_t)base);
#pragma unroll
        for (int i = 0; i < 8; ++i) { const size_t m = (size_t)(base + i);
            f32x4 y[4], x[4]; cvt_row_bf(yn, y);
            if (moe) { f32x4 y1[4]; cvt_row_bf(zn, y1); const float w0 = w0n, w1 = 1.0f - w0n;
#pragma unroll
                for (int j = 0; j < 4; ++j) y[j] = y[j] * w0 + y1[j] * w1; }
            cvt_row_bf(xr, x);
            if (i < 7) TE_LOAD(m + 1);
            const float rs = rsqrtf(row_ss(y) * (1.0f / D) + EPS);
#pragma unroll
            for (int j = 0; j < 4; ++j) x[j] = x[j] + pg[j] * (y[j] * rs);
            if (last) st_row(outp + m * D, lane, x); else st_row_bf(XB + m * D, lane, x);
            if (!last) { const float rs2 = rsqrtf(row_ss(x) * (1.0f / D) + EPS);
#pragma unroll
                for (int j = 0; j < 4; ++j) x[j] = x[j] * rs2 * ng[j] + ns[j];
                st_row_bf(XN + m * D, lane, x); }
        }
#undef TE_LOAD
    }
}
constexpr int L_WA = 0, L_WX = 34816, L_XC = 69632, L_PAR = 104448, L_AGG = 108544, L_HST = 116736, L_HINT = 108544;
template <int N> DI float dpp_shr(float oldv, float x) { return __builtin_bit_cast(float, __builtin_amdgcn_update_dpp(__builtin_bit_cast(int, oldv), __builtin_bit_cast(int, x), 0x110 + N, 0xf, 0xf, false)); }
template <int N> DI void scan_step(f32x4& a, f32x4& u) {
#pragma unroll
    for (int q = 0; q < 4; ++q) { const float ap = dpp_shr<N>(1.0f, a[q]), up = dpp_shr<N>(0.0f, u[q]); u[q] = a[q] * up + u[q]; a[q] = a[q] * ap; }
}
DI f32x4 mfma16(bf16x8 a, bf16x8 b, f32x4 c) { return __builtin_amdgcn_mfma_f32_16x16x32_bf16(a, b, c, 0, 0, 0); }
DI f32x4 bf4lo(u32x4 v) { return (f32x4){bflo(v.x), bfhi(v.x), bflo(v.y), bfhi(v.y)}; }
DI f32x4 bf4hi(u32x4 v) { return (f32x4){bflo(v.z), bfhi(v.z), bflo(v.w), bfhi(v.w)}; }
DI void rnn_pass1(LAS unsigned char* lds, int l, int tid, int wave, int lane) {
    const int fr = lane & 15, fq = lane >> 4;
    LAS float* PAR = (LAS float*)(lds + L_PAR); LAS float* AGG = (LAS float*)(lds + L_AGG); LAS float* HST = (LAS float*)(lds + L_HST);
    const int cc = tid & 15, tg4 = (tid >> 4) * 4;
    for (int it = blockIdx.x; it < 256; it += gridDim.x) {
        const int nb = it & 7, seg = it >> 3, sidx = seg & 15; const int m0 = seg * 512;
        const kargp_t kp = kargs(); unsigned char* ws = karg_ws(kp);
        const bf16* XRp = (const bf16*)(ws + WS_XR);
        __syncthreads();
        u32x4 pre[7];
        f32x4 cw0[4], cw1[4], cb0, cb1;
#define RNN_PREFETCH(stn) do { _Pragma("unroll") for (int j = 0; j < 7; ++j) { const int rl = 128 * (stn) + tg4 - 3 + j; pre[j] = (u32x4){0u, 0u, 0u, 0u}; \
                if (!(sidx == 0 && rl < 0)) pre[j] = *(const u32x4*)(XRp + (size_t)(m0 + rl) * 1024 + nb * 128 + cc * 8); } } while (0)
        RNN_PREFETCH(0);
        { const bf16* WA = (const bf16*)(ws + WS_WL + (size_t)l * WL_STRIDE + WL_WRA) + nb * 16384; const bf16* WX = (const bf16*)(ws + WS_WL + (size_t)l * WL_STRIDE + WL_WRX) + nb * 16384;
          u32x4 wreg[8];
#pragma unroll
          for (int i = 0; i < 4; ++i) { const int q = tid + 512 * i; wreg[i] = *(const u32x4*)(WA + (q >> 4) * 128 + (q & 15) * 8); wreg[4 + i] = *(const u32x4*)(WX + (q >> 4) * 128 + (q & 15) * 8); }
          { const float* cwp = karg_in(kp, 9) + (size_t)l * 4096 + nb * 128 + cc * 8; const float* cbp = karg_in(kp, 10) + l * 1024 + nb * 128 + cc * 8;
#pragma unroll
              for (int k = 0; k < 4; ++k) { cw0[k] = *(const f32x4*)(cwp + k * 1024); cw1[k] = *(const f32x4*)(cwp + k * 1024 + 4); }
              cb0 = *(const f32x4*)cbp; cb1 = *(const f32x4*)(cbp + 4); }
          if (tid < 128) { const int ch = l * 1024 + nb * 128 + tid;
            PAR[0 * 128 + tid] = karg_in(kp, 12)[ch]; PAR[1 * 128 + tid] = karg_in(kp, 14)[ch]; PAR[2 * 128 + tid] = 8.0f * log1pf(expf(-karg_in(kp, 15)[ch])) * LOG2E;
            *(LAS f32x2*)(HST + 2 * tid) = (f32x2){1.0f, 0.0f}; }
#pragma unroll
          for (int i = 0; i < 4; ++i) { const int q = tid + 512 * i; *(LAS u32x4*)(lds + L_WA + (q >> 4) * 272 + (q & 15) * 16) = wreg[i]; *(LAS u32x4*)(lds + L_WX + (q >> 4) * 272 + (q & 15) * 16) = wreg[4 + i]; } }
        for (int st = 0; st < 4; ++st) {
#pragma unroll
            for (int i = 0; i < 4; ++i) { f32x4 o0 = cb0, o1 = cb1;
#pragma unroll
                for (int k = 0; k < 4; ++k) { o0 += cw0[k] * bf4lo(pre[i + k]); o1 += cw1[k] * bf4hi(pre[i + k]); }
                u32x4 pk; pk.x = pk2(o0[0], o0[1]); pk.y = pk2(o0[2], o0[3]); pk.z = pk2(o1[0], o1[1]); pk.w = pk2(o1[2], o1[3]);
                *(LAS u32x4*)(lds + L_XC + (tg4 + i) * 272 + cc * 16) = pk; }
            __syncthreads();
            if (st < 3) RNN_PREFETCH(st + 1);
            const int tl = 16 * wave + fr;
            bf16x8 xb[4];
#pragma unroll
            for (int s = 0; s < 4; ++s) xb[s] = *(const LAS bf16x8*)(lds + L_XC + tl * 272 + (32 * s + 8 * fq) * 2);
            unsigned* PSw = (unsigned*)(ws + WS_PS); float* T16w = (float*)(ws + WS_T16);
#pragma unroll
            for (int n = 0; n < 8; ++n) { const int ch0 = 16 * n + 4 * fq;
                f32x4 ca = (f32x4){0.f, 0.f, 0.f, 0.f}, cx = ca;
#pragma unroll
                for (int s = 0; s < 4; ++s) { const bf16x8 af = *(const LAS bf16x8*)(lds + L_WA + (16 * n + fr) * 272 + (32 * s + 8 * fq) * 2), xf = *(const LAS bf16x8*)(lds + L_WX + (16 * n + fr) * 272 + (32 * s + 8 * fq) * 2);
                    ca = mfma16(af, xb[s], ca); cx = mfma16(xf, xb[s], cx); }
                const u32x2 xv = *(const LAS u32x2*)(lds + L_XC + tl * 272 + ch0 * 2); const f32x4 xc = (f32x4){bflo(xv.x), bfhi(xv.x), bflo(xv.y), bfhi(xv.y)};
                const f32x4 r = pg8::sig4(ca + *(const LAS f32x4*)(PAR + ch0)), ig = pg8::sig4(cx + *(const LAS f32x4*)(PAR + 128 + ch0)), sp = *(const LAS f32x4*)(PAR + 256 + ch0);
                f32x4 av, uv;
#pragma unroll
                for (int q = 0; q < 4; ++q) { const float aa = fexp2(-r[q] * sp[q]); av[q] = aa; uv[q] = __builtin_amdgcn_sqrtf(1.0f - aa * aa) * ig[q] * xc[q]; }
                scan_step<1>(av, uv); scan_step<2>(av, uv); scan_step<4>(av, uv); scan_step<8>(av, uv);
                { u32x4 ps; ps.x = pk2(av[0], uv[0]); ps.y = pk2(av[1], uv[1]); ps.z = pk2(av[2], uv[2]); ps.w = pk2(av[3], uv[3]);
                  *(u32x4*)(PSw + (size_t)(m0 + 128 * st + tl) * 1024 + nb * 128 + ch0) = ps; }
                if (fr == 15) { const f32x4 g0 = (f32x4){av[0], uv[0], av[1], uv[1]}, g1 = (f32x4){av[2], uv[2], av[3], uv[3]};
                    *(LAS f32x4*)(AGG + (wave * 128 + ch0) * 2) = g0; *(LAS f32x4*)(AGG + (wave * 128 + ch0) * 2 + 4) = g1;
                    float* o = T16w + ((size_t)(seg * 32 + st * 8 + wave) * 1024 + nb * 128 + ch0) * 2; *(f32x4*)o = g0; *(f32x4*)(o + 4) = g1; }
            }
            __syncthreads();
            LAS float* HS0 = HST + 256 * (st & 1); LAS float* HS1 = HST + 256 * ((st + 1) & 1);
            if (fr == 0) { const int ch0 = 16 * wave + 4 * fq;
                const f32x4 h0 = *(const LAS f32x4*)(HS0 + 2 * ch0), h1 = *(const LAS f32x4*)(HS0 + 2 * ch0 + 4);
                f32x4 A = (f32x4){h0[0], h0[2], h1[0], h1[2]}, U = (f32x4){h0[1], h0[3], h1[1], h1[3]};
#pragma unroll
                for (int w2 = 0; w2 < 8; ++w2) { const f32x4 g0 = *(const LAS f32x4*)(AGG + (w2 * 128 + ch0) * 2), g1 = *(const LAS f32x4*)(AGG + (w2 * 128 + ch0) * 2 + 4);
                    const f32x4 a2 = (f32x4){g0[0], g0[2], g1[0], g1[2]}, u2 = (f32x4){g0[1], g0[3], g1[1], g1[3]}; U = a2 * U + u2; A = A * a2; }
                const f32x4 o0 = (f32x4){A[0], U[0], A[1], U[1]}, o1 = (f32x4){A[2], U[2], A[3], U[3]};
                *(LAS f32x4*)(HS1 + 2 * ch0) = o0; *(LAS f32x4*)(HS1 + 2 * ch0 + 4) = o1;
                if (st == 3) { float* o = (float*)(ws + WS_RAGG) + ((size_t)seg * 1024 + nb * 128 + ch0) * 2; *(f32x4*)o = o0; *(f32x4*)(o + 4) = o1; } }
        }
#undef RNN_PREFETCH
    }
}
DI void rnn_pass2(LAS unsigned char* lds, int tid) {
    LAS float* HINT = (LAS float*)lds;
    for (int it = blockIdx.x; it < 256; it += gridDim.x) {
        const int nb = it & 7, seg = it >> 3, sidx = seg & 15; const int m0 = seg * 512;
        unsigned char* ws = karg_ws(kargs());
        __syncthreads();
        if (tid < 128) { const float* RAGG = (const float*)(ws + WS_RAGG) + ((size_t)(seg - sidx) * 1024 + nb * 128 + tid) * 2; const float* T16 = (const float*)(ws + WS_T16) + ((size_t)(seg * 32) * 1024 + nb * 128 + tid) * 2;
            f32x2 sa[15], ta[32];
#pragma unroll
            for (int s2 = 0; s2 < 15; ++s2) sa[s2] = *(const f32x2*)(RAGG + (size_t)s2 * 2048);
#pragma unroll
            for (int t2 = 0; t2 < 32; ++t2) ta[t2] = *(const f32x2*)(T16 + (size_t)t2 * 2048);
            float h = 0.f;
#pragma unroll
            for (int s2 = 0; s2 < 15; ++s2) h = (s2 < sidx) ? sa[s2].x * h + sa[s2].y : h;
#pragma unroll
            for (int t2 = 0; t2 < 32; ++t2) { HINT[t2 * 128 + tid] = h; h = ta[t2].x * h + ta[t2].y; } }
        __syncthreads();
        const unsigned* PS = (const unsigned*)(ws + WS_PS); const bf16* GGp = (const bf16*)(ws + WS_GG); bf16* ROp = (bf16*)(ws + WS_RO);
        const int c4 = (tid & 31) * 4, r0 = tid >> 5;
#pragma unroll 4
        for (int i = 0; i < 32; ++i) { const int row = r0 + 16 * i; const size_t off = (size_t)(m0 + row) * 1024 + nb * 128 + c4, offo = (size_t)(m0 + row) * 2048 + nb * 128 + c4;
            const u32x4 ps = *(const u32x4*)(PS + off); const u32x2 gv = *(const u32x2*)(GGp + off); const f32x4 hin = *(const LAS f32x4*)(HINT + (row >> 4) * 128 + c4);
            const float h0 = bflo(ps.x) * hin[0] + bfhi(ps.x), h1 = bflo(ps.y) * hin[1] + bfhi(ps.y), h2 = bflo(ps.z) * hin[2] + bfhi(ps.z), h3 = bflo(ps.w) * hin[3] + bfhi(ps.w);
            u32x2 o; o.x = pk2(h0 * bflo(gv.x), h1 * bfhi(gv.x)); o.y = pk2(h2 * bflo(gv.y), h3 * bfhi(gv.y)); *(u32x2*)(ROp + offo) = o; }
    }
}

constexpr int L_K = 0, L_V = 69632;
DI f32x16 mfma32(bf16x8 a, bf16x8 b, f32x16 c) { return __builtin_amdgcn_mfma_f32_32x32x16_bf16(a, b, c, 0, 0, 0); }
DI void attn_phase(LAS unsigned char* lds, int l, int tid, int wave, int lane) {
    const int r = lane & 31, h = lane >> 5;
    const kargp_t kp = kargs(); unsigned char* ws = karg_ws(kp);
    const bf16* Q = (const bf16*)(ws + WS_Q); const bf16* KB = (const bf16*)(ws + WS_KB); const bf16* VB = (const bf16*)(ws + WS_VB); bf16* AO = (bf16*)(ws + WS_RO) + 1024;   const float* sinks = karg_in(kp, 16) + l * 8;
    for (int it = blockIdx.x; it < 256; it += gridDim.x) {
        const int b = it >> 7, qblk = (it >> 1) & 63, kvh = it & 1; const int rowbase = b * SEQ + qblk * 128;
        __syncthreads();
#pragma unroll
        for (int i = 0; i < 8; ++i) { const int idx = tid + 512 * i, j = idx >> 4, c = idx & 15; u32x4 v = (u32x4){0u, 0u, 0u, 0u};
            if (qblk > 0 || j >= 128) v = *(const u32x4*)(KB + (size_t)(rowbase - 128 + j) * 256 + kvh * 128 + c * 8);
            *(LAS u32x4*)(lds + L_K + j * 272 + c * 16) = v; }
#pragma unroll
        for (int i = 0; i < 8; ++i) { const int idx = tid + 512 * i, c = idx >> 8, j = idx & 255; u32x4 v = (u32x4){0u, 0u, 0u, 0u};
            if (qblk > 0 || j >= 128) v = *(const u32x4*)(VB + (size_t)(rowbase - 128 + j) * 256 + kvh * 128 + c * 8);
            LAS unsigned short* vt = (LAS unsigned short*)(lds + L_V) + (8 * c) * 264 + j;
            vt[0 * 264] = (unsigned short)(v.x & 0xffffu); vt[1 * 264] = (unsigned short)(v.x >> 16); vt[2 * 264] = (unsigned short)(v.y & 0xffffu); vt[3 * 264] = (unsigned short)(v.y >> 16);
            vt[4 * 264] = (unsigned short)(v.z & 0xffffu); vt[5 * 264] = (unsigned short)(v.z >> 16); vt[6 * 264] = (unsigned short)(v.w & 0xffffu); vt[7 * 264] = (unsigned short)(v.w >> 16); }
        __syncthreads();
        const int g = wave >> 1, head = kvh * 4 + g;
        const float slope2 = exp2f(-(float)(head + 1)) * LOG2E, sink2 = sinks[head] * LOG2E;
#pragma unroll 1
        for (int si = 0; si < 2; ++si) {
            const int q0 = 64 * (wave & 1) + 32 * si, kt0 = q0 >> 5; const size_t qrow = (size_t)(rowbase + q0 + r);
            bf16x8 qf[8];
#pragma unroll
            for (int ks = 0; ks < 8; ++ks) qf[ks] = *(const bf16x8*)(Q + qrow * 1024 + head * 128 + 16 * ks + 8 * h);
            const LAS unsigned char* kbase = lds + L_K + (32 * kt0 + r) * 272 + 16 * h;
            const LAS unsigned char* vbase = lds + L_V + r * 528 + 64 * kt0 + 8 * h;
            const int d0 = (q0 + r) + 128 - (32 * kt0 + 4 * h);
            const int jlim = qblk > 0 ? -100000 : 128 - (32 * kt0 + 4 * h);
            const float fd0 = (float)d0, fjl = (float)jlim;
            f32x16 p[5];
#pragma unroll
            for (int t = 0; t < 5; ++t) {
#pragma unroll
                for (int e = 0; e < 16; ++e) p[t][e] = 0.f;
#pragma unroll
                for (int ks = 0; ks < 8; ++ks) { const bf16x8 kf = *(const LAS bf16x8*)(kbase + t * 8704 + ks * 32); p[t] = mfma32(kf, qf[ks], p[t]); } }
            float mx = sink2;
#pragma unroll
            for (int t = 0; t < 5; ++t)
#pragma unroll
                for (int e = 0; e < 16; ++e) { const float cte = (float)(32 * t + (e & 3) + 8 * (e >> 2)); const float fd = fd0 - cte;
                    const float bad = fmaxf(fmaxf(-fd, fd - 127.0f), fjl - cte);
                    p[t][e] = p[t][e] - slope2 * fd + fminf(0.f, -1e30f * bad); mx = fmaxf(mx, p[t][e]); }
            mx = fmaxf(mx, __shfl_xor(mx, 32));
            float sum = 0.f;
#pragma unroll
            for (int t = 0; t < 5; ++t)
#pragma unroll
                for (int e = 0; e < 16; ++e) { const float ev = fexp2(p[t][e] - mx); p[t][e] = ev; sum += ev; }
            sum += __shfl_xor(sum, 32); sum += fexp2(sink2 - mx);
            const float inv = 1.0f / sum;
            f32x16 o[4];
#pragma unroll
            for (int dt = 0; dt < 4; ++dt)
#pragma unroll
                for (int e = 0; e < 16; ++e) o[dt][e] = 0.f;
#pragma unroll
            for (int t = 0; t < 5; ++t) {
#pragma unroll
                for (int s = 0; s < 2; ++s) { u32x4 pk; pk.x = pk2(p[t][8 * s + 0], p[t][8 * s + 1]); pk.y = pk2(p[t][8 * s + 2], p[t][8 * s + 3]); pk.z = pk2(p[t][8 * s + 4], p[t][8 * s + 5]); pk.w = pk2(p[t][8 * s + 6], p[t][8 * s + 7]);
                    const bf16x8 pf = __builtin_bit_cast(bf16x8, pk);
#pragma unroll
                    for (int dt = 0; dt < 4; ++dt) { const LAS unsigned char* va = vbase + dt * 16896 + t * 64 + s * 32;
                        const s16x4 lo = *(const LAS s16x4*)va, hi = *(const LAS s16x4*)(va + 16);
                        const bf16x8 vf = __builtin_shufflevector(lo, hi, 0, 1, 2, 3, 4, 5, 6, 7); o[dt] = mfma32(vf, pf, o[dt]); } } }
#pragma unroll
            for (int dt = 0; dt < 4; ++dt)
#pragma unroll
                for (int gg = 0; gg < 4; ++gg) { u32x2 w; w.x = pk2(o[dt][4 * gg] * inv, o[dt][4 * gg + 1] * inv); w.y = pk2(o[dt][4 * gg + 2] * inv, o[dt][4 * gg + 3] * inv);
                    *(u32x2*)(AO + qrow * 2048 + head * 128 + 32 * dt + 8 * gg + 4 * h) = w; }
        }
    }
}

constexpr int N_PHASES = 2 + 9 * DEPTH;
__global__ void __launch_bounds__(NWAVES * 64, 2) trunk_fwd(Args args) {
    extern __shared__ __attribute__((aligned(16))) unsigned char lds_raw[];
    LAS unsigned char* lds = (LAS unsigned char*)lds_raw;
    volatile LAS unsigned* MISC = (volatile LAS unsigned*)(lds + MISC_OFF);
    const int tid0 = threadIdx.x;
#define TID_DEFS int tid = tid0; asm volatile("" : "+v"(tid)); const int lane = tid & 63, wave = __builtin_amdgcn_readfirstlane(tid >> 6); (void)lane; (void)wave;
    const int G = gridDim.x;
    gu32* ctl = (gu32*)(args.ws + WS_CTL);
    for (int u = tid0; u < (LDS_BYTES - LDSCTL_OFF) / 4; u += NWAVES * 64) ((LAS unsigned*)(lds + LDSCTL_OFF))[u] = 0u;
    __syncthreads();
    XcdBarrier bar = xcd_barrier_post((unsigned*)ctl + CW_BAR, MISC + 8);
    const int lo = args.ph_lo, hi = args.ph_hi;
#ifndef PH_MASK
#define PH_MASK 0xffffffffu
#endif
#define EN(b) ((PH_MASK >> (b)) & 1u)
#ifndef PH_REPEAT
#define PH_REPEAT 0u
#endif
#ifndef PH_NREP
#define PH_NREP 2
#endif
#define REPS(b) (((PH_REPEAT >> (b)) & 1u) ? PH_NREP : 1)
#define REP_BEGIN(b) for (int rep_ = 0; rep_ < REPS(b); ++rep_) { if (rep_) xcd_barrier(bar);
#define REP_END }
#define IN(k) (lo <= (k) && (k) < hi)
#ifndef BAR_TWICE
#define BAR_TWICE 0
#endif
#define SEAM(k) do { if (IN(k) && IN((k) + 1)) { xcd_barrier(bar); if (BAR_TWICE) xcd_barrier(bar); } } while (0)
#if NAIVE_GEMM
#define RUN_GEMM(EPI, SCHED, ALIGN, g, S, E) pg8::gemm_phase_naive<EPI, SCHED>(g, S, E)
#else
#ifndef BF_SP2
#define BF_SP2 true
#endif
#define RUN_GEMM(EPI, SCHED, ALIGN, g, S, E) pg8::gemm_phase<EPI, SCHED, ALIGN, BF_SP2>(lds + RING_OFF, g, S, E)
#endif
#ifndef F8_ALIGN
#define F8_ALIGN(a) (a)
#endif
#ifndef F8_SP2
#define F8_SP2 false
#endif
#define RUN_GEMM8(EPI, SCHED, ALIGN, g, S, E) pg8::gemm_phase<EPI, SCHED, F8_ALIGN(ALIGN), F8_SP2, true>(lds + RING_OFF, g, S, E)
#define SC_ONE 0x7f7f7f7f
#define SC_M5 0x7a7a7a7a
#define SC_M6 0x79797979
    if (EN(0) && IN(0)) { REP_BEGIN(0) TID_DEFS p0_prologue(lds, tid, wave, lane); REP_END } SEAM(0);
    if (EN(1) && IN(1)) { REP_BEGIN(1) TID_DEFS thin_start(wave, lane); REP_END } SEAM(1);

    for (int l = 0; l < DEPTH; ++l) {
        const int pb = 2 + 9 * l;
        if (EN(2) && IN(pb + 0)) { REP_BEGIN(2)
            unsigned char* ws = karg_ws(kargs());
            pg8::Gemm g{(const bf16*)(ws + WS_XN), (const bf16*)(ws + WS_WL + (size_t)l * WL_STRIDE + WL_WIN), M, D_IN, D}; pg8::StaticOrder S; S.init(M, D_IN, G, (int)blockIdx.x);
            pg8::EpiWin E; E.R = ws + WS_R;
            RUN_GEMM(pg8::EpiWin, pg8::StaticOrder, true, g, S, E);
         REP_END } SEAM(pb + 0);
        if (IN(pb + 1)) {
            if (EN(3)) { REP_BEGIN(3) TID_DEFS rnn_pass1(lds, l, tid, wave, lane); REP_END }
            if (EN(4)) { REP_BEGIN(4) TID_DEFS attn_phase(lds, l, tid, wave, lane); REP_END }
        } SEAM(pb + 1);
        if (EN(5) && IN(pb + 2)) { REP_BEGIN(5) TID_DEFS rnn_pass2(lds, tid); REP_END } SEAM(pb + 2);
        if (EN(6) && IN(pb + 3)) { REP_BEGIN(6)
            unsigned char* ws = karg_ws(kargs());
            pg8::Gemm g{(const bf16*)(ws + WS_RO), (const bf16*)(ws + WS_WL + (size_t)l * WL_STRIDE + WL_WB), M, D, 2 * D}; pg8::StaticOrder S; S.init(M, D, G, (int)blockIdx.x);
            pg8::EpiMerge E; E.R = ws + WS_R; RUN_GEMM(pg8::EpiMerge, pg8::StaticOrder, false, g, S, E);
         REP_END } SEAM(pb + 3);
        if (EN(7) && IN(pb + 4)) { REP_BEGIN(7)
            unsigned char* ws = karg_ws(kargs());
            pg8::Gemm g{(const bf16*)(ws + WS_MG), (const bf16*)(ws + WS_WL + (size_t)l * WL_STRIDE + WL_WO), M, D, D}; pg8::StaticOrder S; S.init(M, D, G, (int)blockIdx.x);
            pg8::EpiBf16N E; E.O = (bf16*)(ws + WS_MIX); RUN_GEMM(pg8::EpiBf16N, pg8::StaticOrder, false, g, S, E);
         REP_END } SEAM(pb + 4);
        if (IN(pb + 5)) { if (l & 1) { if (EN(9)) { TID_DEFS thin_mid_moe(lds, l, tid, wave, lane); } } else { if (EN(8)) { TID_DEFS thin_mid_dense(l, wave, lane); } } } SEAM(pb + 5);
        if (l & 1) {
            if (EN(10) && IN(pb + 6)) { REP_BEGIN(10)
                unsigned char* ws = karg_ws(kargs()); const unsigned* cntg = (const unsigned*)(ws + WS_CTL) + CW_CNT + 64 * (l >> 1);
                pg8::Gemm g{(const bf16*)(ws + WS_AP), (const bf16*)(ws + WS_WM + (size_t)(l >> 1) * WM_STRIDE + WM_MIN), 0, 0, D, SC_M5, SC_ONE}; pg8::MoeOrder S; S.init(cntg, 12, G, (int)blockIdx.x, ECAP / 256);
                if ((FP8_LAYERS >> l) & 1u) { pg8::EpiSwiglu8 E; E.O = ws + WS_ACTP; E.ldc = D_FFE; E.ntile = 12; RUN_GEMM8(pg8::EpiSwiglu8, pg8::MoeOrder, true, g, S, E); }
                else { pg8::EpiSwiglu E; E.O = (bf16*)(ws + WS_ACTP); E.ldc = D_FFE; E.ntile = 12; RUN_GEMM(pg8::EpiSwiglu, pg8::MoeOrder, true, g, S, E); }
             REP_END } SEAM(pb + 6);
            if (EN(11) && IN(pb + 7)) { REP_BEGIN(11)
                unsigned char* ws = karg_ws(kargs()); const unsigned* cntg = (const unsigned*)(ws + WS_CTL) + CW_CNT + 64 * (l >> 1);
                pg8::Gemm g{(const bf16*)(ws + WS_ACTP), (const bf16*)(ws + WS_WM + (size_t)(l >> 1) * WM_STRIDE + WM_MOUT), 0, 0, D_FFE, SC_M5, SC_ONE}; pg8::MoeOrder S; S.init(cntg, 4, G, (int)blockIdx.x, 0);
                pg8::EpiBf16Mod4 E; E.O = (bf16*)(ws + WS_YP);
                if ((FP8_LAYERS >> l) & 1u) RUN_GEMM8(pg8::EpiBf16Mod4, pg8::MoeOrder, true, g, S, E); else RUN_GEMM(pg8::EpiBf16Mod4, pg8::MoeOrder, true, g, S, E);
             REP_END } SEAM(pb + 7);
        } else {
            if (EN(12) && IN(pb + 6)) { REP_BEGIN(12)
                unsigned char* ws = karg_ws(kargs());
                pg8::Gemm g{(const bf16*)(ws + WS_XN), (const bf16*)(ws + WS_WD + (size_t)(l >> 1) * WD_STRIDE + WD_FIN), M, 2 * D_FF, D, SC_M5, SC_ONE}; pg8::StaticOrder S; S.init(M, 2 * D_FF, G, (int)blockIdx.x);
                if ((FP8_LAYERS >> l) & 1u) { pg8::EpiSwiglu8 E; E.O = ws + WS_ACT; E.ldc = D_FF; E.ntile = 24; RUN_GEMM8(pg8::EpiSwiglu8, pg8::StaticOrder, true, g, S, E); }
                else { pg8::EpiSwiglu E; E.O = (bf16*)(ws + WS_ACT); E.ldc = D_FF; E.ntile = 24; RUN_GEMM(pg8::EpiSwiglu, pg8::StaticOrder, true, g, S, E); }
             REP_END } SEAM(pb + 6);
            if (EN(13) && IN(pb + 7)) { REP_BEGIN(13)
                unsigned char* ws = karg_ws(kargs());
                pg8::Gemm g{(const bf16*)(ws + WS_ACT), (const bf16*)(ws + WS_WD + (size_t)(l >> 1) * WD_STRIDE + WD_FOUT), M, D, D_FF, SC_M6, SC_ONE}; pg8::StaticOrder S; S.init(M, D, G, (int)blockIdx.x);
                pg8::EpiBf16N E; E.O = (bf16*)(ws + WS_MIX);
                if ((FP8_LAYERS >> l) & 1u) RUN_GEMM8(pg8::EpiBf16N, pg8::StaticOrder, false, g, S, E); else RUN_GEMM(pg8::EpiBf16N, pg8::StaticOrder, false, g, S, E);
             REP_END } SEAM(pb + 7);
        }
        if (EN(14) && IN(pb + 8)) { TID_DEFS thin_end(l, wave, lane); } SEAM(pb + 8);
    }
#undef IN
#undef SEAM
}

extern "C" void kernel_launch(void* const* d_in, const int* in_sizes, int n_in, void* d_out, int out_size, void* d_ws, size_t ws_size, hipStream_t stream) {
    static int grid = 0;
    if (grid == 0) {
        if (n_in != 24 || in_sizes[0] != M * D || out_size != M * D || ws_size < WS_END) { fprintf(stderr, "kernel_launch: unexpected shapes or workspace (n_in %d, in0 %d, out %d, ws %zu < %zu); nothing launched\n", n_in, n_in > 0 ? in_sizes[0] : -1, out_size, ws_size, (size_t)WS_END); grid = -1; return; }
        int dev = 0, cus = 0, per_cu = 0;
        if (hipGetDevice(&dev) != hipSuccess || hipDeviceGetAttribute(&cus, hipDeviceAttributeMultiprocessorCount, dev) != hipSuccess) { grid = -1; return; }
        if (hipFuncSetAttribute((const void*)trunk_fwd, hipFuncAttributeMaxDynamicSharedMemorySize, LDS_BYTES) != hipSuccess) { fprintf(stderr, "kernel_launch: hipFuncSetAttribute failed\n"); grid = -1; return; }
        if (hipOccupancyMaxActiveBlocksPerMultiprocessor(&per_cu, (const void*)trunk_fwd, NWAVES * 64, LDS_BYTES) != hipSuccess || per_cu < 1)
            fprintf(stderr, "kernel_launch: note: occupancy query reports %d workgroups per CU\n", per_cu);
        (void)hipGetLastError();
        grid = cus;
    }
    if (grid < 0) return;
    if (hipMemsetAsync((char*)d_ws + WS_CTL, 0, CTL_ZERO_BYTES, stream) != hipSuccess) return;
    Args a{};
    for (int i = 0; i < 24; ++i) a.in[i] = (const float*)d_in[i];
    a.out = (float*)d_out; a.ws = (unsigned char*)d_ws;
#if MK_ONE_LAUNCH
    a.ph_lo = 0; a.ph_hi = N_PHASES;
    hipLaunchKernelGGL(trunk_fwd, dim3(grid), dim3(NWAVES * 64), LDS_BYTES, stream, a);
#else
    for (int p = 0; p < N_PHASES; ++p) { a.ph_lo = p; a.ph_hi = p + 1; hipLaunchKernelGGL(trunk_fwd, dim3(grid), dim3(NWAVES * 64), LDS_BYTES, stream, a); }
#endif
}
```

```cpp
#include <hip/hip_runtime.h>
#include <cstdio>
#include <cstdint>

#ifndef MK_ONE_LAUNCH
#define MK_ONE_LAUNCH 1
#endif
#ifndef NAIVE_GEMM
#define NAIVE_GEMM 0
#endif

#ifndef FP8_LAYERS
#define FP8_LAYERS 0xEu
#endif
#define DI __device__ __forceinline__
#define GAS __attribute__((address_space(1)))
#define LAS __attribute__((address_space(3)))
typedef unsigned short bf16;
typedef short bf16x8 __attribute__((ext_vector_type(8)));
typedef short s16x4 __attribute__((ext_vector_type(4)));
typedef float f32x2 __attribute__((ext_vector_type(2)));
typedef float f32x4 __attribute__((ext_vector_type(4)));
typedef float f32x16 __attribute__((ext_vector_type(16)));
typedef unsigned u32x2 __attribute__((ext_vector_type(2)));
typedef unsigned u32x4 __attribute__((ext_vector_type(4)));
typedef __bf16 bf16x2_t __attribute__((ext_vector_type(2)));
typedef GAS unsigned gu32;

constexpr int BATCH = 2, SEQ = 8192, D = 1024, DEPTH = 4, M = BATCH * SEQ;
constexpr int D_IN = 5632, D_FF = 3072, NE = 8, D_FFE = 1536, ECAP = 16384;
constexpr float EPS = 1e-6f;
constexpr float LOG2E = 1.4426950408889634f;
constexpr float QSCALE = 0.08838834764831845f * 1.4426950408889634f;

DI unsigned pk2(float lo, float hi) { f32x2 v = {lo, hi}; return __builtin_bit_cast(unsigned, __builtin_convertvector(v, bf16x2_t)); }
DI float bflo(unsigned w) { return __uint_as_float(w << 16); }
DI float bfhi(unsigned w) { return __uint_as_float(w & 0xffff0000u); }
DI float fexp2(float x) { return __builtin_amdgcn_exp2f(x); }
DI float frcp(float x) { return __builtin_amdgcn_rcpf(x); }
DI float sigmoidf_(float v) { return frcp(1.0f + fexp2(-LOG2E * v)); }
DI float siluf_(float v) { return v * sigmoidf_(v); }
DI float gelu_tanh_(float v) { const float t = v + 0.044715f * v * v * v; return v * frcp(1.0f + fexp2(-2.0f * 0.7978845608028654f * LOG2E * t)); }
DI float wave_sum(float v) {
#pragma unroll
    for (int o = 1; o < 64; o <<= 1) v += __shfl_xor(v, o);
    return v;
}
#define LDS_WAIT() asm volatile("s_waitcnt lgkmcnt(0)" ::: "memory")
#define VM_WAIT() asm volatile("s_waitcnt vmcnt(0)" ::: "memory")
#define RLX_AGENT __ATOMIC_RELAXED, __HIP_MEMORY_SCOPE_AGENT
#ifndef HOOK_ON
#define HOOK_ON 1
#endif
#ifndef WGM_SET
#define WGM_SET 8
#endif
namespace pg8 {
#define PG8_LAS __attribute__((address_space(3)))
typedef unsigned short bf16_t;
constexpr int BM = 256, BK = 64, HALF = 128, HTB = HALF * BK * 2  , STAGE_BYTES = 8 * HTB, NXCD = 8, WGM = WGM_SET;

__host__ __device__ __forceinline__ int lds_byte(int r, int c) { const int st = (r >> 4) * 2 + (c >> 5), rr = r & 15, cc = c & 31, ob = rr * 64 + cc * 2; return st * 1024 + (ob ^ (((ob >> 9) & 1) << 5)); }
__host__ __device__ __forceinline__ void stage_rc(int b, int& R, int& C) { const int st = b / 1024, sb = b % 1024, swz = sb ^ (((sb >> 9) & 1) << 5); R = (st >> 1) * 16 + swz / 64; C = (st & 1) * 32 + (swz % 64) / 2; }
__host__ __device__ __forceinline__ int perm32(int rho) { const int n = rho >> 4, i = rho & 15; return 8 * (i >> 2) + 4 * n + (i & 3); }

struct Unit { int pm, pn, po; };
struct Gemm { const bf16_t* A; const bf16_t* Bt; int M, N, K; int sw, sa; };
typedef int i32x8 __attribute__((ext_vector_type(8)));
typedef int i32x4v __attribute__((ext_vector_type(4)));
__device__ __forceinline__ i32x8 cat8(bf16x8 lo, bf16x8 hi) { return __builtin_shufflevector(__builtin_bit_cast(i32x4v, lo), __builtin_bit_cast(i32x4v, hi), 0, 1, 2, 3, 4, 5, 6, 7); }
__device__ __forceinline__ unsigned pk4fp8(f32x4 v) { int w = __builtin_amdgcn_cvt_pk_fp8_f32(v[0], v[1], 0, false); w = __builtin_amdgcn_cvt_pk_fp8_f32(v[2], v[3], w, true); return (unsigned)w; }

struct StaticOrder {
    int nM, nN, nwg, G, c;
    __host__ __device__ void init(int M, int N, int G_, int c_) { nM = M / BM; nN = N / BM; nwg = nM * nN; G = G_; c = c_; }
    __host__ __device__ bool next(int i, Unit& u) const {
        const long L = (long)i * G + c; if (L >= nwg) return false;
        int wgid = (int)L; { const int q = nwg / NXCD, r = nwg % NXCD, xcd = wgid % NXCD, off = wgid / NXCD; wgid = (xcd < r ? xcd * (q + 1) : r * (q + 1) + (xcd - r) * q) + off; }
        const int nig = WGM * nN, gid = wgid / nig, fm = gid * WGM, gsz = (nM - fm) < WGM ? (nM - fm) : WGM;
        u.pm = fm + ((wgid % nig) % gsz); u.pn = (wgid % nig) / gsz; u.po = u.pm; return true;
    }
    __device__ __forceinline__ void a_ready(const Unit&) const {}
    __device__ __forceinline__ void done(const Unit&) const {}
};
struct ListOrder {
    int first, count, ncol, pn0;
    __device__ __forceinline__ bool next(int i, Unit& u) const { if (i >= count) return false; const int g = first + i; u.pm = g / ncol; u.pn = pn0 + g % ncol; u.po = u.pm; return true; }
    __device__ __forceinline__ void a_ready(const Unit&) const {}
    __device__ __forceinline__ void done(const Unit&) const {}
};
struct MoeOrder {
    int pp[9]; int nM, nN, nwg, G, c, astride;
    __device__ __forceinline__ void init(const unsigned* cnt, int NT, int G_, int c_, int astride_) {
        int a = 0;
#pragma unroll
        for (int e = 0; e < 8; ++e) { pp[e] = a; const unsigned n = (unsigned)__builtin_amdgcn_readfirstlane((int)__hip_atomic_load(cnt + e, RLX_AGENT)); a += (int)((n + 255u) >> 8); }
        pp[8] = a; nM = a; nN = NT; nwg = nM * nN; G = G_; c = c_; astride = astride_;
    }
    __device__ __forceinline__ bool next(int i, Unit& u) const {
        const long L = (long)i * G + c; if (L >= nwg) return false;
        int wgid = (int)L; { const int q = nwg / NXCD, r = nwg % NXCD, xcd = wgid % NXCD, off = wgid / NXCD; wgid = (xcd < r ? xcd * (q + 1) : r * (q + 1) + (xcd - r) * q) + off; }
        const int nig = WGM * nN, gid = wgid / nig, fm = gid * WGM, gsz = (nM - fm) < WGM ? (nM - fm) : WGM;
        const int vp = fm + ((wgid % nig) % gsz), t = (wgid % nig) / gsz;
        int e = 0, base = 0;
#pragma unroll
        for (int k = 1; k < 8; ++k) if (vp >= pp[k]) { e = k; base = pp[k]; }
        u.pm = astride ? e * astride + (vp - base) : vp; u.pn = e * nN + t; u.po = vp; return true;
    }
    __device__ __forceinline__ void a_ready(const Unit&) const {}
    __device__ __forceinline__ void done(const Unit&) const {}
};

template <class E> __device__ __forceinline__ void epi_rows(const E& e, const f32x4 (&acc)[2][2][4][2], const Unit& u, int wr, int wc, int fr, int fq) {
    asm volatile("" : "+v"(fr), "+v"(fq));
#pragma unroll
    for (int ai = 0; ai < 2; ++ai)
#pragma unroll
        for (int m = 0; m < 4; ++m) e.row8(u, ai * HALF + wr * 64 + m * 16 + fr, wc * 32 + 8 * fq, acc[ai][0][m][0], acc[ai][0][m][1], acc[ai][1][m][0], acc[ai][1][m][1]);
}
#define PG8_EPI_COMMON static constexpr bool PERM = true, AFTER_DRAIN = false, MID_HOOK = false; \
    __device__ __forceinline__ void operator()(const f32x4 (&acc)[2][2][4][2], const Unit& u, int wr, int wc, int fr, int fq) const { epi_rows(*this, acc, u, wr, wc, fr, fq); }
__device__ __forceinline__ void st8bf(bf16_t* p, f32x4 a, f32x4 b) { u32x4 w; w.x = pk2(a[0], a[1]); w.y = pk2(a[2], a[3]); w.z = pk2(b[0], b[1]); w.w = pk2(b[2], b[3]); *(u32x4*)p = w; }
__device__ __forceinline__ void ld8bf(const bf16_t* p, f32x4& a, f32x4& b) { const u32x4 w = *(const u32x4*)p; a = (f32x4){bflo(w.x), bfhi(w.x), bflo(w.y), bfhi(w.y)}; b = (f32x4){bflo(w.z), bfhi(w.z), bflo(w.w), bfhi(w.w)}; }
__device__ __forceinline__ f32x4 gelu4(f32x4 v) { return (f32x4){gelu_tanh_(v[0]), gelu_tanh_(v[1]), gelu_tanh_(v[2]), gelu_tanh_(v[3])}; }
__device__ __forceinline__ f32x4 sig4(f32x4 v) { return (f32x4){sigmoidf_(v[0]), sigmoidf_(v[1]), sigmoidf_(v[2]), sigmoidf_(v[3])}; }
__device__ __forceinline__ f32x4 silu4(f32x4 v) { return (f32x4){siluf_(v[0]), siluf_(v[1]), siluf_(v[2]), siluf_(v[3])}; }

struct EpiWin { PG8_EPI_COMMON
    unsigned char* R;
    __device__ __forceinline__ void row8(const Unit& u, int r, int cit, f32x4 a0, f32x4 a1, f32x4 b0, f32x4 b1) const {
        const size_t row = (size_t)u.po * BM + r; const int pn = u.pn;
        bf16_t* XR = (bf16_t*)R; bf16_t* GG = (bf16_t*)(R + (32u << 20)); bf16_t* Q = (bf16_t*)(R + (64u << 20)); bf16_t* KB = (bf16_t*)(R + (96u << 20)); bf16_t* VB = (bf16_t*)(R + (104u << 20)); bf16_t* GT = (bf16_t*)(R + (112u << 20));
        if (pn < 4)       { bf16_t* o = XR + row * 1024 + 256 * pn + cit; st8bf(o, a0, a1); st8bf(o + HALF, b0, b1); }
        else if (pn < 8)  { bf16_t* o = GG + row * 1024 + 256 * (pn - 4) + cit; st8bf(o, gelu4(a0), gelu4(a1)); st8bf(o + HALF, gelu4(b0), gelu4(b1)); }
        else if (pn < 12) { bf16_t* o = Q + row * 1024 + 256 * (pn - 8) + cit; st8bf(o, a0 * QSCALE, a1 * QSCALE); st8bf(o + HALF, b0 * QSCALE, b1 * QSCALE); }
        else if (pn == 12) { bf16_t* o = KB + row * 256 + cit; st8bf(o, a0, a1); st8bf(o + HALF, b0, b1); }
        else if (pn == 13) { bf16_t* o = VB + row * 256 + cit; st8bf(o, a0, a1); st8bf(o + HALF, b0, b1); }
        else { bf16_t* o = GT + row * 2048 + 256 * (pn - 14) + cit; st8bf(o, sig4(a0), sig4(a1)); st8bf(o + HALF, sig4(b0), sig4(b1)); }
    }
};
struct EpiMerge {
    static constexpr bool PERM = true, AFTER_DRAIN = false, MID_HOOK = true;
    unsigned char* R;
    __device__ __forceinline__ void operator()(const f32x4 (&acc)[2][2][4][2], const Unit& u, int wr, int wc, int fr, int fq) const { epi_rows(*this, acc, u, wr, wc, fr, fq); }
    __device__ __forceinline__ void mid(f32x4 (&acc)[2][2][4][2], const Unit& u, int wr, int wc, int fr, int fq) const {
        asm volatile("" : "+v"(fr), "+v"(fq));
        const bf16_t* GT = (const bf16_t*)(R + (112u << 20));
#pragma unroll
        for (int ai = 0; ai < 2; ++ai)
#pragma unroll
            for (int m = 0; m < 4; ++m) { const size_t row = (size_t)u.po * BM + ai * HALF + wr * 64 + m * 16 + fr;
#pragma unroll
                for (int bj = 0; bj < 2; ++bj) { const int c = 256 * u.pn + bj * HALF + wc * 32 + 8 * fq; f32x4 g0a, g0b, g1a, g1b; ld8bf(GT + row * 2048 + c, g0a, g0b); ld8bf(GT + row * 2048 + 1024 + c, g1a, g1b);
#pragma unroll
                    for (int i = 0; i < 4; ++i) { acc[ai][bj][m][0][i] *= g0a[i] * frcp(fmaxf(g1a[i], 1e-30f)); acc[ai][bj][m][1][i] *= g0b[i] * frcp(fmaxf(g1b[i], 1e-30f)); } } }
    }
    __device__ __forceinline__ void row8(const Unit& u, int r, int cit, f32x4 a0, f32x4 a1, f32x4 b0, f32x4 b1) const {
        const size_t row = (size_t)u.po * BM + r; const int c = 256 * u.pn + cit;
        const bf16_t* GT = (const bf16_t*)(R + (112u << 20)); bf16_t* MG = (bf16_t*)(R + (304u << 20));
        f32x4 g0, g1; ld8bf(GT + row * 2048 + 1024 + c, g0, g1); st8bf(MG + row * 1024 + c, g0 * a0, g1 * a1);
        ld8bf(GT + row * 2048 + 1024 + c + HALF, g0, g1); st8bf(MG + row * 1024 + c + HALF, g0 * b0, g1 * b1);
    }
};
struct EpiBf16N { PG8_EPI_COMMON
    bf16_t* O;
    __device__ __forceinline__ void row8(const Unit& u, int r, int cit, f32x4 a0, f32x4 a1, f32x4 b0, f32x4 b1) const {
        bf16_t* o = O + ((size_t)u.po * BM + r) * 1024 + 256 * u.pn + cit; st8bf(o, a0, a1); st8bf(o + HALF, b0, b1);
    }
};
struct EpiF32 { PG8_EPI_COMMON
    float* O;
    __device__ __forceinline__ void row8(const Unit& u, int r, int cit, f32x4 a0, f32x4 a1, f32x4 b0, f32x4 b1) const {
        float* o = O + ((size_t)u.po * BM + r) * 1024 + 256 * u.pn + cit; *(f32x4*)o = a0; *(f32x4*)(o + 4) = a1; *(f32x4*)(o + HALF) = b0; *(f32x4*)(o + HALF + 4) = b1;
    }
};
struct EpiSwiglu { PG8_EPI_COMMON
    bf16_t* O; int ldc, ntile;
    __device__ __forceinline__ void row8(const Unit& u, int r, int cit, f32x4 a0, f32x4 a1, f32x4 b0, f32x4 b1) const {
        st8bf(O + ((size_t)u.po * BM + r) * ldc + HALF * (u.pn % ntile) + cit, silu4(a0) * b0, silu4(a1) * b1);
    }
};
struct EpiSwiglu8 { PG8_EPI_COMMON
    unsigned char* O; int ldc, ntile;
    __device__ __forceinline__ void row8(const Unit& u, int r, int cit, f32x4 a0, f32x4 a1, f32x4 b0, f32x4 b1) const {
        u32x2 w; w.x = pk4fp8(silu4(a0) * b0); w.y = pk4fp8(silu4(a1) * b1); *(u32x2*)(O + ((size_t)u.po * BM + r) * ldc + HALF * (u.pn % ntile) + cit) = w;
    }
};
struct EpiBf16Mod4 { PG8_EPI_COMMON
    bf16_t* O;
    __device__ __forceinline__ void row8(const Unit& u, int r, int cit, f32x4 a0, f32x4 a1, f32x4 b0, f32x4 b1) const {
        bf16_t* o = O + ((size_t)u.po * BM + r) * 1024 + 256 * (u.pn & 3) + cit; st8bf(o, a0, a1); st8bf(o + HALF, b0, b1);
    }
};


struct PanelSS {
    float* xbuf;
    unsigned* cnt;
    unsigned* tmo;
    __device__ __forceinline__ void run(const f32x4 (&v)[2][2][4][2], const Unit& u, int wr, int wc, int fr, int fq, PG8_LAS unsigned char* lds, int wid, int lane) const {
        PG8_LAS float* P = (PG8_LAS float*)lds;
        PG8_LAS float* S = (PG8_LAS float*)(lds + 8192);
        PG8_LAS unsigned* flag = (PG8_LAS unsigned*)(lds + 8192 + 2048);
#pragma unroll
        for (int ai = 0; ai < 2; ++ai)
#pragma unroll
            for (int m = 0; m < 4; ++m) { float s = 0.f;
#pragma unroll
                for (int bj = 0; bj < 2; ++bj)
#pragma unroll
                    for (int n = 0; n < 2; ++n) { const f32x4 x = v[ai][bj][m][n]; s += (x[0] * x[0] + x[1] * x[1]) + (x[2] * x[2] + x[3] * x[3]); }
                s += __shfl_xor(s, 16); s += __shfl_xor(s, 32);
                if (fq == 0) P[(ai * HALF + wr * 64 + m * 16 + fr) * 4 + wc] = s; }
        asm volatile("s_waitcnt lgkmcnt(0)" ::: "memory"); __builtin_amdgcn_s_barrier(); asm volatile("" ::: "memory");
        const int row = wid * 32 + (lane & 31);
        if (lane < 32) { const f32x4 p = *(const PG8_LAS f32x4*)(P + row * 4);
            __hip_atomic_store((unsigned*)xbuf + ((size_t)(u.pm * BM + row) * 4 + u.pn), __float_as_uint((p[0] + p[1]) + (p[2] + p[3])), __ATOMIC_RELAXED, __HIP_MEMORY_SCOPE_AGENT); }
        asm volatile("s_waitcnt vmcnt(0)" ::: "memory");
        if (lane == 0) __hip_atomic_fetch_add(cnt + 64 * u.pm, 1u, __ATOMIC_RELAXED, __HIP_MEMORY_SCOPE_AGENT);
        if (wid == 0) {
            const unsigned long long t0 = __builtin_amdgcn_s_memrealtime();
            for (;;) {
                if ((unsigned)__builtin_amdgcn_readfirstlane((int)__hip_atomic_load(cnt + 64 * u.pm, __ATOMIC_RELAXED, __HIP_MEMORY_SCOPE_AGENT)) >= 32u) break;
                if (__builtin_amdgcn_s_memrealtime() - t0 > 2000000ull) { if (lane == 0) __hip_atomic_store(tmo, 1u, __ATOMIC_RELAXED, __HIP_MEMORY_SCOPE_AGENT); break; }
                __builtin_amdgcn_s_sleep(2);
            }
            __builtin_amdgcn_fence(__ATOMIC_ACQUIRE, "agent");
            if (lane == 0) flag[0] = 0u;
        }
        asm volatile("s_waitcnt vmcnt(0) lgkmcnt(0)" ::: "memory"); __builtin_amdgcn_s_barrier(); asm volatile("" ::: "memory");
        if (lane < 32) { const unsigned* slot = (const unsigned*)xbuf + (size_t)(u.pm * BM + row) * 4; float t = 0.f;
#pragma unroll
            for (int k = 0; k < 4; ++k) t += __uint_as_float(__hip_atomic_load(slot + k, __ATOMIC_RELAXED, __HIP_MEMORY_SCOPE_AGENT));
            S[row] = rsqrtf(t * (1.0f / 1024.0f) + 1e-6f); }
        asm volatile("s_waitcnt lgkmcnt(0)" ::: "memory"); __builtin_amdgcn_s_barrier(); asm volatile("" ::: "memory");
    }
};
struct EpiRmsResRms {
    static constexpr bool PERM = true, AFTER_DRAIN = true, MID_HOOK = false;
    const float* xin32; const bf16_t* xin16;
    bf16_t* XB; bf16_t* XN; int xn_fp8;
    const float *gainA, *gateA, *gainB, *scB, *shB;
    PanelSS st1, st2;
    __device__ __forceinline__ void fused(f32x4 (&acc)[2][2][4][2], const Unit& u, int wr, int wc, int fr, int fq, PG8_LAS unsigned char* lds, int wid, int lane) const {
        asm volatile("" : "+v"(fr), "+v"(fq));
        const PG8_LAS float* S = (const PG8_LAS float*)(lds + 8192);
        const int bofs = (((u.pm * BM) >> 13) != 0) ? 6144 : 0;
        const int col0 = 256 * u.pn + wc * 32 + 8 * fq;
        st1.run(acc, u, wr, wc, fr, fq, lds, wid, lane);
        { f32x4 cA[2][2];
#pragma unroll
          for (int bj = 0; bj < 2; ++bj)
#pragma unroll
            for (int n = 0; n < 2; ++n) cA[bj][n] = *(const f32x4*)(gainA + col0 + bj * HALF + 4 * n) * *(const f32x4*)(gateA + bofs + col0 + bj * HALF + 4 * n);
#pragma unroll
          for (int ai = 0; ai < 2; ++ai)
#pragma unroll
            for (int m = 0; m < 4; ++m) { const int r = ai * HALF + wr * 64 + m * 16 + fr; const float rs = S[r]; const size_t off = (size_t)(u.pm * BM + r) * 1024 + col0;
#pragma unroll
                for (int bj = 0; bj < 2; ++bj) { f32x4 x0, x1;
                    if (xin32) { x0 = *(const f32x4*)(xin32 + off + bj * HALF); x1 = *(const f32x4*)(xin32 + off + bj * HALF + 4); } else ld8bf(xin16 + off + bj * HALF, x0, x1);
                    acc[ai][bj][m][0] = x0 + cA[bj][0] * (acc[ai][bj][m][0] * rs); acc[ai][bj][m][1] = x1 + cA[bj][1] * (acc[ai][bj][m][1] * rs);
                    st8bf(XB + off + bj * HALF, acc[ai][bj][m][0], acc[ai][bj][m][1]); }
                asm volatile("" : "+v"(acc[ai][0][m][0]), "+v"(acc[ai][0][m][1]), "+v"(acc[ai][1][m][0]), "+v"(acc[ai][1][m][1])); } }
        st2.run(acc, u, wr, wc, fr, fq, lds, wid, lane);
        { f32x4 cB[2][2], cC[2][2];
#pragma unroll
          for (int bj = 0; bj < 2; ++bj)
#pragma unroll
            for (int n = 0; n < 2; ++n) { cB[bj][n] = *(const f32x4*)(gainB + col0 + bj * HALF + 4 * n) * (*(const f32x4*)(scB + bofs + col0 + bj * HALF + 4 * n) + 1.0f); cC[bj][n] = *(const f32x4*)(shB + bofs + col0 + bj * HALF + 4 * n); }
#pragma unroll
          for (int ai = 0; ai < 2; ++ai)
#pragma unroll
            for (int m = 0; m < 4; ++m) { const int r = ai * HALF + wr * 64 + m * 16 + fr; const float rs = S[r]; const size_t off = (size_t)(u.pm * BM + r) * 1024 + col0;
#pragma unroll
                for (int bj = 0; bj < 2; ++bj) { const f32x4 h0 = acc[ai][bj][m][0] * rs * cB[bj][0] + cC[bj][0], h1 = acc[ai][bj][m][1] * rs * cB[bj][1] + cC[bj][1];
                    if (xn_fp8) { u32x2 w; w.x = pk4fp8(h0); w.y = pk4fp8(h1); *(u32x2*)((unsigned char*)XN + off + bj * HALF) = w; } else st8bf(XN + off + bj * HALF, h0, h1); } } }
    }
};
template <class Epi, class Sched>
__device__ __forceinline__ void gemm_phase_naive(const Gemm g, const Sched& S, const Epi& E) {
    Unit u;
    for (int i = 0; S.next(i, u); ++i) {
        for (int idx = threadIdx.x; idx < 256 * 16; idx += blockDim.x) {
            const int r = idx >> 4, cit = (idx & 15) * 8;
            const bf16_t* a = g.A + ((size_t)u.pm * BM + r) * g.K;
            float o[16];
#pragma unroll
            for (int j = 0; j < 16; ++j) o[j] = 0.f;
            for (int k = 0; k < g.K; k += 8) {
                f32x4 x0, x1; ld8bf(a + k, x0, x1);
#pragma unroll
                for (int j = 0; j < 16; ++j) { const bf16_t* b = g.Bt + ((size_t)u.pn * BM + (j >> 3) * HALF + cit + (j & 7)) * g.K + k; f32x4 y0, y1; ld8bf(b, y0, y1);
                    o[j] += x0[0] * y0[0] + x0[1] * y0[1] + x0[2] * y0[2] + x0[3] * y0[3] + x1[0] * y1[0] + x1[1] * y1[1] + x1[2] * y1[2] + x1[3] * y1[3]; }
            }
            E.row8(u, r, cit, (f32x4){o[0], o[1], o[2], o[3]}, (f32x4){o[4], o[5], o[6], o[7]}, (f32x4){o[8], o[9], o[10], o[11]}, (f32x4){o[12], o[13], o[14], o[15]});
        }
    }
}

template <class Epi, class Sched, bool ALIGN_EPI = false, bool SP2 = false, bool FP8 = false>
__device__ __forceinline__ void gemm_phase(PG8_LAS unsigned char* lds, const Gemm g, const Sched& S, const Epi& E) {
    int tid_ = threadIdx.x; asm volatile("" : "+v"(tid_));
    const int tid = tid_, wid = __builtin_amdgcn_readfirstlane(tid >> 6), lane = tid & 63, wr = wid >> 2, wc = wid & 3, fr = lane & 15, fq = lane >> 4;
    constexpr int ESZ = FP8 ? 1 : 2;
    const int K = g.K, nt = K * ESZ / (BK * 2);
    unsigned voffA[2], voffB[2];
#pragma unroll
    for (int i = 0; i < 2; ++i) { int R, C; stage_rc(tid * 16 + i * 8192, R, C); const int Rb = Epi::PERM ? ((R & ~31) + perm32(R & 31)) : R;
        voffA[i] = (unsigned)(R * K * ESZ + C * 2); voffB[i] = (unsigned)(Rb * K * ESZ + C * 2); }
    const size_t kstep = (size_t)(BK * 2);
    const size_t hstep = (size_t)HALF * K * ESZ;
    const size_t tstep = 2 * hstep;
    const unsigned ldsw = (unsigned)wid * 1024u;
    const int aoff = lds_byte(wr * 64 + fr, FP8 ? fq * 16 : fq * 8), boff = lds_byte(wc * 32 + fr, FP8 ? fq * 16 : fq * 8);
#define PG8_SA(b, h) (((b) * 2 + (h)) * HTB)
#define PG8_SB(b, h) ((4 + (b) * 2 + (h)) * HTB)
#define PG8_STAGE(bufoff, gbase, voff) do { _Pragma("unroll") for (int _i = 0; _i < 2; ++_i) \
        __builtin_amdgcn_global_load_lds((const unsigned*)((const char*)(gbase) + (voff)[_i]), (PG8_LAS unsigned*)(lds + (bufoff) + ldsw + _i * 8192), 16, 0, 0); } while (0)
#define PG8_LDA(dst, b, h) do { _Pragma("unroll") for (int m = 0; m < 4; ++m) { if constexpr (FP8) dst##8[m] = cat8(*(const PG8_LAS bf16x8*)(lds + PG8_SA(b, h) + aoff + m * 2048), *(const PG8_LAS bf16x8*)(lds + PG8_SA(b, h) + aoff + m * 2048 + 16)); \
        else { _Pragma("unroll") for (int k = 0; k < 2; ++k) dst[m][k] = *(const PG8_LAS bf16x8*)(lds + PG8_SA(b, h) + aoff + m * 2048 + k * 1024); } } } while (0)
#define PG8_LDB(dst, b, h) do { _Pragma("unroll") for (int n = 0; n < 2; ++n) { if constexpr (FP8) dst##8[n] = cat8(*(const PG8_LAS bf16x8*)(lds + PG8_SB(b, h) + boff + n * 2048), *(const PG8_LAS bf16x8*)(lds + PG8_SB(b, h) + boff + n * 2048 + 16)); \
        else { _Pragma("unroll") for (int k = 0; k < 2; ++k) dst[n][k] = *(const PG8_LAS bf16x8*)(lds + PG8_SB(b, h) + boff + n * 2048 + k * 1024); } } } while (0)
#define PG8_MMA(ai, bj, At, Bt) do { __builtin_amdgcn_s_setprio(1); _Pragma("unroll") for (int m = 0; m < 4; ++m) _Pragma("unroll") for (int n = 0; n < 2; ++n) { \
        if constexpr (FP8) asm volatile("v_mfma_scale_f32_16x16x128_f8f6f4 %0, %1, %2, %0, %3, %4 op_sel_hi:[0,0,0]" : "+v"(acc[ai][bj][m][n]) : "v"(Bt##8[n]), "v"(At##8[m]), "v"(sw_), "v"(sa_)); \
        else { _Pragma("unroll") for (int k = 0; k < 2; ++k) acc[ai][bj][m][n] = __builtin_amdgcn_mfma_f32_16x16x32_bf16(Bt[n][k], At[m][k], acc[ai][bj][m][n], 0, 0, 0); } } \
        __builtin_amdgcn_s_setprio(0); } while (0)
#define PG8_WAIT_V(n) asm volatile("s_waitcnt vmcnt(" #n ")" ::: "memory")
#define PG8_WAIT_L(n) asm volatile("s_waitcnt lgkmcnt(" #n ")" ::: "memory")
#define PG8_BAR __builtin_amdgcn_s_barrier()
#define PG8_SCHED __builtin_amdgcn_sched_barrier(0)
    Unit cur, nxt; int ui = 0;
    if (!S.next(0, cur)) return;
    f32x4 acc[2][2][4][2];
#pragma unroll
    for (int a = 0; a < 2; ++a)
#pragma unroll
        for (int b = 0; b < 2; ++b)
#pragma unroll
            for (int m = 0; m < 4; ++m)
#pragma unroll
                for (int n = 0; n < 2; ++n) acc[a][b][m][n] = (f32x4){0.f, 0.f, 0.f, 0.f};
    const int sw_ = g.sw, sa_ = g.sa;
    bf16x8 At[4][2], B0[2][2], B1[2][2]; i32x8 At8[4], B08[2], B18[2];
    const char* cA = (const char*)g.A + (size_t)cur.pm * tstep; const char* cB = (const char*)g.Bt + (size_t)cur.pn * tstep;
    S.a_ready(cur);
    if constexpr (SP2) {
        PG8_STAGE(PG8_SB(0, 0), cB, voffB); PG8_STAGE(PG8_SB(0, 1), cB + hstep, voffB); PG8_STAGE(PG8_SA(0, 0), cA, voffA); PG8_STAGE(PG8_SA(0, 1), cA + hstep, voffA);
        if (wr == 1) PG8_BAR;
        PG8_WAIT_V(2); PG8_BAR;
        PG8_STAGE(PG8_SB(1, 0), cB + kstep, voffB); PG8_STAGE(PG8_SA(1, 0), cA + kstep, voffA); PG8_STAGE(PG8_SB(1, 1), cB + hstep + kstep, voffB);
        PG8_WAIT_V(6); PG8_BAR;
    } else {
        PG8_STAGE(PG8_SB(0, 0), cB, voffB); PG8_STAGE(PG8_SA(0, 0), cA, voffA); PG8_STAGE(PG8_SB(0, 1), cB + hstep, voffB); PG8_STAGE(PG8_SA(0, 1), cA + hstep, voffA);
        if (wr == 1) PG8_BAR;
        PG8_WAIT_V(4); PG8_BAR;
        PG8_STAGE(PG8_SB(1, 0), cB + kstep, voffB); PG8_STAGE(PG8_SA(1, 0), cA + kstep, voffA); PG8_STAGE(PG8_SB(1, 1), cB + hstep + kstep, voffB);
        PG8_WAIT_V(6); PG8_BAR;
    }
    for (;;) {
        const bool has_next = S.next(ui + 1, nxt);
        const char* nA = has_next ? (const char*)g.A + (size_t)nxt.pm * tstep : cA; const char* nB = has_next ? (const char*)g.Bt + (size_t)nxt.pn * tstep : cB;
        for (int t = 0; t < nt; t += 2) {
            if constexpr (Epi::MID_HOOK && HOOK_ON) { if (t == (nt >> 1)) E.mid(acc, cur, wr, wc, fr, fq); }
            const bool last = (t == nt - 2);
            const char* a1 = cA + (size_t)(t + 1) * kstep;
            const char* a2 = last ? nA : cA + (size_t)(t + 2) * kstep; const char* b2 = last ? nB : cB + (size_t)(t + 2) * kstep;
            const char* a3 = a2 + kstep; const char* b3 = b2 + kstep;
            if (last && has_next) S.a_ready(nxt);
            if constexpr (SP2) {
            PG8_LDB(B0, 0, 0); PG8_LDB(B1, 0, 1); PG8_SCHED; PG8_LDA(At, 0, 0); PG8_STAGE(PG8_SA(1, 1), a1 + hstep, voffA);
            PG8_WAIT_V(8); PG8_WAIT_L(0); PG8_BAR; PG8_MMA(0, 0, At, B0); PG8_MMA(0, 1, At, B1); PG8_BAR; PG8_SCHED;
            PG8_LDA(At, 0, 1); PG8_STAGE(PG8_SB(0, 0), b2, voffB); PG8_STAGE(PG8_SB(0, 1), b2 + hstep, voffB); PG8_STAGE(PG8_SA(0, 0), a2, voffA);
            PG8_WAIT_V(8); PG8_WAIT_L(0); PG8_BAR; PG8_MMA(1, 0, At, B0); PG8_MMA(1, 1, At, B1); PG8_BAR; PG8_SCHED;
            PG8_LDB(B0, 1, 0); PG8_LDB(B1, 1, 1); PG8_SCHED; PG8_LDA(At, 1, 0); PG8_STAGE(PG8_SA(0, 1), a2 + hstep, voffA);
            PG8_WAIT_V(8); PG8_WAIT_L(0); PG8_BAR; PG8_MMA(0, 0, At, B0); PG8_MMA(0, 1, At, B1); PG8_BAR; PG8_SCHED;
            PG8_LDA(At, 1, 1); PG8_STAGE(PG8_SB(1, 0), b3, voffB); PG8_STAGE(PG8_SB(1, 1), b3 + hstep, voffB); PG8_STAGE(PG8_SA(1, 0), a3, voffA);
            PG8_WAIT_V(8); PG8_WAIT_L(0); PG8_BAR; PG8_MMA(1, 0, At, B0); PG8_MMA(1, 1, At, B1); PG8_BAR; PG8_SCHED;
            } else {
            PG8_LDB(B0, 0, 0); PG8_SCHED; PG8_LDA(At, 0, 0); PG8_STAGE(PG8_SA(1, 1), a1 + hstep, voffA);
            PG8_WAIT_L(8); PG8_BAR; PG8_WAIT_L(0); PG8_MMA(0, 0, At, B0); PG8_BAR; PG8_SCHED;
            PG8_LDB(B1, 0, 1); PG8_STAGE(PG8_SB(0, 0), b2, voffB);
            PG8_BAR; PG8_WAIT_L(0); PG8_MMA(0, 1, At, B1); PG8_BAR;
            PG8_LDA(At, 0, 1); PG8_STAGE(PG8_SA(0, 0), a2, voffA);
            PG8_BAR; PG8_WAIT_L(0); PG8_MMA(1, 0, At, B0); PG8_BAR; PG8_SCHED;
            PG8_STAGE(PG8_SB(0, 1), b2 + hstep, voffB);
            PG8_WAIT_V(6); PG8_BAR; PG8_MMA(1, 1, At, B1); PG8_BAR;
            PG8_LDB(B0, 1, 0); PG8_SCHED; PG8_LDA(At, 1, 0); PG8_STAGE(PG8_SA(0, 1), a2 + hstep, voffA);
            PG8_WAIT_L(8); PG8_BAR; PG8_WAIT_L(0); PG8_MMA(0, 0, At, B0); PG8_BAR; PG8_SCHED;
            PG8_LDB(B1, 1, 1); PG8_STAGE(PG8_SB(1, 0), b3, voffB);
            PG8_BAR; PG8_WAIT_L(0); PG8_MMA(0, 1, At, B1); PG8_BAR;
            PG8_LDA(At, 1, 1); PG8_STAGE(PG8_SA(1, 0), a3, voffA);
            PG8_BAR; PG8_WAIT_L(0); PG8_MMA(1, 0, At, B0); PG8_BAR; PG8_SCHED;
            PG8_STAGE(PG8_SB(1, 1), b3 + hstep, voffB);
            PG8_WAIT_V(6); PG8_BAR; PG8_MMA(1, 1, At, B1); PG8_BAR;
            }
        }
        if constexpr (ALIGN_EPI) { if (wr == 0) PG8_BAR; }
        if constexpr (FP8) asm volatile("s_nop 15\n\ts_nop 15" ::: "memory");
        if constexpr (!Epi::AFTER_DRAIN) { E(acc, cur, wr, wc, fr, fq); S.done(cur); }
        if (!has_next) break;
#pragma unroll
        for (int a = 0; a < 2; ++a)
#pragma unroll
            for (int b = 0; b < 2; ++b)
#pragma unroll
                for (int m = 0; m < 4; ++m)
#pragma unroll
                    for (int n = 0; n < 2; ++n) acc[a][b][m][n] = (f32x4){0.f, 0.f, 0.f, 0.f};
        cur = nxt; cA = nA; cB = nB; ++ui;
        if constexpr (ALIGN_EPI) { if (wr == 1) PG8_BAR; }
    }
    PG8_WAIT_V(0);
    if constexpr (!ALIGN_EPI) { if (wr == 0) PG8_BAR; }
    PG8_BAR;
    if constexpr (Epi::AFTER_DRAIN) { if constexpr (FP8) asm volatile("s_nop 15\n\ts_nop 15" ::: "memory"); E.fused(acc, cur, wr, wc, fr, fq, lds, wid, lane); S.done(cur); }
#undef PG8_SA
#undef PG8_SB
#undef PG8_STAGE
#undef PG8_LDA
#undef PG8_LDB
#undef PG8_MMA
#undef PG8_WAIT_V
#undef PG8_WAIT_L
#undef PG8_BAR
#undef PG8_SCHED
}
}

constexpr int NWAVES = 8;
constexpr size_t MiB = 1u << 20;
constexpr size_t WS_CTL = 0, CTL_ZERO_BYTES = 1 * MiB;
constexpr size_t WS_ADA = 1 * MiB;
constexpr size_t WS_RAGG = 2 * MiB;
constexpr size_t WS_MIX = 288 * MiB; constexpr size_t WS_T16 = WS_MIX;
constexpr size_t WS_TOK = 3 * MiB;
constexpr size_t WS_WL = 4 * MiB, WL_STRIDE = 18 * MiB;
constexpr size_t WL_WIN = 0, WL_WB = 11 * MiB, WL_WO = 15 * MiB, WL_WRA = 17 * MiB, WL_WRX = 17 * MiB + 256 * 1024;
constexpr size_t WS_WD = 76 * MiB, WD_STRIDE = 18 * MiB;
constexpr size_t WD_FIN = 0, WD_FOUT = 12 * MiB;
constexpr size_t WS_WM = 112 * MiB, WM_STRIDE = 72 * MiB;
constexpr size_t WM_MIN = 0, WM_MOUT = 48 * MiB;
constexpr size_t WS_XN = 256 * MiB;
constexpr size_t WS_R = 352 * MiB;
constexpr size_t WS_XR = WS_R, WS_GG = WS_R + 32 * MiB, WS_Q = WS_R + 64 * MiB, WS_KB = WS_R + 96 * MiB, WS_VB = WS_R + 104 * MiB, WS_GT = WS_R + 112 * MiB;
constexpr size_t WS_RO = WS_R + 176 * MiB, WS_AO = WS_R + 208 * MiB, WS_MGP = WS_R + 240 * MiB, WS_MG = WS_R + 304 * MiB;
constexpr size_t WS_PS = WS_MGP;
constexpr size_t WS_XC = WS_MG;
constexpr size_t WS_ACT = WS_R;
constexpr size_t WS_AP = WS_R;
constexpr size_t WS_YP = WS_R;
constexpr size_t WS_ACTP = WS_R + 256 * MiB;
constexpr size_t WS_XB = WS_ACTP + 102 * MiB;
constexpr size_t WS_XS = WS_XB + 32 * MiB;
constexpr size_t WS_END = WS_XS + 2 * MiB;
constexpr int MAXPANELS = 136;

constexpr int CW_CNT = 64;
constexpr int CW_BAR = 4096;
constexpr int CW_SEAM = 16384, SEAM_BANK = 8192;
static_assert((CW_SEAM + 8 * SEAM_BANK) * 4 <= (int)CTL_ZERO_BYTES, "panel counters inside the memset region");

constexpr int RING_OFF = 0, RING_BYTES = 139264;
constexpr int LDSCTL_OFF = RING_BYTES, MISC_OFF = LDSCTL_OFF + 320;
constexpr int LDS_BYTES = 147456;

#define XB_TMO      128
#define XB_XCNT(j)  (256  + 64 * (j))
#define XB_XSUB(j)  (1280 + 64 * (j))
#define XB_XGEN(j)  (2304 + 64 * (j))
#define XB_TOP      3328
#define XB_TOPGEN   3392
#define XCD_BAR_WORDS 3456
#define XB_SPIN_CAP (1u << 18)

__device__ __forceinline__ unsigned xb_ld(unsigned* p)              { return __hip_atomic_load(p, __ATOMIC_RELAXED, __HIP_MEMORY_SCOPE_AGENT); }
__device__ __forceinline__ unsigned xb_add(unsigned* p, unsigned v) { return __hip_atomic_fetch_add(p, v, __ATOMIC_RELAXED, __HIP_MEMORY_SCOPE_AGENT); }
__device__ __forceinline__ unsigned xb_xcc_id() { return (unsigned)__builtin_amdgcn_s_getreg((3 << 11) | 20) & 0xFu; }
#define XB_SPIN(cond, bar) do { unsigned _sp = 0; while (cond) { __builtin_amdgcn_s_sleep(1); \
    if ((++_sp & 255u) == 0u) { if (xb_ld(&(bar)[XB_TMO])) break; if (_sp > XB_SPIN_CAP) { atomicAdd(&(bar)[XB_TMO], 1u); break; } } } } while (0)

struct XcdBarrier {
    unsigned* bar; unsigned x;
    volatile LAS unsigned* st;
};

__device__ __forceinline__ XcdBarrier xcd_barrier_post(unsigned* bar, volatile LAS unsigned* st) {
    XcdBarrier b; b.bar = bar; b.x = xb_xcc_id(); b.st = st;
    if (threadIdx.x == 0) (void)xb_add(&bar[XB_XCNT(b.x)], 1u);
    return b;
}
__device__ __forceinline__ void xcd_barrier_complete(unsigned* bar, unsigned x, unsigned& nloc, unsigned& nx) {
    const unsigned G = gridDim.x * gridDim.y * gridDim.z;
    unsigned sum, cnt, mine, sp = 0u;
    for (;;) {
        sum = 0u; cnt = 0u; mine = 0u;
#pragma unroll
        for (unsigned j = 0; j < 16; ++j) { const unsigned c = xb_ld(&bar[XB_XCNT(j)]); sum += c; cnt += (c > 0u) ? 1u : 0u; mine = (j == x) ? c : mine; }
        if (sum == G) break;
        __builtin_amdgcn_s_sleep(1);
        if ((++sp & 255u) == 0u) { if (xb_ld(&bar[XB_TMO])) break; if (sp > XB_SPIN_CAP) { atomicAdd(&bar[XB_TMO], 1u); break; } }
    }
    nloc = mine > 0u ? mine : 1u; nx = cnt > 0u ? cnt : 1u;
}

__device__ __forceinline__ void xcd_barrier(const XcdBarrier& b) {
    asm volatile("s_waitcnt vmcnt(0)" ::: "memory");
    __syncthreads();
    if (threadIdx.x == 0) {
        unsigned* bar = b.bar;
        __builtin_amdgcn_s_waitcnt(0);
        unsigned nloc = b.st[0], nx = b.st[1];
        if (nloc == 0u) { xcd_barrier_complete(bar, b.x, nloc, nx); b.st[0] = nloc; b.st[1] = nx; }
        const unsigned old = xb_add(&bar[XB_XSUB(b.x)], 1u);
        const unsigned gen = old / nloc;
        if (old + 1u == (gen + 1u) * nloc) {
            __builtin_amdgcn_fence(__ATOMIC_RELEASE, "agent");
            asm volatile("s_waitcnt vmcnt(0)" ::: "memory");
            const unsigned og = xb_add(&bar[XB_TOP], 1u);
            const unsigned tg = og / nx;
            if (og + 1u == (tg + 1u) * nx) xb_add(&bar[XB_TOPGEN], 1u);
            else XB_SPIN(xb_ld(&bar[XB_TOPGEN]) == tg, bar);
            __builtin_amdgcn_fence(__ATOMIC_ACQUIRE, "agent");
            xb_add(&bar[XB_XGEN(b.x)], 1u);
            asm volatile("s_waitcnt vmcnt(0)" ::: "memory");
        } else {
            XB_SPIN(xb_ld(&bar[XB_XGEN(b.x)]) == gen, bar);
            __builtin_amdgcn_fence(__ATOMIC_ACQUIRE, "agent");
            asm volatile("s_waitcnt vmcnt(0)" ::: "memory");
        }
    }
    __syncthreads();
}
struct Args { const float* in[24]; float* out; unsigned char* ws; int ph_lo, ph_hi; };
typedef const __attribute__((address_space(4))) unsigned char* kargp_t;
DI kargp_t kargs() { kargp_t p = (kargp_t)__builtin_amdgcn_kernarg_segment_ptr(); asm volatile("" : "+s"(p)); return p; }
DI const float* karg_in(kargp_t p, int i) { return *(const float* const __attribute__((address_space(4)))*)(p + 8 * i); }
DI float* karg_out(kargp_t p) { return *(float* const __attribute__((address_space(4)))*)(p + 192); }
DI unsigned char* karg_ws(kargp_t p) { return *(unsigned char* const __attribute__((address_space(4)))*)(p + 200); }
static_assert(sizeof(Args) == 216, "kernarg offsets");

DI void p0_transpose_item(const float* W, int K, int N, bf16* WT, int mode, int H, LAS float* scr, int item, int lane, int ldk = 0, float mult = 1.0f) {
    if (ldk == 0) ldk = K;
    const int nblk = N / 32, kb = item / nblk, nb = item % nblk, k0 = 64 * kb, n0 = 32 * nb;
    int dr0 = n0;
    if (mode == 1) { if (n0 < H) dr0 = (n0 >> 7) * 256 + (n0 & 127); else { const int n1 = n0 - H; dr0 = (n1 >> 7) * 256 + 128 + (n1 & 127); } }
#pragma unroll 8
    for (int i = 0; i < 32; ++i) { const int kk = 2 * i + (lane >> 5); scr[kk * 33 + (lane & 31)] = __builtin_nontemporal_load(W + (size_t)(k0 + kk) * N + n0 + (lane & 31)) * mult; }
    LDS_WAIT(); asm volatile("" ::: "memory");
    const int c = lane & 7;
#pragma unroll
    for (int j = 0; j < 4; ++j) { const int n = (lane >> 3) + 8 * j; const LAS float* s = scr + (8 * c) * 33 + n;
        u32x4 o; o.x = pk2(s[0 * 33], s[1 * 33]); o.y = pk2(s[2 * 33], s[3 * 33]); o.z = pk2(s[4 * 33], s[5 * 33]); o.w = pk2(s[6 * 33], s[7 * 33]);
        *(GAS u32x4*)(WT + (size_t)(dr0 + n) * ldk + k0 + 8 * c) = o; }
    LDS_WAIT(); asm volatile("" ::: "memory");
}
DI void p0_transpose_item8(const float* W, int K, int N, unsigned char* WT, int mode, int H, float mult, LAS float* scr, int item, int lane) {
    const int nblk = N / 32, kb = item / nblk, nb = item % nblk, k0 = 64 * kb, n0 = 32 * nb;
    int dr0 = n0;
    if (mode == 1) { if (n0 < H) dr0 = (n0 >> 7) * 256 + (n0 & 127); else { const int n1 = n0 - H; dr0 = (n1 >> 7) * 256 + 128 + (n1 & 127); } }
#pragma unroll 8
    for (int i = 0; i < 32; ++i) { const int kk = 2 * i + (lane >> 5); scr[kk * 33 + (lane & 31)] = __builtin_nontemporal_load(W + (size_t)(k0 + kk) * N + n0 + (lane & 31)) * mult; }
    LDS_WAIT(); asm volatile("" ::: "memory");
#pragma unroll
    for (int j = 0; j < 2; ++j) { const int idx = lane + 64 * j, n = idx >> 2, c = idx & 3; const LAS float* s = scr + (16 * c) * 33 + n;
        u32x4 o;
        o.x = pg8::pk4fp8((f32x4){s[0 * 33], s[1 * 33], s[2 * 33], s[3 * 33]}); o.y = pg8::pk4fp8((f32x4){s[4 * 33], s[5 * 33], s[6 * 33], s[7 * 33]});
        o.z = pg8::pk4fp8((f32x4){s[8 * 33], s[9 * 33], s[10 * 33], s[11 * 33]}); o.w = pg8::pk4fp8((f32x4){s[12 * 33], s[13 * 33], s[14 * 33], s[15 * 33]});
        *(GAS u32x4*)(WT + (size_t)(dr0 + n) * K + k0 + 16 * c) = o; }
    LDS_WAIT(); asm volatile("" ::: "memory");
}
constexpr int CI_WIN = 16 * 176, CI_SQ = 16 * 32, CI_RG = 64, CI_LAYER = CI_WIN + 3 * CI_SQ + 2 * CI_RG;
constexpr int CI_FIN = 16 * 192, CI_FOUT = 48 * 32, CI_DENSE = CI_FIN + CI_FOUT;
constexpr int CI_MIN = 16 * 96, CI_MOUT = 24 * 32, CI_EXP = CI_MIN + CI_MOUT, CI_MOE = 8 * CI_EXP;
constexpr int CI_TOTAL = 4 * CI_LAYER + 2 * CI_DENSE + 2 * CI_MOE;
DI void p0_convert_item(kargp_t kp, int it, LAS float* scr, int lane) {
    unsigned char* ws = karg_ws(kp);
    if (it < 4 * CI_LAYER) {
        const int l = it / CI_LAYER; int r = it % CI_LAYER; unsigned char* wl = ws + WS_WL + (size_t)l * WL_STRIDE;
        if (r < CI_WIN) { p0_transpose_item(karg_in(kp, 8) + (size_t)l * 1024 * D_IN, 1024, D_IN, (bf16*)(wl + WL_WIN), 0, 0, scr, r, lane); return; } r -= CI_WIN;
        if (r < 2 * CI_SQ) { const int br = r / CI_SQ; p0_transpose_item(karg_in(kp, 17) + (size_t)(l * 2 + br) * 1024 * 1024, 1024, 1024, (bf16*)(wl + WL_WB) + (size_t)br * 1024, 0, 0, scr, r % CI_SQ, lane, 2048); return; }   r -= 2 * CI_SQ;
        if (r < CI_SQ) { p0_transpose_item(karg_in(kp, 18) + (size_t)l * 1024 * 1024, 1024, 1024, (bf16*)(wl + WL_WO), 0, 0, scr, r, lane); return; } r -= CI_SQ;
        if (r < CI_RG) { const int nb = r >> 3; p0_transpose_item(karg_in(kp, 11) + (size_t)(l * 8 + nb) * 16384, 128, 128, (bf16*)(wl + WL_WRA) + nb * 16384, 0, 0, scr, r & 7, lane, 0, -LOG2E); return; }     r -= CI_RG;
        { const int nb = r >> 3; p0_transpose_item(karg_in(kp, 13) + (size_t)(l * 8 + nb) * 16384, 128, 128, (bf16*)(wl + WL_WRX) + nb * 16384, 0, 0, scr, r & 7, lane, 0, -LOG2E); return; }
    }
    it -= 4 * CI_LAYER;
    if (it < 2 * CI_DENSE) {
        const int j = it / CI_DENSE; int r = it % CI_DENSE; unsigned char* wd = ws + WS_WD + (size_t)j * WD_STRIDE;
        const bool f8 = (FP8_LAYERS >> (2 * j)) & 1u;
        if (r < CI_FIN) { if (f8) p0_transpose_item8(karg_in(kp, 19) + (size_t)j * 1024 * 6144, 1024, 6144, wd + WD_FIN, 1, 3072, 32.0f, scr, r, lane); else p0_transpose_item(karg_in(kp, 19) + (size_t)j * 1024 * 6144, 1024, 6144, (bf16*)(wd + WD_FIN), 1, 3072, scr, r, lane); return; } r -= CI_FIN;
        if (f8) p0_transpose_item8(karg_in(kp, 20) + (size_t)j * 3072 * 1024, 3072, 1024, wd + WD_FOUT, 0, 0, 64.0f, scr, r, lane); else p0_transpose_item(karg_in(kp, 20) + (size_t)j * 3072 * 1024, 3072, 1024, (bf16*)(wd + WD_FOUT), 0, 0, scr, r, lane); return;
    }
    it -= 2 * CI_DENSE;
    {
        const int j = it / CI_MOE; int r = it % CI_MOE; const int e = r / CI_EXP; r %= CI_EXP; unsigned char* wm = ws + WS_WM + (size_t)j * WM_STRIDE;
        const bool f8 = (FP8_LAYERS >> (2 * j + 1)) & 1u;
        if (r < CI_MIN) { if (f8) p0_transpose_item8(karg_in(kp, 22) + (size_t)(j * 8 + e) * 1024 * 3072, 1024, 3072, wm + WM_MIN + (size_t)e * 3072 * 1024, 1, 1536, 32.0f, scr, r, lane); else p0_transpose_item(karg_in(kp, 22) + (size_t)(j * 8 + e) * 1024 * 3072, 1024, 3072, (bf16*)(wm + WM_MIN) + (size_t)e * 3072 * 1024, 1, 1536, scr, r, lane); return; } r -= CI_MIN;
        if (f8) p0_transpose_item8(karg_in(kp, 23) + (size_t)(j * 8 + e) * 1536 * 1024, 1536, 1024, wm + WM_MOUT + (size_t)e * 1024 * 1536, 0, 0, 32.0f, scr, r, lane); else p0_transpose_item(karg_in(kp, 23) + (size_t)(j * 8 + e) * 1536 * 1024, 1536, 1024, (bf16*)(wm + WM_MOUT) + (size_t)e * 1024 * 1536, 0, 0, scr, r, lane);
    }
}
DI void p0_prologue(LAS unsigned char* lds, int tid, int wave, int lane) {
    const kargp_t kp = kargs();
    LAS float* cact = (LAS float*)lds; LAS float* red = (LAS float*)(lds + 8192);
    float* ADA = (float*)(karg_ws(kp) + WS_ADA);
    for (int i = tid; i < 2 * D; i += NWAVES * 64) { const float c = karg_in(kp, 1)[i]; cact[i] = c / (1.0f + expf(-c)); }
    __syncthreads();
    const int col = tid & 31, ks = tid >> 5;
    for (int it = blockIdx.x; it < 4 * 192; it += gridDim.x) {
        const int l = it / 192, n0 = (it % 192) * 32;
        const float* w = karg_in(kp, 2) + (size_t)l * 1024 * 6144 + (size_t)(ks * 64) * 6144 + n0 + col;
        float s0 = 0.f, s1 = 0.f;
#pragma unroll 32
        for (int k = 0; k < 64; ++k) { const float wv = __builtin_nontemporal_load(w + (size_t)k * 6144); s0 += cact[ks * 64 + k] * wv; s1 += cact[1024 + ks * 64 + k] * wv; }
        red[(ks * 2 + 0) * 32 + col] = s0; red[(ks * 2 + 1) * 32 + col] = s1;
        __syncthreads();
        if (tid < 64) { const int b = tid >> 5, c2 = tid & 31; float s = karg_in(kp, 3)[l * 6144 + n0 + c2];
#pragma unroll
            for (int k2 = 0; k2 < 16; ++k2) s += red[(k2 * 2 + b) * 32 + c2];
            ADA[(l * 2 + b) * 6144 + n0 + c2] = s; }
        __syncthreads();
    }
    __syncthreads();
    LAS float* scr = (LAS float*)(lds + wave * 16384);
    const int gw = blockIdx.x * NWAVES + wave, NGW = gridDim.x * NWAVES;
    for (int it = gw; it < CI_TOTAL; it += NGW) p0_convert_item(kp, it, scr, lane);
}

DI int vcu_index() { const int G = (int)gridDim.x, bx = (int)blockIdx.x; return (G % 8 == 0) ? (bx % 8) * (G / 8) + bx / 8 : bx; }
DI float row_ss(const f32x4 (&v)[4]) { float s = 0.f;
#pragma unroll
    for (int j = 0; j < 4; ++j) s += (v[j].x * v[j].x + v[j].y * v[j].y) + (v[j].z * v[j].z + v[j].w * v[j].w);
    return wave_sum(s); }
DI void ld_row(const float* p, int lane, f32x4 (&v)[4]) {
#pragma unroll
    for (int j = 0; j < 4; ++j) v[j] = *(const f32x4*)(p + 256 * j + 4 * lane); }
DI void st_row(float* p, int lane, const f32x4 (&v)[4]) {
#pragma unroll
    for (int j = 0; j < 4; ++j) *(f32x4*)(p + 256 * j + 4 * lane) = v[j]; }
DI void st_row_f8(unsigned char* p, int lane, const f32x4 (&v)[4]) {
#pragma unroll
    for (int j = 0; j < 4; ++j) *(unsigned*)(p + 256 * j + 4 * lane) = pg8::pk4fp8(v[j]); }
DI void st_row_bf(bf16* p, int lane, const f32x4 (&v)[4]) {
#pragma unroll
    for (int j = 0; j < 4; ++j) { u32x2 w; w.x = pk2(v[j].x, v[j].y); w.y = pk2(v[j].z, v[j].w); *(u32x2*)(p + 256 * j + 4 * lane) = w; } }
DI void ld_row_bfraw(const bf16* p, int lane, u32x2 (&w)[4]) {
#pragma unroll
    for (int j = 0; j < 4; ++j) w[j] = *(const u32x2*)(p + 256 * j + 4 * lane); }
DI void cvt_row_bf(const u32x2 (&w)[4], f32x4 (&v)[4]) {
#pragma unroll
    for (int j = 0; j < 4; ++j) v[j] = (f32x4){bflo(w[j].x), bfhi(w[j].x), bflo(w[j].y), bfhi(w[j].y)}; }
DI void ld_row_bf(const bf16* p, int lane, f32x4 (&v)[4]) {
#pragma unroll
    for (int j = 0; j < 4; ++j) { const u32x2 w = *(const u32x2*)(p + 256 * j + 4 * lane); v[j] = (f32x4){bflo(w.x), bfhi(w.x), bflo(w.y), bfhi(w.y)}; } }

DI void thin_start(int wave, int lane) {
    const kargp_t kp = kargs(); unsigned char* ws = karg_ws(kp);
    const float* ADA = (const float*)(ws + WS_ADA); bf16* XN = (bf16*)(ws + WS_XN);
    const int NGW = gridDim.x * NWAVES, gw = vcu_index() * NWAVES + wave;
    for (int base = gw * 8; base < M; base += NGW * 8) {
        const int b = base >> 13; const float* ada = ADA + (size_t)b * 6144;
        f32x4 g[4], sc[4], sh[4]; ld_row(karg_in(kp, 4), lane, g); ld_row(ada + 1024, lane, sc); ld_row(ada, lane, sh);
#pragma unroll
        for (int j = 0; j < 4; ++j) sc[j] = g[j] * (sc[j] + 1.0f);
        const float* xin = karg_in(kp, 0);
        f32x4 xn[4]; ld_row(xin + (size_t)base * D, lane, xn);
#pragma unroll
        for (int i = 0; i < 8; ++i) { const size_t m = (size_t)(base + i);
            f32x4 x[4];
#pragma unroll
            for (int j = 0; j < 4; ++j) x[j] = xn[j];
            if (i < 7) ld_row(xin + (m + 1) * D, lane, xn);
            const float rs = rsqrtf(row_ss(x) * (1.0f / D) + EPS);
#pragma unroll
            for (int j = 0; j < 4; ++j) x[j] = x[j] * rs * sc[j] + sh[j];
            st_row_bf(XN + m * D, lane, x); }
    }
}
DI void thin_mid_dense(int l, int wave, int lane) {
    const kargp_t kp = kargs(); unsigned char* ws = karg_ws(kp); bf16* XB = (bf16*)(ws + WS_XB);
    const float* ADA = (const float*)(ws + WS_ADA); bf16* XN = (bf16*)(ws + WS_XN); const bf16* MIX = (const bf16*)(ws + WS_MIX);
    const float* xin = karg_in(kp, 0); const bool l0 = (l == 0);
    const int NGW = gridDim.x * NWAVES, gw = vcu_index() * NWAVES + wave;
    for (int base = gw * 8; base < M; base += NGW * 8) {
        const int b = base >> 13; const float* ada = ADA + (size_t)(l * 2 + b) * 6144;
        f32x4 pg[4], fg[4], fs[4], t[4];
        ld_row(karg_in(kp, 5) + l * D, lane, pg); ld_row(ada + 2048, lane, t);
#pragma unroll
        for (int j = 0; j < 4; ++j) pg[j] = pg[j] * t[j];
        ld_row(karg_in(kp, 6) + l * D, lane, fg); ld_row(ada + 4096, lane, t); ld_row(ada + 3072, lane, fs);
#pragma unroll
        for (int j = 0; j < 4; ++j) fg[j] = fg[j] * (t[j] + 1.0f);
        u32x2 yn[4], xr[4]; f32x4 xn[4]; ld_row_bfraw(MIX + (size_t)base * D, lane, yn); if (l0) ld_row(xin + (size_t)base * D, lane, xn); else ld_row_bfraw(XB + (size_t)base * D, lane, xr);
#pragma unroll
        for (int i = 0; i < 8; ++i) { const size_t m = (size_t)(base + i);
            f32x4 y[4], x[4]; cvt_row_bf(yn, y);
            if (l0) {
#pragma unroll
                for (int j = 0; j < 4; ++j) x[j] = xn[j];
            } else cvt_row_bf(xr, x);
            if (i < 7) { ld_row_bfraw(MIX + (m + 1) * D, lane, yn); if (l0) ld_row(xin + (m + 1) * D, lane, xn); else ld_row_bfraw(XB + (m + 1) * D, lane, xr); }
            const float rs = rsqrtf(row_ss(y) * (1.0f / D) + EPS);
#pragma unroll
            for (int j = 0; j < 4; ++j) x[j] = x[j] + pg[j] * (y[j] * rs);
            st_row_bf(XB + m * D, lane, x);
            const float rs2 = rsqrtf(row_ss(x) * (1.0f / D) + EPS);
#pragma unroll
            for (int j = 0; j < 4; ++j) x[j] = x[j] * rs2 * fg[j] + fs[j];
            if ((FP8_LAYERS >> l) & 1u) st_row_f8((unsigned char*)XN + m * D, lane, x); else st_row_bf(XN + m * D, lane, x); }
    }
}
DI void thin_mid_moe(LAS unsigned char* lds, int l, int tid, int wave, int lane) {
    const kargp_t kp = kargs(); unsigned char* ws = karg_ws(kp); bf16* XB = (bf16*)(ws + WS_XB);
    const float* ADA = (const float*)(ws + WS_ADA); const bf16* MIX = (const bf16*)(ws + WS_MIX);
    unsigned char* AP = ws + WS_AP; int* TOK = (int*)(ws + WS_TOK);
    unsigned* cntg = (unsigned*)(ws + WS_CTL) + CW_CNT + 64 * (l >> 1);
    const float* wr = karg_in(kp, 21) + (size_t)(l >> 1) * D * NE;
    LAS float* RT = (LAS float*)lds;
    LAS unsigned* cntL = (LAS unsigned*)(lds + 32768);
    for (int i = tid; i < D * NE; i += NWAVES * 64) RT[i] = wr[i];
    for (int rb = vcu_index(); rb < M / 64; rb += gridDim.x) {
        if (tid < 16) cntL[tid] = 0u;
        __syncthreads();
        const int base = rb * 64 + wave * 8; const int b = base >> 13; const float* ada = ADA + (size_t)(l * 2 + b) * 6144;
        f32x4 pg[4], fg[4], fs[4], t[4];
        ld_row(karg_in(kp, 5) + l * D, lane, pg); ld_row(ada + 2048, lane, t);
#pragma unroll
        for (int j = 0; j < 4; ++j) pg[j] = pg[j] * t[j];
        ld_row(karg_in(kp, 6) + l * D, lane, fg); ld_row(ada + 4096, lane, t); ld_row(ada + 3072, lane, fs);
#pragma unroll
        for (int j = 0; j < 4; ++j) fg[j] = fg[j] * (t[j] + 1.0f);
        int e0s[8], e1s[8], lp0[8], lp1[8]; float w0s[8], rs2s[8];
        u32x2 yn[4], xr[4]; ld_row_bfraw(MIX + (size_t)base * D, lane, yn); ld_row_bfraw(XB + (size_t)base * D, lane, xr);
#pragma unroll
        for (int i = 0; i < 8; ++i) { const size_t m = (size_t)(base + i);
            f32x4 y[4], x[4]; cvt_row_bf(yn, y);
            cvt_row_bf(xr, x);
            if (i < 7) { ld_row_bfraw(MIX + (m + 1) * D, lane, yn); ld_row_bfraw(XB + (m + 1) * D, lane, xr); }
            const float rs = rsqrtf(row_ss(y) * (1.0f / D) + EPS);
#pragma unroll
            for (int j = 0; j < 4; ++j) x[j] = x[j] + pg[j] * (y[j] * rs);
            st_row_bf(XB + m * D, lane, x);
            const float rs2 = rsqrtf(row_ss(x) * (1.0f / D) + EPS);
            float lg[8];
#pragma unroll
            for (int e = 0; e < 8; ++e) lg[e] = 0.f;
#pragma unroll
            for (int j = 0; j < 4; ++j) { x[j] = x[j] * rs2 * fg[j] + fs[j];
#pragma unroll
                for (int q = 0; q < 4; ++q) { const LAS f32x4* tr = (const LAS f32x4*)(RT + (256 * j + 4 * lane + q) * 8); const f32x4 t0 = tr[0], t1 = tr[1]; const float hv = x[j][q];
                    lg[0] += hv * t0.x; lg[1] += hv * t0.y; lg[2] += hv * t0.z; lg[3] += hv * t0.w; lg[4] += hv * t1.x; lg[5] += hv * t1.y; lg[6] += hv * t1.z; lg[7] += hv * t1.w; } }
#pragma unroll
            for (int e = 0; e < 8; ++e) lg[e] = wave_sum(lg[e]);
            int e0 = 0; float v0 = lg[0];
#pragma unroll
            for (int e = 1; e < 8; ++e) if (lg[e] > v0) { v0 = lg[e]; e0 = e; }
            int e1 = (e0 == 0) ? 1 : 0; float v1 = -INFINITY;
#pragma unroll
            for (int e = 0; e < 8; ++e) if (e != e0 && lg[e] > v1) { v1 = lg[e]; e1 = e; }
            e0 = __builtin_amdgcn_readfirstlane(e0); e1 = __builtin_amdgcn_readfirstlane(e1);
            const float w0 = 1.0f / (1.0f + expf(v1 - v0));
            unsigned q0 = 0u, q1 = 0u;
            if (lane == 0) { q0 = __hip_atomic_fetch_add(cntL + e0, 1u, __ATOMIC_RELAXED, __HIP_MEMORY_SCOPE_WORKGROUP); q1 = __hip_atomic_fetch_add(cntL + e1, 1u, __ATOMIC_RELAXED, __HIP_MEMORY_SCOPE_WORKGROUP); }
            e0s[i] = e0; e1s[i] = e1; lp0[i] = __builtin_amdgcn_readfirstlane((int)q0); lp1[i] = __builtin_amdgcn_readfirstlane((int)q1); w0s[i] = w0; rs2s[i] = rs2;
        }
        __syncthreads();
        if (tid < 8) cntL[8 + tid] = __hip_atomic_fetch_add(cntg + tid, cntL[tid], RLX_AGENT);
        __syncthreads();
#pragma unroll
        for (int i = 0; i < 8; ++i) { const size_t m = (size_t)(base + i);
            const int p0 = (int)cntL[8 + e0s[i]] + lp0[i], p1 = (int)cntL[8 + e1s[i]] + lp1[i];
            const int esz = ((FP8_LAYERS >> l) & 1u) ? 1 : 2; unsigned char* r0 = AP + ((size_t)e0s[i] * ECAP + p0) * D * esz; unsigned char* r1 = AP + ((size_t)e1s[i] * ECAP + p1) * D * esz;
            f32x4 x[4]; ld_row_bf(XB + m * D, lane, x);
#pragma unroll
            for (int j = 0; j < 4; ++j) { x[j] = x[j] * rs2s[i] * fg[j] + fs[j];
                if (esz == 1) { const unsigned hpk = pg8::pk4fp8(x[j]); *(unsigned*)(r0 + 256 * j + 4 * lane) = hpk; *(unsigned*)(r1 + 256 * j + 4 * lane) = hpk; }
                else { u32x2 hpk; hpk.x = pk2(x[j].x, x[j].y); hpk.y = pk2(x[j].z, x[j].w); *(u32x2*)(r0 + 512 * j + 8 * lane) = hpk; *(u32x2*)(r1 + 512 * j + 8 * lane) = hpk; } }
            if (lane == 0) { int4 ti; ti.x = e0s[i] | (e1s[i] << 8); ti.y = p0; ti.z = p1; ti.w = __float_as_int(w0s[i]); *(int4*)(TOK + 4 * m) = ti; }
        }
        __syncthreads();
    }
}
DI void thin_end(int l, int wave, int lane) {
    const kargp_t kp = kargs(); unsigned char* ws = karg_ws(kp); float* outp = karg_out(kp); bf16* XB = (bf16*)(ws + WS_XB);
    const float* ADA = (const float*)(ws + WS_ADA); bf16* XN = (bf16*)(ws + WS_XN); const bf16* MIX = (const bf16*)(ws + WS_MIX);
    const bf16* YP = (const bf16*)(ws + WS_YP); const int* TOK = (const int*)(ws + WS_TOK);
    const bool moe = (l & 1) != 0; const bool last = (l == DEPTH - 1);
    int pp[8];
    { const unsigned* cntg = (const unsigned*)(ws + WS_CTL) + CW_CNT + 64 * (l >> 1); int acc = 0;
#pragma unroll
      for (int e = 0; e < 8; ++e) { pp[e] = acc; const unsigned n = moe ? (unsigned)__builtin_amdgcn_readfirstlane((int)__hip_atomic_load(cntg + e, RLX_AGENT)) : 0u; acc += (int)((n + 255u) >> 8); } }
    const int NGW = gridDim.x * NWAVES, gw = vcu_index() * NWAVES + wave;
    for (int base = gw * 8; base < M; base += NGW * 8) {
        const int b = base >> 13; const float* ada = ADA + (size_t)(l * 2 + b) * 6144; const float* adan = ADA + (size_t)((last ? l : l + 1) * 2 + b) * 6144;
        f32x4 pg[4], ng[4], ns[4], t[4];
        ld_row(karg_in(kp, 7) + l * D, lane, pg); ld_row(ada + 5120, lane, t);
#pragma unroll
        for (int j = 0; j < 4; ++j) pg[j] = pg[j] * t[j];
        ld_row(karg_in(kp, 4) + (last ? l : l + 1) * D, lane, ng); ld_row(adan + 1024, lane, t); ld_row(adan, lane, ns);
#pragma unroll
        for (int j = 0; j < 4; ++j) ng[j] = ng[j] * (t[j] + 1.0f);
        u32x2 yn[4], zn[4], xr[4]; float w0n = 1.0f;
#define TE_LOAD(mm) do { if (moe) { const int4 ti = *(const int4*)(TOK + 4 * (mm)); const int e0 = ti.x & 255, e1 = (ti.x >> 8) & 255; int b0 = 0, b1 = 0; \
                _Pragma("unroll") for (int e = 1; e < 8; ++e) { if (e0 == e) b0 = pp[e]; if (e1 == e) b1 = pp[e]; } \
                w0n = __int_as_float(ti.w); ld_row_bfraw(YP + ((size_t)b0 * 256 + ti.y) * D, lane, yn); ld_row_bfraw(YP + ((size_t)b1 * 256 + ti.z) * D, lane, zn); } \
            else ld_row_bfraw(MIX + (mm) * D, lane, yn); \
            ld_row_bfraw(XB + (mm) * D, lane, xr); } while (0)
        TE_LOAD((size_t)base);
#pragma unroll
        for (int i = 0; i < 8; ++i) { const size_t m = (size_t)(base + i);
            f32x4 y[4], x[4]; cvt_row_bf(yn, y);
            if (moe) { f32x4 y1[4]; cvt_row_bf(zn, y1); const float w0 = w0n, w1 = 1.0f - w0n;
#pragma unroll
                for (int j = 0; j < 4; ++j) y[j] = y[j] * w0 + y1[j] * w1; }
            cvt_row_bf(xr, x);
            if (i < 7) TE_LOAD(m + 1);
            const float rs = rsqrtf(row_ss(y) * (1.0f / D) + EPS);
#pragma unroll
            for (int j = 0; j < 4; ++j) x[j] = x[j] + pg[j] * (y[j] * rs);
            if (last) st_row(outp + m * D, lane, x); else st_row_bf(XB + m * D, lane, x);
            if (!last) { const float rs2 = rsqrtf(row_ss(x) * (1.0f / D) + EPS);
#pragma unroll
                for (int j = 0; j < 4; ++j) x[j] = x[j] * rs2 * ng[j] + ns[j];
                st_row_bf(XN + m * D, lane, x); }
        }
#undef TE_LOAD
    }
}
constexpr int L_WA = 0, L_WX = 34816, L_XC = 69632, L_PAR = 104448, L_AGG = 108544, L_HST = 116736, L_HINT = 108544;
template <int N> DI float dpp_shr(float oldv, float x) { return __builtin_bit_cast(float, __builtin_amdgcn_update_dpp(__builtin_bit_cast(int, oldv), __builtin_bit_cast(int, x), 0x110 + N, 0xf, 0xf, false)); }
#define RNN_SCAN_STEP(S) \
    "v_fmac_f32_dpp %4, %4, %0 row_shr:" #S " row_mask:0xf bank_mask:0xf\n\t" "v_fmac_f32_dpp %5, %5, %1 row_shr:" #S " row_mask:0xf bank_mask:0xf\n\t" \
    "v_fmac_f32_dpp %6, %6, %2 row_shr:" #S " row_mask:0xf bank_mask:0xf\n\t" "v_fmac_f32_dpp %7, %7, %3 row_shr:" #S " row_mask:0xf bank_mask:0xf\n\t" \
    "v_mul_f32_dpp %0, %0, %0 row_shr:" #S " row_mask:0xf bank_mask:0xf\n\t" "v_mul_f32_dpp %1, %1, %1 row_shr:" #S " row_mask:0xf bank_mask:0xf\n\t" \
    "v_mul_f32_dpp %2, %2, %2 row_shr:" #S " row_mask:0xf bank_mask:0xf\n\t" "v_mul_f32_dpp %3, %3, %3 row_shr:" #S " row_mask:0xf bank_mask:0xf\n\t"
DI void scan16(f32x4& a, f32x4& u) {
    float a0 = a[0], a1 = a[1], a2 = a[2], a3 = a[3], u0 = u[0], u1 = u[1], u2 = u[2], u3 = u[3];
    asm volatile("s_nop 1\n\t" RNN_SCAN_STEP(1) RNN_SCAN_STEP(2) RNN_SCAN_STEP(4) RNN_SCAN_STEP(8) "s_nop 0"
                 : "+v"(a0), "+v"(a1), "+v"(a2), "+v"(a3), "+v"(u0), "+v"(u1), "+v"(u2), "+v"(u3));
    a = (f32x4){a0, a1, a2, a3}; u = (f32x4){u0, u1, u2, u3};
}
template <int N> DI void scan_step(f32x4& a, f32x4& u) {
#pragma unroll
    for (int q = 0; q < 4; ++q) { const float ap = dpp_shr<N>(1.0f, a[q]), up = dpp_shr<N>(0.0f, u[q]); u[q] = a[q] * up + u[q]; a[q] = a[q] * ap; }
}
DI f32x4 mfma16(bf16x8 a, bf16x8 b, f32x4 c) { return __builtin_amdgcn_mfma_f32_16x16x32_bf16(a, b, c, 0, 0, 0); }
DI f32x4 bf4lo(u32x4 v) { return (f32x4){bflo(v.x), bfhi(v.x), bflo(v.y), bfhi(v.y)}; }
DI f32x4 bf4hi(u32x4 v) { return (f32x4){bflo(v.z), bfhi(v.z), bflo(v.w), bfhi(v.w)}; }
DI void rnn_pass1(LAS unsigned char* lds, int l, int tid, int wave, int lane, int it_first, int it_count, int it_stride) {
    const int fr = lane & 15, fq = lane >> 4;
    LAS float* PAR = (LAS float*)(lds + L_PAR); LAS float* AGG = (LAS float*)(lds + L_AGG); LAS float* HST = (LAS float*)(lds + L_HST);
    const int cc = tid & 15, tg4 = (tid >> 4) * 4;
    for (int itk = 0; itk < it_count; ++itk) { const int it = it_first + itk * it_stride;
        const int nb = it & 7, seg = it >> 3, sidx = seg & 15; const int m0 = seg * 512;
        const kargp_t kp = kargs(); unsigned char* ws = karg_ws(kp);
        const bf16* XRp = (const bf16*)(ws + WS_XR);
        __syncthreads();
        u32x4 pre[7];
        f32x4 cw0[4], cw1[4], cb0, cb1;
#define RNN_PREFETCH(stn) do { _Pragma("unroll") for (int j = 0; j < 7; ++j) { const int rl = 128 * (stn) + tg4 - 3 + j; pre[j] = (u32x4){0u, 0u, 0u, 0u}; \
                if (!(sidx == 0 && rl < 0)) pre[j] = *(const u32x4*)(XRp + (size_t)(m0 + rl) * 1024 + nb * 128 + cc * 8); } } while (0)
        RNN_PREFETCH(0);
        { const bf16* WA = (const bf16*)(ws + WS_WL + (size_t)l * WL_STRIDE + WL_WRA) + nb * 16384; const bf16* WX = (const bf16*)(ws + WS_WL + (size_t)l * WL_STRIDE + WL_WRX) + nb * 16384;
          u32x4 wreg[8];
#pragma unroll
          for (int i = 0; i < 4; ++i) { const int q = tid + 512 * i; wreg[i] = *(const u32x4*)(WA + (q >> 4) * 128 + (q & 15) * 8); wreg[4 + i] = *(const u32x4*)(WX + (q >> 4) * 128 + (q & 15) * 8); }
          { const float* cwp = karg_in(kp, 9) + (size_t)l * 4096 + nb * 128 + cc * 8; const float* cbp = karg_in(kp, 10) + l * 1024 + nb * 128 + cc * 8;
#pragma unroll
              for (int k = 0; k < 4; ++k) { cw0[k] = *(const f32x4*)(cwp + k * 1024); cw1[k] = *(const f32x4*)(cwp + k * 1024 + 4); }
              cb0 = *(const f32x4*)cbp; cb1 = *(const f32x4*)(cbp + 4); }
          if (tid < 128) { const int ch = l * 1024 + nb * 128 + tid;
            PAR[0 * 128 + tid] = -LOG2E * karg_in(kp, 12)[ch]; PAR[1 * 128 + tid] = -LOG2E * karg_in(kp, 14)[ch]; PAR[2 * 128 + tid] = 8.0f * log1pf(expf(-karg_in(kp, 15)[ch])) * LOG2E;
            *(LAS f32x2*)(HST + 2 * tid) = (f32x2){1.0f, 0.0f}; }
#pragma unroll
          for (int i = 0; i < 4; ++i) { const int q = tid + 512 * i; *(LAS u32x4*)(lds + L_WA + (q >> 4) * 272 + (q & 15) * 16) = wreg[i]; *(LAS u32x4*)(lds + L_WX + (q >> 4) * 272 + (q & 15) * 16) = wreg[4 + i]; } }
        for (int st = 0; st < 4; ++st) {
#pragma unroll
            for (int i = 0; i < 4; ++i) { f32x4 o0 = cb0, o1 = cb1;
#pragma unroll
                for (int k = 0; k < 4; ++k) { o0 += cw0[k] * bf4lo(pre[i + k]); o1 += cw1[k] * bf4hi(pre[i + k]); }
                u32x4 pk; pk.x = pk2(o0[0], o0[1]); pk.y = pk2(o0[2], o0[3]); pk.z = pk2(o1[0], o1[1]); pk.w = pk2(o1[2], o1[3]);
                *(LAS u32x4*)(lds + L_XC + (tg4 + i) * 272 + cc * 16) = pk; }
            __syncthreads();
            if (st < 3) RNN_PREFETCH(st + 1);
            const int tl = 16 * wave + fr;
            bf16x8 xb[4];
#pragma unroll
            for (int s = 0; s < 4; ++s) xb[s] = *(const LAS bf16x8*)(lds + L_XC + tl * 272 + (32 * s + 8 * fq) * 2);
            unsigned* PSw = (unsigned*)(ws + WS_PS); float* T16w = (float*)(ws + WS_T16);
#pragma unroll
            for (int n = 0; n < 8; ++n) { const int ch0 = 16 * n + 4 * fq;
                f32x4 ca = *(const LAS f32x4*)(PAR + ch0), cx = *(const LAS f32x4*)(PAR + 128 + ch0);
#pragma unroll
                for (int s = 0; s < 4; ++s) { const bf16x8 af = *(const LAS bf16x8*)(lds + L_WA + (16 * n + fr) * 272 + (32 * s + 8 * fq) * 2), xf = *(const LAS bf16x8*)(lds + L_WX + (16 * n + fr) * 272 + (32 * s + 8 * fq) * 2);
                    ca = mfma16(af, xb[s], ca); cx = mfma16(xf, xb[s], cx); }
                const u32x2 xv = *(const LAS u32x2*)(lds + L_XC + tl * 272 + ch0 * 2); const f32x4 xc = (f32x4){bflo(xv.x), bfhi(xv.x), bflo(xv.y), bfhi(xv.y)};
                const f32x4 sp = *(const LAS f32x4*)(PAR + 256 + ch0);
                f32x4 av, uv;
#pragma unroll
                for (int q = 0; q < 4; ++q) { const float r = frcp(1.0f + fexp2(ca[q])), ig = frcp(1.0f + fexp2(cx[q]));
                    const float aa = fexp2(-r * sp[q]); av[q] = aa; uv[q] = __builtin_amdgcn_sqrtf(1.0f - aa * aa) * ig * xc[q]; }
                scan16(av, uv);
                { u32x4 ps; ps.x = pk2(av[0], uv[0]); ps.y = pk2(av[1], uv[1]); ps.z = pk2(av[2], uv[2]); ps.w = pk2(av[3], uv[3]);
                  *(u32x4*)(PSw + (size_t)(m0 + 128 * st + tl) * 1024 + nb * 128 + ch0) = ps; }
                if (fr == 15) { const f32x4 g0 = (f32x4){av[0], uv[0], av[1], uv[1]}, g1 = (f32x4){av[2], uv[2], av[3], uv[3]};
                    *(LAS f32x4*)(AGG + (wave * 128 + ch0) * 2) = g0; *(LAS f32x4*)(AGG + (wave * 128 + ch0) * 2 + 4) = g1;
                    float* o = T16w + ((size_t)(seg * 32 + st * 8 + wave) * 1024 + nb * 128 + ch0) * 2; *(f32x4*)o = g0; *(f32x4*)(o + 4) = g1; }
            }
            __syncthreads();
            LAS float* HS0 = HST + 256 * (st & 1); LAS float* HS1 = HST + 256 * ((st + 1) & 1);
            if (fr == 0) { const int ch0 = 16 * wave + 4 * fq;
                const f32x4 h0 = *(const LAS f32x4*)(HS0 + 2 * ch0), h1 = *(const LAS f32x4*)(HS0 + 2 * ch0 + 4);
                f32x4 A = (f32x4){h0[0], h0[2], h1[0], h1[2]}, U = (f32x4){h0[1], h0[3], h1[1], h1[3]};
#pragma unroll
                for (int w2 = 0; w2 < 8; ++w2) { const f32x4 g0 = *(const LAS f32x4*)(AGG + (w2 * 128 + ch0) * 2), g1 = *(const LAS f32x4*)(AGG + (w2 * 128 + ch0) * 2 + 4);
                    const f32x4 a2 = (f32x4){g0[0], g0[2], g1[0], g1[2]}, u2 = (f32x4){g0[1], g0[3], g1[1], g1[3]}; U = a2 * U + u2; A = A * a2; }
                const f32x4 o0 = (f32x4){A[0], U[0], A[1], U[1]}, o1 = (f32x4){A[2], U[2], A[3], U[3]};
                *(LAS f32x4*)(HS1 + 2 * ch0) = o0; *(LAS f32x4*)(HS1 + 2 * ch0 + 4) = o1;
                if (st == 3) { float* o = (float*)(ws + WS_RAGG) + ((size_t)seg * 1024 + nb * 128 + ch0) * 2; *(f32x4*)o = o0; *(f32x4*)(o + 4) = o1; } }
        }
#undef RNN_PREFETCH
    }
}
DI void rnn_pass2(LAS unsigned char* lds, int tid) {
    LAS float* HINT = (LAS float*)lds;
    for (int it = vcu_index(); it < 256; it += gridDim.x) {
        const int nb = it & 7, seg = it >> 3, sidx = seg & 15; const int m0 = seg * 512;
        unsigned char* ws = karg_ws(kargs());
        __syncthreads();
        if (tid < 128) { const float* RAGG = (const float*)(ws + WS_RAGG) + ((size_t)(seg - sidx) * 1024 + nb * 128 + tid) * 2; const float* T16 = (const float*)(ws + WS_T16) + ((size_t)(seg * 32) * 1024 + nb * 128 + tid) * 2;
            f32x2 sa[15], ta[32];
#pragma unroll
            for (int s2 = 0; s2 < 15; ++s2) sa[s2] = *(const f32x2*)(RAGG + (size_t)s2 * 2048);
#pragma unroll
            for (int t2 = 0; t2 < 32; ++t2) ta[t2] = *(const f32x2*)(T16 + (size_t)t2 * 2048);
            float h = 0.f;
#pragma unroll
            for (int s2 = 0; s2 < 15; ++s2) h = (s2 < sidx) ? sa[s2].x * h + sa[s2].y : h;
#pragma unroll
            for (int t2 = 0; t2 < 32; ++t2) { HINT[t2 * 128 + tid] = h; h = ta[t2].x * h + ta[t2].y; } }
        __syncthreads();
        const unsigned* PS = (const unsigned*)(ws + WS_PS); const bf16* GGp = (const bf16*)(ws + WS_GG); bf16* ROp = (bf16*)(ws + WS_RO);
        const int c4 = (tid & 31) * 4, r0 = tid >> 5;
#pragma unroll 4
        for (int i = 0; i < 32; ++i) { const int row = r0 + 16 * i; const size_t off = (size_t)(m0 + row) * 1024 + nb * 128 + c4, offo = (size_t)(m0 + row) * 2048 + nb * 128 + c4;
            const u32x4 ps = *(const u32x4*)(PS + off); const u32x2 gv = *(const u32x2*)(GGp + off); const f32x4 hin = *(const LAS f32x4*)(HINT + (row >> 4) * 128 + c4);
            const float h0 = bflo(ps.x) * hin[0] + bfhi(ps.x), h1 = bflo(ps.y) * hin[1] + bfhi(ps.y), h2 = bflo(ps.z) * hin[2] + bfhi(ps.z), h3 = bflo(ps.w) * hin[3] + bfhi(ps.w);
            u32x2 o; o.x = pk2(h0 * bflo(gv.x), h1 * bfhi(gv.x)); o.y = pk2(h2 * bflo(gv.y), h3 * bfhi(gv.y)); *(u32x2*)(ROp + offo) = o; }
    }
}

constexpr int L_K = 0, L_V = 69632;
DI f32x16 mfma32(bf16x8 a, bf16x8 b, f32x16 c) { return __builtin_amdgcn_mfma_f32_32x32x16_bf16(a, b, c, 0, 0, 0); }
DI void attn_phase(LAS unsigned char* lds, int l, int tid, int wave, int lane, int it_first, int it_count, int it_stride) {
    const int r = lane & 31, h = lane >> 5;
    const kargp_t kp = kargs(); unsigned char* ws = karg_ws(kp);
    const bf16* Q = (const bf16*)(ws + WS_Q); const bf16* KB = (const bf16*)(ws + WS_KB); const bf16* VB = (const bf16*)(ws + WS_VB); bf16* AO = (bf16*)(ws + WS_RO) + 1024;   const float* sinks = karg_in(kp, 16) + l * 8;
    for (int itk = 0; itk < it_count; ++itk) { const int it = it_first + itk * it_stride;
        const int b = it >> 7, qblk = (it >> 1) & 63, kvh = it & 1; const int rowbase = b * SEQ + qblk * 128;
        __syncthreads();
        { u32x4 kreg[8], vreg[8];
#pragma unroll
          for (int i = 0; i < 8; ++i) { const int idx = tid + 512 * i, j = idx >> 4, c = idx & 15; const int jr = (qblk > 0 || j >= 128) ? j : 128;
            kreg[i] = *(const u32x4*)(KB + (size_t)(rowbase - 128 + jr) * 256 + kvh * 128 + c * 8); vreg[i] = *(const u32x4*)(VB + (size_t)(rowbase - 128 + jr) * 256 + kvh * 128 + c * 8); }
#pragma unroll
          for (int i = 0; i < 8; ++i) { const int idx = tid + 512 * i, j = idx >> 4, c = idx & 15; const bool ok = (qblk > 0 || j >= 128); const u32x4 z = (u32x4){0u, 0u, 0u, 0u};
            *(LAS u32x4*)(lds + L_K + j * 272 + c * 16) = ok ? kreg[i] : z; *(LAS u32x4*)(lds + L_V + j * 272 + c * 16) = ok ? vreg[i] : z; } }
        const int g = wave >> 1, head = kvh * 4 + g;
        bf16x8 qf[8], qn[8];
#pragma unroll
        for (int ks = 0; ks < 8; ++ks) qf[ks] = *(const bf16x8*)(Q + (size_t)(rowbase + 64 * (wave & 1) + r) * 1024 + head * 128 + 16 * ks + 8 * h);
        __syncthreads();
        const float slope2 = exp2f(-(float)(head + 1)) * LOG2E, sink2 = sinks[head] * LOG2E;
#pragma unroll 1
        for (int si = 0; si < 2; ++si) {
            const int q0 = 64 * (wave & 1) + 32 * si, kt0 = q0 >> 5; const size_t qrow = (size_t)(rowbase + q0 + r);
            const LAS unsigned char* kbase = lds + L_K + (32 * kt0 + r) * 272 + 16 * h;
            const LAS unsigned char* vbase = lds + L_V + (32 * kt0 + 4 * h + ((lane & 15) >> 2)) * 272 + (16 * ((lane >> 4) & 1) + 4 * (lane & 3)) * 2;
            const int d0 = (q0 + r) + 128 - (32 * kt0 + 4 * h);
            const int jlim = qblk > 0 ? -100000 : 128 - (32 * kt0 + 4 * h);
            const float fd0 = (float)d0, fjl = (float)jlim;
            f32x16 p[5];
#pragma unroll
            for (int t = 0; t < 5; ++t) {
#pragma unroll
                for (int e = 0; e < 16; ++e) p[t][e] = 0.f;
#pragma unroll
                for (int ks = 0; ks < 8; ++ks) { const bf16x8 kf = *(const LAS bf16x8*)(kbase + t * 8704 + ks * 32); p[t] = mfma32(kf, qf[ks], p[t]); } }
            if (si == 0) {
#pragma unroll
                for (int ks = 0; ks < 8; ++ks) qn[ks] = *(const bf16x8*)(Q + (qrow + 32) * 1024 + head * 128 + 16 * ks + 8 * h);
            }
            float mx = sink2;
#pragma unroll
            for (int t = 0; t < 5; ++t) {
                if (t >= 1 && t <= 3 && qblk > 0) {
#pragma unroll
                    for (int e = 0; e < 16; ++e) { const float cte = (float)(32 * t + (e & 3) + 8 * (e >> 2)); p[t][e] = p[t][e] - slope2 * (fd0 - cte); mx = fmaxf(mx, p[t][e]); }
                } else {
#pragma unroll
                    for (int e = 0; e < 16; ++e) { const float cte = (float)(32 * t + (e & 3) + 8 * (e >> 2)); const float fd = fd0 - cte;
                        const float bad = fmaxf(fmaxf(-fd, fd - 127.0f), fjl - cte);
                        p[t][e] = p[t][e] - slope2 * fd + fminf(0.f, -1e30f * bad); mx = fmaxf(mx, p[t][e]); }
                } }
            mx = fmaxf(mx, __shfl_xor(mx, 32));
            float sum = 0.f;
#pragma unroll
            for (int t = 0; t < 5; ++t)
#pragma unroll
                for (int e = 0; e < 16; ++e) { const float ev = fexp2(p[t][e] - mx); p[t][e] = ev; sum += ev; }
            sum += __shfl_xor(sum, 32); sum += fexp2(sink2 - mx);
            const float inv = 1.0f / sum;
            f32x16 o[4];
#pragma unroll
            for (int dt = 0; dt < 4; ++dt)
#pragma unroll
                for (int e = 0; e < 16; ++e) o[dt][e] = 0.f;
#pragma unroll
            for (int t = 0; t < 5; ++t) {
#pragma unroll
                for (int s = 0; s < 2; ++s) { u32x4 pk; pk.x = pk2(p[t][8 * s + 0], p[t][8 * s + 1]); pk.y = pk2(p[t][8 * s + 2], p[t][8 * s + 3]); pk.z = pk2(p[t][8 * s + 4], p[t][8 * s + 5]); pk.w = pk2(p[t][8 * s + 6], p[t][8 * s + 7]);
                    const bf16x8 pf = __builtin_bit_cast(bf16x8, pk);
#pragma unroll
                    for (int dt = 0; dt < 4; ++dt) { const LAS unsigned char* va = vbase + t * 8704 + s * 4352 + dt * 64;
                        const s16x4 lo = __builtin_amdgcn_ds_read_tr16_b64_v4i16((LAS s16x4*)va), hi = __builtin_amdgcn_ds_read_tr16_b64_v4i16((LAS s16x4*)(va + 2176));
                        const bf16x8 vf = __builtin_shufflevector(lo, hi, 0, 1, 2, 3, 4, 5, 6, 7); o[dt] = mfma32(vf, pf, o[dt]); } } }
#pragma unroll
            for (int dt = 0; dt < 4; ++dt)
#pragma unroll
                for (int gg = 0; gg < 4; ++gg) { u32x2 w; w.x = pk2(o[dt][4 * gg] * inv, o[dt][4 * gg + 1] * inv); w.y = pk2(o[dt][4 * gg + 2] * inv, o[dt][4 * gg + 3] * inv);
                    *(u32x2*)(AO + qrow * 2048 + head * 128 + 32 * dt + 8 * gg + 4 * h) = w; }
#pragma unroll
            for (int ks = 0; ks < 8; ++ks) qf[ks] = qn[ks];
        }
    }
}

constexpr int N_PHASES = 2 + 9 * DEPTH;
__global__ void __launch_bounds__(NWAVES * 64, 2) trunk_fwd(Args args) {
    extern __shared__ __attribute__((aligned(16))) unsigned char lds_raw[];
    LAS unsigned char* lds = (LAS unsigned char*)lds_raw;
    volatile LAS unsigned* MISC = (volatile LAS unsigned*)(lds + MISC_OFF);
    const int tid0 = threadIdx.x;
#define TID_DEFS int tid = tid0; asm volatile("" : "+v"(tid)); const int lane = tid & 63, wave = __builtin_amdgcn_readfirstlane(tid >> 6); (void)lane; (void)wave;
    const int G = gridDim.x;
    gu32* ctl = (gu32*)(args.ws + WS_CTL);
    for (int u = tid0; u < (LDS_BYTES - LDSCTL_OFF) / 4; u += NWAVES * 64) ((LAS unsigned*)(lds + LDSCTL_OFF))[u] = 0u;
    __syncthreads();
    XcdBarrier bar = xcd_barrier_post((unsigned*)ctl + CW_BAR, MISC + 8);
    const int lo = args.ph_lo, hi = args.ph_hi;
#ifndef PH_MASK
#define PH_MASK 0xffffffffu
#endif
#define EN(b) ((PH_MASK >> (b)) & 1u)
#ifndef A_ALIGN
#define A_ALIGN true
#endif
#ifndef MIX_DEAL
#define MIX_DEAL 0
#endif
#ifndef BINPACK
#define BINPACK 1
#endif
#ifndef FUSE_DENSE
#define FUSE_DENSE 0
#endif
#ifndef PH_REPEAT
#define PH_REPEAT 0u
#endif
#ifndef PH_NREP
#define PH_NREP 2
#endif
#define REPS(b) (((PH_REPEAT >> (b)) & 1u) ? PH_NREP : 1)
#define REP_BEGIN(b) for (int rep_ = 0; rep_ < REPS(b); ++rep_) { if (rep_) xcd_barrier(bar);
#define REP_END }
#define IN(k) (lo <= (k) && (k) < hi)
#ifndef BAR_TWICE
#define BAR_TWICE 0
#endif
#define SEAM(k) do { if (IN(k) && IN((k) + 1)) { xcd_barrier(bar); if (BAR_TWICE) xcd_barrier(bar); } } while (0)
#if NAIVE_GEMM
#define RUN_GEMM(EPI, SCHED, ALIGN, g, S, E) pg8::gemm_phase_naive<EPI, SCHED>(g, S, E)
#else
#ifndef BF_SP2
#define BF_SP2 true
#endif
#define RUN_GEMM(EPI, SCHED, ALIGN, g, S, E) pg8::gemm_phase<EPI, SCHED, ALIGN, BF_SP2>(lds + RING_OFF, g, S, E)
#endif
#ifndef F8_ALIGN
#define F8_ALIGN(a) (a)
#endif
#ifndef F8_SP2
#define F8_SP2 false
#endif
#define RUN_GEMM8(EPI, SCHED, ALIGN, g, S, E) pg8::gemm_phase<EPI, SCHED, F8_ALIGN(ALIGN), F8_SP2, true>(lds + RING_OFF, g, S, E)
#define SC_ONE 0x7f7f7f7f
#define SC_M5 0x7a7a7a7a
#define SC_M6 0x79797979
    if (EN(0) && IN(0)) { REP_BEGIN(0) TID_DEFS p0_prologue(lds, tid, wave, lane); REP_END } SEAM(0);
    if (EN(1) && IN(1)) { REP_BEGIN(1) TID_DEFS thin_start(wave, lane); REP_END } SEAM(1);

    for (int l = 0; l < DEPTH; ++l) {
        const int pb = 2 + 9 * l;
        const bool binpack = BINPACK && G == 256;
        if (EN(2) && IN(pb + 0)) { REP_BEGIN(2)
            unsigned char* ws = karg_ws(kargs());
            pg8::Gemm g{(const bf16*)(ws + WS_XN), (const bf16*)(ws + WS_WL + (size_t)l * WL_STRIDE + WL_WIN), M, D_IN, D}; pg8::StaticOrder S; S.init(M, binpack ? 16 * 256 : D_IN, G, (int)blockIdx.x);
            pg8::EpiWin E; E.R = ws + WS_R;
            RUN_GEMM(pg8::EpiWin, pg8::StaticOrder, A_ALIGN, g, S, E);
        REP_END } SEAM(pb + 0);
        if (IN(pb + 1)) {
            if (binpack) {
                const int xq = (int)blockIdx.x & 7, qq = (int)blockIdx.x >> 3; const bool gx = qq < 16;
                if (EN(2)) { unsigned char* ws = karg_ws(kargs());
                    pg8::Gemm g{(const bf16*)(ws + WS_XN), (const bf16*)(ws + WS_WL + (size_t)l * WL_STRIDE + WL_WIN), M, D_IN, D}; pg8::ListOrder S; S.first = gx ? 48 * xq + 2 * qq : 48 * xq + 32 + (qq - 16); S.count = gx ? 2 : 1; S.ncol = 6; S.pn0 = 16;
                    pg8::EpiWin E; E.R = ws + WS_R;
                    RUN_GEMM(pg8::EpiWin, pg8::ListOrder, A_ALIGN, g, S, E); }
                if (EN(3)) { TID_DEFS rnn_pass1(lds, l, tid, wave, lane, 32 * xq + qq, 1, 1); }
                if (!gx) { if (EN(4)) { TID_DEFS attn_phase(lds, l, tid, wave, lane, 32 * xq + 2 * (qq - 16), 2, 1); } }
            } else {
                const int c = vcu_index(), cnt = c < 256 ? (256 - c + G - 1) / G : 0;
                if (EN(3)) { REP_BEGIN(3) TID_DEFS rnn_pass1(lds, l, tid, wave, lane, c, cnt, G); REP_END }
                if (EN(4)) { REP_BEGIN(4) TID_DEFS attn_phase(lds, l, tid, wave, lane, c, cnt, G); REP_END }
            }
        } SEAM(pb + 1);
        if (EN(5) && IN(pb + 2)) { REP_BEGIN(5) TID_DEFS rnn_pass2(lds, tid); REP_END } SEAM(pb + 2);
        if (EN(6) && IN(pb + 3)) { REP_BEGIN(6)
            unsigned char* ws = karg_ws(kargs());
            pg8::Gemm g{(const bf16*)(ws + WS_RO), (const bf16*)(ws + WS_WL + (size_t)l * WL_STRIDE + WL_WB), M, D, 2 * D}; pg8::StaticOrder S; S.init(M, D, G, (int)blockIdx.x);
            pg8::EpiMerge E; E.R = ws + WS_R; RUN_GEMM(pg8::EpiMerge, pg8::StaticOrder, false, g, S, E);
         REP_END } SEAM(pb + 3);
        const bool fuse = FUSE_DENSE && !(l & 1) && G == 256;
        if (EN(7) && IN(pb + 4)) { REP_BEGIN(7)
            const kargp_t kp = kargs(); unsigned char* ws = karg_ws(kp);
            pg8::Gemm g{(const bf16*)(ws + WS_MG), (const bf16*)(ws + WS_WL + (size_t)l * WL_STRIDE + WL_WO), M, D, D}; pg8::StaticOrder S; S.init(M, D, G, (int)blockIdx.x);
            if (fuse) {
                const float* ada = (const float*)(ws + WS_ADA) + (size_t)(l * 2) * 6144; unsigned* ctlw = (unsigned*)(ws + WS_CTL); const int bank = (l >> 1) * 4;
                pg8::EpiRmsResRms E; E.xin32 = (l == 0) ? karg_in(kp, 0) : nullptr; E.xin16 = (const bf16*)(ws + WS_XB); E.XB = (bf16*)(ws + WS_XB); E.XN = (bf16*)(ws + WS_XN); E.xn_fp8 = (int)((FP8_LAYERS >> l) & 1u);
                E.gainA = karg_in(kp, 5) + l * D; E.gateA = ada + 2048; E.gainB = karg_in(kp, 6) + l * D; E.scB = ada + 4096; E.shB = ada + 3072;
                E.st1.xbuf = (float*)(ws + WS_XS) + (size_t)bank * 65536; E.st1.cnt = ctlw + CW_SEAM + bank * SEAM_BANK; E.st1.tmo = ctlw;
                E.st2.xbuf = (float*)(ws + WS_XS) + (size_t)(bank + 1) * 65536; E.st2.cnt = ctlw + CW_SEAM + (bank + 1) * SEAM_BANK; E.st2.tmo = ctlw;
                RUN_GEMM(pg8::EpiRmsResRms, pg8::StaticOrder, false, g, S, E);
            } else { pg8::EpiBf16N E; E.O = (bf16*)(ws + WS_MIX); RUN_GEMM(pg8::EpiBf16N, pg8::StaticOrder, false, g, S, E); }
        REP_END } SEAM(pb + 4);
        if (IN(pb + 5) && !fuse) { if (l & 1) { if (EN(9)) { TID_DEFS thin_mid_moe(lds, l, tid, wave, lane); } } else { if (EN(8)) { TID_DEFS thin_mid_dense(l, wave, lane); } } }
        if (!fuse) SEAM(pb + 5);
        if (l & 1) {
            if (EN(10) && IN(pb + 6)) { REP_BEGIN(10)
                unsigned char* ws = karg_ws(kargs()); const unsigned* cntg = (const unsigned*)(ws + WS_CTL) + CW_CNT + 64 * (l >> 1);
                pg8::Gemm g{(const bf16*)(ws + WS_AP), (const bf16*)(ws + WS_WM + (size_t)(l >> 1) * WM_STRIDE + WM_MIN), 0, 0, D, SC_M5, SC_ONE}; pg8::MoeOrder S; S.init(cntg, 12, G, (int)blockIdx.x, ECAP / 256);
                if ((FP8_LAYERS >> l) & 1u) { pg8::EpiSwiglu8 E; E.O = ws + WS_ACTP; E.ldc = D_FFE; E.ntile = 12; RUN_GEMM8(pg8::EpiSwiglu8, pg8::MoeOrder, true, g, S, E); }
                else { pg8::EpiSwiglu E; E.O = (bf16*)(ws + WS_ACTP); E.ldc = D_FFE; E.ntile = 12; RUN_GEMM(pg8::EpiSwiglu, pg8::MoeOrder, true, g, S, E); }
             REP_END } SEAM(pb + 6);
            if (EN(11) && IN(pb + 7)) { REP_BEGIN(11)
                unsigned char* ws = karg_ws(kargs()); const unsigned* cntg = (const unsigned*)(ws + WS_CTL) + CW_CNT + 64 * (l >> 1);
                pg8::Gemm g{(const bf16*)(ws + WS_ACTP), (const bf16*)(ws + WS_WM + (size_t)(l >> 1) * WM_STRIDE + WM_MOUT), 0, 0, D_FFE, SC_M5, SC_ONE}; pg8::MoeOrder S; S.init(cntg, 4, G, (int)blockIdx.x, 0);
                pg8::EpiBf16Mod4 E; E.O = (bf16*)(ws + WS_YP);
                if ((FP8_LAYERS >> l) & 1u) RUN_GEMM8(pg8::EpiBf16Mod4, pg8::MoeOrder, true, g, S, E); else RUN_GEMM(pg8::EpiBf16Mod4, pg8::MoeOrder, true, g, S, E);
             REP_END } SEAM(pb + 7);
        } else {
            if (EN(12) && IN(pb + 6)) { REP_BEGIN(12)
                unsigned char* ws = karg_ws(kargs());
                pg8::Gemm g{(const bf16*)(ws + WS_XN), (const bf16*)(ws + WS_WD + (size_t)(l >> 1) * WD_STRIDE + WD_FIN), M, 2 * D_FF, D, SC_M5, SC_ONE}; pg8::StaticOrder S; S.init(M, 2 * D_FF, G, (int)blockIdx.x);
                if ((FP8_LAYERS >> l) & 1u) { pg8::EpiSwiglu8 E; E.O = ws + WS_ACT; E.ldc = D_FF; E.ntile = 24; RUN_GEMM8(pg8::EpiSwiglu8, pg8::StaticOrder, true, g, S, E); }
                else { pg8::EpiSwiglu E; E.O = (bf16*)(ws + WS_ACT); E.ldc = D_FF; E.ntile = 24; RUN_GEMM(pg8::EpiSwiglu, pg8::StaticOrder, true, g, S, E); }
             REP_END } SEAM(pb + 6);
            if (EN(13) && IN(pb + 7)) { REP_BEGIN(13)
                unsigned char* ws = karg_ws(kargs());
                pg8::Gemm g{(const bf16*)(ws + WS_ACT), (const bf16*)(ws + WS_WD + (size_t)(l >> 1) * WD_STRIDE + WD_FOUT), M, D, D_FF, SC_M6, SC_ONE}; pg8::StaticOrder S; S.init(M, D, G, (int)blockIdx.x);
                if (fuse) {
                    const kargp_t kp = kargs(); const float* ada = (const float*)(ws + WS_ADA) + (size_t)(l * 2) * 6144; const float* adan = (const float*)(ws + WS_ADA) + (size_t)((l + 1) * 2) * 6144; unsigned* ctlw = (unsigned*)(ws + WS_CTL); const int bank = (l >> 1) * 4 + 2;
                    pg8::EpiRmsResRms E; E.xin32 = nullptr; E.xin16 = (const bf16*)(ws + WS_XB); E.XB = (bf16*)(ws + WS_XB); E.XN = (bf16*)(ws + WS_XN); E.xn_fp8 = 0;
                    E.gainA = karg_in(kp, 7) + l * D; E.gateA = ada + 5120; E.gainB = karg_in(kp, 4) + (l + 1) * D; E.scB = adan + 1024; E.shB = adan;
                    E.st1.xbuf = (float*)(ws + WS_XS) + (size_t)bank * 65536; E.st1.cnt = ctlw + CW_SEAM + bank * SEAM_BANK; E.st1.tmo = ctlw;
                    E.st2.xbuf = (float*)(ws + WS_XS) + (size_t)(bank + 1) * 65536; E.st2.cnt = ctlw + CW_SEAM + (bank + 1) * SEAM_BANK; E.st2.tmo = ctlw;
                    if ((FP8_LAYERS >> l) & 1u) RUN_GEMM8(pg8::EpiRmsResRms, pg8::StaticOrder, false, g, S, E); else RUN_GEMM(pg8::EpiRmsResRms, pg8::StaticOrder, false, g, S, E);
                } else { pg8::EpiBf16N E; E.O = (bf16*)(ws + WS_MIX);
                    if ((FP8_LAYERS >> l) & 1u) RUN_GEMM8(pg8::EpiBf16N, pg8::StaticOrder, false, g, S, E); else RUN_GEMM(pg8::EpiBf16N, pg8::StaticOrder, false, g, S, E); }
             REP_END } SEAM(pb + 7);
        }
        if (EN(14) && IN(pb + 8) && !fuse) { TID_DEFS thin_end(l, wave, lane); }
        if (!fuse) SEAM(pb + 8);
    }
#undef IN
#undef SEAM
}

extern "C" void kernel_launch(void* const* d_in, const int* in_sizes, int n_in, void* d_out, int out_size, void* d_ws, size_t ws_size, hipStream_t stream) {
    static int grid = 0;
    if (grid == 0) {
        if (n_in != 24 || in_sizes[0] != M * D || out_size != M * D || ws_size < WS_END) { fprintf(stderr, "kernel_launch: unexpected shapes or workspace (n_in %d, in0 %d, out %d, ws %zu < %zu); nothing launched\n", n_in, n_in > 0 ? in_sizes[0] : -1, out_size, ws_size, (size_t)WS_END); grid = -1; return; }
        int dev = 0, cus = 0, per_cu = 0;
        if (hipGetDevice(&dev) != hipSuccess || hipDeviceGetAttribute(&cus, hipDeviceAttributeMultiprocessorCount, dev) != hipSuccess) { grid = -1; return; }
        if (hipFuncSetAttribute((const void*)trunk_fwd, hipFuncAttributeMaxDynamicSharedMemorySize, LDS_BYTES) != hipSuccess) { fprintf(stderr, "kernel_launch: hipFuncSetAttribute failed\n"); grid = -1; return; }
        if (hipOccupancyMaxActiveBlocksPerMultiprocessor(&per_cu, (const void*)trunk_fwd, NWAVES * 64, LDS_BYTES) != hipSuccess || per_cu < 1)
            fprintf(stderr, "kernel_launch: note: occupancy query reports %d workgroups per CU\n", per_cu);
        (void)hipGetLastError();
        grid = cus;
    }
    if (grid < 0) return;
    if (hipMemsetAsync((char*)d_ws + WS_CTL, 0, CTL_ZERO_BYTES, stream) != hipSuccess) return;
    Args a{};
    for (int i = 0; i < 24; ++i) a.in[i] = (const float*)d_in[i];
    a.out = (float*)d_out; a.ws = (unsigned char*)d_ws;
#if MK_ONE_LAUNCH
    a.ph_lo = 0; a.ph_hi = N_PHASES;
    hipLaunchKernelGGL(trunk_fwd, dim3(grid), dim3(NWAVES * 64), LDS_BYTES, stream, a);
#else
    for (int p = 0; p < N_PHASES; ++p) { a.ph_lo = p; a.ph_hi = p + 1; hipLaunchKernelGGL(trunk_fwd, dim3(grid), dim3(NWAVES * 64), LDS_BYTES, stream, a); }
#endif
}
```

```cpp
#include <hip/hip_runtime.h>
#include <cstdio>
#include <cstdint>

#ifndef MK_ONE_LAUNCH
#define MK_ONE_LAUNCH 1
#endif
#ifndef NAIVE_GEMM
#define NAIVE_GEMM 0
#endif

#ifndef FP8_LAYERS
#define FP8_LAYERS 0xEu
#endif
#define DI __device__ __forceinline__
#define GAS __attribute__((address_space(1)))
#define LAS __attribute__((address_space(3)))
typedef unsigned short bf16;
typedef short bf16x8 __attribute__((ext_vector_type(8)));
typedef short s16x4 __attribute__((ext_vector_type(4)));
typedef float f32x2 __attribute__((ext_vector_type(2)));
typedef float f32x4 __attribute__((ext_vector_type(4)));
typedef float f32x16 __attribute__((ext_vector_type(16)));
typedef unsigned u32x2 __attribute__((ext_vector_type(2)));
typedef unsigned u32x4 __attribute__((ext_vector_type(4)));
typedef __bf16 bf16x2_t __attribute__((ext_vector_type(2)));
typedef GAS unsigned gu32;

constexpr int BATCH = 2, SEQ = 8192, D = 1024, DEPTH = 4, M = BATCH * SEQ;
constexpr int D_IN = 5632, D_FF = 3072, NE = 8, D_FFE = 1536, ECAP = 16384;
constexpr float EPS = 1e-6f;
constexpr float LOG2E = 1.4426950408889634f;
constexpr float QSCALE = 0.08838834764831845f * 1.4426950408889634f;

DI unsigned pk2(float lo, float hi) { f32x2 v = {lo, hi}; return __builtin_bit_cast(unsigned, __builtin_convertvector(v, bf16x2_t)); }
DI float bflo(unsigned w) { return __uint_as_float(w << 16); }
DI float bfhi(unsigned w) { return __uint_as_float(w & 0xffff0000u); }
DI float fexp2(float x) { return __builtin_amdgcn_exp2f(x); }
DI float frcp(float x) { return __builtin_amdgcn_rcpf(x); }
DI float sigmoidf_(float v) { return frcp(1.0f + fexp2(-LOG2E * v)); }
DI float siluf_(float v) { return v * sigmoidf_(v); }
DI float gelu_tanh_(float v) { const float t = v + 0.044715f * v * v * v; return v * frcp(1.0f + fexp2(-2.0f * 0.7978845608028654f * LOG2E * t)); }
DI float wave_sum(float v) {
#pragma unroll
    for (int o = 1; o < 64; o <<= 1) v += __shfl_xor(v, o);
    return v;
}
#define LDS_WAIT() asm volatile("s_waitcnt lgkmcnt(0)" ::: "memory")
#define VM_WAIT() asm volatile("s_waitcnt vmcnt(0)" ::: "memory")
#define RLX_AGENT __ATOMIC_RELAXED, __HIP_MEMORY_SCOPE_AGENT
#ifndef HOOK_ON
#define HOOK_ON 1
#endif
#ifndef WGM_SET
#define WGM_SET 8
#endif
namespace pg8 {
#define PG8_LAS __attribute__((address_space(3)))
typedef unsigned short bf16_t;
constexpr int BM = 256, BK = 64, HALF = 128, HTB = HALF * BK * 2  , STAGE_BYTES = 8 * HTB, NXCD = 8, WGM = WGM_SET;

__host__ __device__ __forceinline__ int lds_byte(int r, int c) { const int st = (r >> 4) * 2 + (c >> 5), rr = r & 15, cc = c & 31, ob = rr * 64 + cc * 2; return st * 1024 + (ob ^ (((ob >> 9) & 1) << 5)); }
__host__ __device__ __forceinline__ void stage_rc(int b, int& R, int& C) { const int st = b / 1024, sb = b % 1024, swz = sb ^ (((sb >> 9) & 1) << 5); R = (st >> 1) * 16 + swz / 64; C = (st & 1) * 32 + (swz % 64) / 2; }
__host__ __device__ __forceinline__ int perm32(int rho) { const int n = rho >> 4, i = rho & 15; return 8 * (i >> 2) + 4 * n + (i & 3); }

struct Unit { int pm, pn, po; };
struct Gemm { const bf16_t* A; const bf16_t* Bt; int M, N, K; int sw, sa; };
typedef int i32x8 __attribute__((ext_vector_type(8)));
typedef int i32x4v __attribute__((ext_vector_type(4)));
__device__ __forceinline__ i32x8 cat8(bf16x8 lo, bf16x8 hi) { return __builtin_shufflevector(__builtin_bit_cast(i32x4v, lo), __builtin_bit_cast(i32x4v, hi), 0, 1, 2, 3, 4, 5, 6, 7); }
__device__ __forceinline__ unsigned pk4fp8(f32x4 v) { int w = __builtin_amdgcn_cvt_pk_fp8_f32(v[0], v[1], 0, false); w = __builtin_amdgcn_cvt_pk_fp8_f32(v[2], v[3], w, true); return (unsigned)w; }

struct StaticOrder {
    int nM, nN, nwg, G, c;
    __host__ __device__ void init(int M, int N, int G_, int c_) { nM = M / BM; nN = N / BM; nwg = nM * nN; G = G_; c = c_; }
    __host__ __device__ bool next(int i, Unit& u) const {
        const long L = (long)i * G + c; if (L >= nwg) return false;
        int wgid = (int)L; { const int q = nwg / NXCD, r = nwg % NXCD, xcd = wgid % NXCD, off = wgid / NXCD; wgid = (xcd < r ? xcd * (q + 1) : r * (q + 1) + (xcd - r) * q) + off; }
        const int nig = WGM * nN, gid = wgid / nig, fm = gid * WGM, gsz = (nM - fm) < WGM ? (nM - fm) : WGM;
        u.pm = fm + ((wgid % nig) % gsz); u.pn = (wgid % nig) / gsz; u.po = u.pm; return true;
    }
    __device__ __forceinline__ void a_ready(const Unit&) const {}
    __device__ __forceinline__ void done(const Unit&) const {}
};
struct ListOrder {
    int first, count, ncol, pn0;
    __device__ __forceinline__ bool next(int i, Unit& u) const { if (i >= count) return false; const int g = first + i; u.pm = g / ncol; u.pn = pn0 + g % ncol; u.po = u.pm; return true; }
    __device__ __forceinline__ void a_ready(const Unit&) const {}
    __device__ __forceinline__ void done(const Unit&) const {}
};
struct MoeOrder {
    int pp[9]; int nM, nN, nwg, G, c, astride;
    __device__ __forceinline__ void init(const unsigned* cnt, int NT, int G_, int c_, int astride_) {
        int a = 0;
#pragma unroll
        for (int e = 0; e < 8; ++e) { pp[e] = a; const unsigned n = (unsigned)__builtin_amdgcn_readfirstlane((int)__hip_atomic_load(cnt + e, RLX_AGENT)); a += (int)((n + 255u) >> 8); }
        pp[8] = a; nM = a; nN = NT; nwg = nM * nN; G = G_; c = c_; astride = astride_;
    }
    __device__ __forceinline__ bool next(int i, Unit& u) const {
        const long L = (long)i * G + c; if (L >= nwg) return false;
        int wgid = (int)L; { const int q = nwg / NXCD, r = nwg % NXCD, xcd = wgid % NXCD, off = wgid / NXCD; wgid = (xcd < r ? xcd * (q + 1) : r * (q + 1) + (xcd - r) * q) + off; }
        const int nig = WGM * nN, gid = wgid / nig, fm = gid * WGM, gsz = (nM - fm) < WGM ? (nM - fm) : WGM;
        const int vp = fm + ((wgid % nig) % gsz), t = (wgid % nig) / gsz;
        int e = 0, base = 0;
#pragma unroll
        for (int k = 1; k < 8; ++k) if (vp >= pp[k]) { e = k; base = pp[k]; }
        u.pm = astride ? e * astride + (vp - base) : vp; u.pn = e * nN + t; u.po = vp; return true;
    }
    __device__ __forceinline__ void a_ready(const Unit&) const {}
    __device__ __forceinline__ void done(const Unit&) const {}
};

template <class E> __device__ __forceinline__ void epi_rows(const E& e, const f32x4 (&acc)[2][2][4][2], const Unit& u, int wr, int wc, int fr, int fq) {
    asm volatile("" : "+v"(fr), "+v"(fq));
#pragma unroll
    for (int ai = 0; ai < 2; ++ai)
#pragma unroll
        for (int m = 0; m < 4; ++m) e.row8(u, ai * HALF + wr * 64 + m * 16 + fr, wc * 32 + 8 * fq, acc[ai][0][m][0], acc[ai][0][m][1], acc[ai][1][m][0], acc[ai][1][m][1]);
}
#define PG8_EPI_COMMON static constexpr bool PERM = true, AFTER_DRAIN = false, MID_HOOK = false; \
    __device__ __forceinline__ void operator()(const f32x4 (&acc)[2][2][4][2], const Unit& u, int wr, int wc, int fr, int fq) const { epi_rows(*this, acc, u, wr, wc, fr, fq); }
__device__ __forceinline__ void st8bf(bf16_t* p, f32x4 a, f32x4 b) { u32x4 w; w.x = pk2(a[0], a[1]); w.y = pk2(a[2], a[3]); w.z = pk2(b[0], b[1]); w.w = pk2(b[2], b[3]); *(u32x4*)p = w; }
__device__ __forceinline__ void ld8bf(const bf16_t* p, f32x4& a, f32x4& b) { const u32x4 w = *(const u32x4*)p; a = (f32x4){bflo(w.x), bfhi(w.x), bflo(w.y), bfhi(w.y)}; b = (f32x4){bflo(w.z), bfhi(w.z), bflo(w.w), bfhi(w.w)}; }
__device__ __forceinline__ f32x4 gelu4(f32x4 v) { return (f32x4){gelu_tanh_(v[0]), gelu_tanh_(v[1]), gelu_tanh_(v[2]), gelu_tanh_(v[3])}; }
__device__ __forceinline__ f32x4 sig4(f32x4 v) { return (f32x4){sigmoidf_(v[0]), sigmoidf_(v[1]), sigmoidf_(v[2]), sigmoidf_(v[3])}; }
__device__ __forceinline__ f32x4 silu4(f32x4 v) { return (f32x4){siluf_(v[0]), siluf_(v[1]), siluf_(v[2]), siluf_(v[3])}; }

struct EpiWin { PG8_EPI_COMMON
    unsigned char* R;
    __device__ __forceinline__ void row8(const Unit& u, int r, int cit, f32x4 a0, f32x4 a1, f32x4 b0, f32x4 b1) const {
        const size_t row = (size_t)u.po * BM + r; const int pn = u.pn;
        bf16_t* XR = (bf16_t*)R; bf16_t* GG = (bf16_t*)(R + (32u << 20)); bf16_t* Q = (bf16_t*)(R + (64u << 20)); bf16_t* KB = (bf16_t*)(R + (96u << 20)); bf16_t* VB = (bf16_t*)(R + (104u << 20)); bf16_t* GT = (bf16_t*)(R + (112u << 20));
        if (pn < 4)       { bf16_t* o = XR + row * 1024 + 256 * pn + cit; st8bf(o, a0, a1); st8bf(o + HALF, b0, b1); }
        else if (pn < 8)  { bf16_t* o = GG + row * 1024 + 256 * (pn - 4) + cit; st8bf(o, gelu4(a0), gelu4(a1)); st8bf(o + HALF, gelu4(b0), gelu4(b1)); }
        else if (pn < 12) { bf16_t* o = Q + row * 1024 + 256 * (pn - 8) + cit; st8bf(o, a0 * QSCALE, a1 * QSCALE); st8bf(o + HALF, b0 * QSCALE, b1 * QSCALE); }
        else if (pn == 12) { bf16_t* o = KB + row * 256 + cit; st8bf(o, a0, a1); st8bf(o + HALF, b0, b1); }
        else if (pn == 13) { bf16_t* o = VB + row * 256 + cit; st8bf(o, a0, a1); st8bf(o + HALF, b0, b1); }
        else { bf16_t* o = GT + row * 2048 + 256 * (pn - 14) + cit; st8bf(o, sig4(a0), sig4(a1)); st8bf(o + HALF, sig4(b0), sig4(b1)); }
    }
};
struct EpiMerge {
    static constexpr bool PERM = true, AFTER_DRAIN = false, MID_HOOK = true;
    unsigned char* R;
    __device__ __forceinline__ void operator()(const f32x4 (&acc)[2][2][4][2], const Unit& u, int wr, int wc, int fr, int fq) const { epi_rows(*this, acc, u, wr, wc, fr, fq); }
    __device__ __forceinline__ void mid(f32x4 (&acc)[2][2][4][2], const Unit& u, int wr, int wc, int fr, int fq) const {
        asm volatile("" : "+v"(fr), "+v"(fq));
        const bf16_t* GT = (const bf16_t*)(R + (112u << 20));
#pragma unroll
        for (int ai = 0; ai < 2; ++ai)
#pragma unroll
            for (int m = 0; m < 4; ++m) { const size_t row = (size_t)u.po * BM + ai * HALF + wr * 64 + m * 16 + fr;
#pragma unroll
                for (int bj = 0; bj < 2; ++bj) { const int c = 256 * u.pn + bj * HALF + wc * 32 + 8 * fq; f32x4 g0a, g0b, g1a, g1b; ld8bf(GT + row * 2048 + c, g0a, g0b); ld8bf(GT + row * 2048 + 1024 + c, g1a, g1b);
#pragma unroll
                    for (int i = 0; i < 4; ++i) { acc[ai][bj][m][0][i] *= g0a[i] * frcp(fmaxf(g1a[i], 1e-30f)); acc[ai][bj][m][1][i] *= g0b[i] * frcp(fmaxf(g1b[i], 1e-30f)); } } }
    }
    __device__ __forceinline__ void row8(const Unit& u, int r, int cit, f32x4 a0, f32x4 a1, f32x4 b0, f32x4 b1) const {
        const size_t row = (size_t)u.po * BM + r; const int c = 256 * u.pn + cit;
        const bf16_t* GT = (const bf16_t*)(R + (112u << 20)); bf16_t* MG = (bf16_t*)(R + (304u << 20));
        f32x4 g0, g1; ld8bf(GT + row * 2048 + 1024 + c, g0, g1); st8bf(MG + row * 1024 + c, g0 * a0, g1 * a1);
        ld8bf(GT + row * 2048 + 1024 + c + HALF, g0, g1); st8bf(MG + row * 1024 + c + HALF, g0 * b0, g1 * b1);
    }
};
struct EpiBf16N { PG8_EPI_COMMON
    bf16_t* O;
    __device__ __forceinline__ void row8(const Unit& u, int r, int cit, f32x4 a0, f32x4 a1, f32x4 b0, f32x4 b1) const {
        bf16_t* o = O + ((size_t)u.po * BM + r) * 1024 + 256 * u.pn + cit; st8bf(o, a0, a1); st8bf(o + HALF, b0, b1);
    }
};
struct EpiF32 { PG8_EPI_COMMON
    float* O;
    __device__ __forceinline__ void row8(const Unit& u, int r, int cit, f32x4 a0, f32x4 a1, f32x4 b0, f32x4 b1) const {
        float* o = O + ((size_t)u.po * BM + r) * 1024 + 256 * u.pn + cit; *(f32x4*)o = a0; *(f32x4*)(o + 4) = a1; *(f32x4*)(o + HALF) = b0; *(f32x4*)(o + HALF + 4) = b1;
    }
};
struct EpiSwiglu { PG8_EPI_COMMON
    bf16_t* O; int ldc, ntile;
    __device__ __forceinline__ void row8(const Unit& u, int r, int cit, f32x4 a0, f32x4 a1, f32x4 b0, f32x4 b1) const {
        st8bf(O + ((size_t)u.po * BM + r) * ldc + HALF * (u.pn % ntile) + cit, silu4(a0) * b0, silu4(a1) * b1);
    }
};
struct EpiSwiglu8 { PG8_EPI_COMMON
    unsigned char* O; int ldc, ntile;
    __device__ __forceinline__ void row8(const Unit& u, int r, int cit, f32x4 a0, f32x4 a1, f32x4 b0, f32x4 b1) const {
        u32x2 w; w.x = pk4fp8(silu4(a0) * b0); w.y = pk4fp8(silu4(a1) * b1); *(u32x2*)(O + ((size_t)u.po * BM + r) * ldc + HALF * (u.pn % ntile) + cit) = w;
    }
};
struct EpiBf16Mod4 { PG8_EPI_COMMON
    bf16_t* O;
    __device__ __forceinline__ void row8(const Unit& u, int r, int cit, f32x4 a0, f32x4 a1, f32x4 b0, f32x4 b1) const {
        bf16_t* o = O + ((size_t)u.po * BM + r) * 1024 + 256 * (u.pn & 3) + cit; st8bf(o, a0, a1); st8bf(o + HALF, b0, b1);
    }
};


struct PanelSS {
    float* xbuf;
    unsigned* cnt;
    unsigned* tmo;
    __device__ __forceinline__ void run(const f32x4 (&v)[2][2][4][2], const Unit& u, int wr, int wc, int fr, int fq, PG8_LAS unsigned char* lds, int wid, int lane) const {
        PG8_LAS float* P = (PG8_LAS float*)lds;
        PG8_LAS float* S = (PG8_LAS float*)(lds + 8192);
        PG8_LAS unsigned* flag = (PG8_LAS unsigned*)(lds + 8192 + 2048);
#pragma unroll
        for (int ai = 0; ai < 2; ++ai)
#pragma unroll
            for (int m = 0; m < 4; ++m) { float s = 0.f;
#pragma unroll
                for (int bj = 0; bj < 2; ++bj)
#pragma unroll
                    for (int n = 0; n < 2; ++n) { const f32x4 x = v[ai][bj][m][n]; s += (x[0] * x[0] + x[1] * x[1]) + (x[2] * x[2] + x[3] * x[3]); }
                s += __shfl_xor(s, 16); s += __shfl_xor(s, 32);
                if (fq == 0) P[(ai * HALF + wr * 64 + m * 16 + fr) * 4 + wc] = s; }
        asm volatile("s_waitcnt lgkmcnt(0)" ::: "memory"); __builtin_amdgcn_s_barrier(); asm volatile("" ::: "memory");
        const int row = wid * 32 + (lane & 31);
        if (lane < 32) { const f32x4 p = *(const PG8_LAS f32x4*)(P + row * 4);
            __hip_atomic_store((unsigned*)xbuf + ((size_t)(u.pm * BM + row) * 4 + u.pn), __float_as_uint((p[0] + p[1]) + (p[2] + p[3])), __ATOMIC_RELAXED, __HIP_MEMORY_SCOPE_AGENT); }
        asm volatile("s_waitcnt vmcnt(0)" ::: "memory");
        if (lane == 0) __hip_atomic_fetch_add(cnt + 64 * u.pm, 1u, __ATOMIC_RELAXED, __HIP_MEMORY_SCOPE_AGENT);
        if (wid == 0) {
            const unsigned long long t0 = __builtin_amdgcn_s_memrealtime();
            for (;;) {
                if ((unsigned)__builtin_amdgcn_readfirstlane((int)__hip_atomic_load(cnt + 64 * u.pm, __ATOMIC_RELAXED, __HIP_MEMORY_SCOPE_AGENT)) >= 32u) break;
                if (__builtin_amdgcn_s_memrealtime() - t0 > 2000000ull) { if (lane == 0) __hip_atomic_store(tmo, 1u, __ATOMIC_RELAXED, __HIP_MEMORY_SCOPE_AGENT); break; }
                __builtin_amdgcn_s_sleep(2);
            }
            __builtin_amdgcn_fence(__ATOMIC_ACQUIRE, "agent");
            if (lane == 0) flag[0] = 0u;
        }
        asm volatile("s_waitcnt vmcnt(0) lgkmcnt(0)" ::: "memory"); __builtin_amdgcn_s_barrier(); asm volatile("" ::: "memory");
        if (lane < 32) { const unsigned* slot = (const unsigned*)xbuf + (size_t)(u.pm * BM + row) * 4; float t = 0.f;
#pragma unroll
            for (int k = 0; k < 4; ++k) t += __uint_as_float(__hip_atomic_load(slot + k, __ATOMIC_RELAXED, __HIP_MEMORY_SCOPE_AGENT));
            S[row] = rsqrtf(t * (1.0f / 1024.0f) + 1e-6f); }
        asm volatile("s_waitcnt lgkmcnt(0)" ::: "memory"); __builtin_amdgcn_s_barrier(); asm volatile("" ::: "memory");
    }
};
struct EpiRmsResRms {
    static constexpr bool PERM = true, AFTER_DRAIN = true, MID_HOOK = false;
    const float* xin32; const bf16_t* xin16;
    bf16_t* XB; bf16_t* XN; int xn_fp8;
    const float *gainA, *gateA, *gainB, *scB, *shB;
    PanelSS st1, st2;
    __device__ __forceinline__ void fused(f32x4 (&acc)[2][2][4][2], const Unit& u, int wr, int wc, int fr, int fq, PG8_LAS unsigned char* lds, int wid, int lane) const {
        asm volatile("" : "+v"(fr), "+v"(fq));
        const PG8_LAS float* S = (const PG8_LAS float*)(lds + 8192);
        const int bofs = (((u.pm * BM) >> 13) != 0) ? 6144 : 0;
        const int col0 = 256 * u.pn + wc * 32 + 8 * fq;
        st1.run(acc, u, wr, wc, fr, fq, lds, wid, lane);
        { f32x4 cA[2][2];
#pragma unroll
          for (int bj = 0; bj < 2; ++bj)
#pragma unroll
            for (int n = 0; n < 2; ++n) cA[bj][n] = *(const f32x4*)(gainA + col0 + bj * HALF + 4 * n) * *(const f32x4*)(gateA + bofs + col0 + bj * HALF + 4 * n);
#pragma unroll
          for (int ai = 0; ai < 2; ++ai)
#pragma unroll
            for (int m = 0; m < 4; ++m) { const int r = ai * HALF + wr * 64 + m * 16 + fr; const float rs = S[r]; const size_t off = (size_t)(u.pm * BM + r) * 1024 + col0;
#pragma unroll
                for (int bj = 0; bj < 2; ++bj) { f32x4 x0, x1;
                    if (xin32) { x0 = *(const f32x4*)(xin32 + off + bj * HALF); x1 = *(const f32x4*)(xin32 + off + bj * HALF + 4); } else ld8bf(xin16 + off + bj * HALF, x0, x1);
                    acc[ai][bj][m][0] = x0 + cA[bj][0] * (acc[ai][bj][m][0] * rs); acc[ai][bj][m][1] = x1 + cA[bj][1] * (acc[ai][bj][m][1] * rs);
                    st8bf(XB + off + bj * HALF, acc[ai][bj][m][0], acc[ai][bj][m][1]); }
                asm volatile("" : "+v"(acc[ai][0][m][0]), "+v"(acc[ai][0][m][1]), "+v"(acc[ai][1][m][0]), "+v"(acc[ai][1][m][1])); } }
        st2.run(acc, u, wr, wc, fr, fq, lds, wid, lane);
        { f32x4 cB[2][2], cC[2][2];
#pragma unroll
          for (int bj = 0; bj < 2; ++bj)
#pragma unroll
            for (int n = 0; n < 2; ++n) { cB[bj][n] = *(const f32x4*)(gainB + col0 + bj * HALF + 4 * n) * (*(const f32x4*)(scB + bofs + col0 + bj * HALF + 4 * n) + 1.0f); cC[bj][n] = *(const f32x4*)(shB + bofs + col0 + bj * HALF + 4 * n); }
#pragma unroll
          for (int ai = 0; ai < 2; ++ai)
#pragma unroll
            for (int m = 0; m < 4; ++m) { const int r = ai * HALF + wr * 64 + m * 16 + fr; const float rs = S[r]; const size_t off = (size_t)(u.pm * BM + r) * 1024 + col0;
#pragma unroll
                for (int bj = 0; bj < 2; ++bj) { const f32x4 h0 = acc[ai][bj][m][0] * rs * cB[bj][0] + cC[bj][0], h1 = acc[ai][bj][m][1] * rs * cB[bj][1] + cC[bj][1];
                    if (xn_fp8) { u32x2 w; w.x = pk4fp8(h0); w.y = pk4fp8(h1); *(u32x2*)((unsigned char*)XN + off + bj * HALF) = w; } else st8bf(XN + off + bj * HALF, h0, h1); } } }
    }
};
template <class Epi, class Sched>
__device__ __forceinline__ void gemm_phase_naive(const Gemm g, const Sched& S, const Epi& E) {
    Unit u;
    for (int i = 0; S.next(i, u); ++i) {
        for (int idx = threadIdx.x; idx < 256 * 16; idx += blockDim.x) {
            const int r = idx >> 4, cit = (idx & 15) * 8;
            const bf16_t* a = g.A + ((size_t)u.pm * BM + r) * g.K;
            float o[16];
#pragma unroll
            for (int j = 0; j < 16; ++j) o[j] = 0.f;
            for (int k = 0; k < g.K; k += 8) {
                f32x4 x0, x1; ld8bf(a + k, x0, x1);
#pragma unroll
                for (int j = 0; j < 16; ++j) { const bf16_t* b = g.Bt + ((size_t)u.pn * BM + (j >> 3) * HALF + cit + (j & 7)) * g.K + k; f32x4 y0, y1; ld8bf(b, y0, y1);
                    o[j] += x0[0] * y0[0] + x0[1] * y0[1] + x0[2] * y0[2] + x0[3] * y0[3] + x1[0] * y1[0] + x1[1] * y1[1] + x1[2] * y1[2] + x1[3] * y1[3]; }
            }
            E.row8(u, r, cit, (f32x4){o[0], o[1], o[2], o[3]}, (f32x4){o[4], o[5], o[6], o[7]}, (f32x4){o[8], o[9], o[10], o[11]}, (f32x4){o[12], o[13], o[14], o[15]});
        }
    }
}

template <class Epi, class Sched, bool ALIGN_EPI = false, bool SP2 = false, bool FP8 = false>
__device__ __forceinline__ void gemm_phase(PG8_LAS unsigned char* lds, const Gemm g, const Sched& S, const Epi& E) {
    int tid_ = threadIdx.x; asm volatile("" : "+v"(tid_));
    const int tid = tid_, wid = __builtin_amdgcn_readfirstlane(tid >> 6), lane = tid & 63, wr = wid >> 2, wc = wid & 3, fr = lane & 15, fq = lane >> 4;
    constexpr int ESZ = FP8 ? 1 : 2;
    const int K = g.K, nt = K * ESZ / (BK * 2);
    unsigned voffA[2], voffB[2];
#pragma unroll
    for (int i = 0; i < 2; ++i) { int R, C; stage_rc(tid * 16 + i * 8192, R, C); const int Rb = Epi::PERM ? ((R & ~31) + perm32(R & 31)) : R;
        voffA[i] = (unsigned)(R * K * ESZ + C * 2); voffB[i] = (unsigned)(Rb * K * ESZ + C * 2); }
    const size_t kstep = (size_t)(BK * 2);
    const size_t hstep = (size_t)HALF * K * ESZ;
    const size_t tstep = 2 * hstep;
    const unsigned ldsw = (unsigned)wid * 1024u;
    const int aoff = lds_byte(wr * 64 + fr, FP8 ? fq * 16 : fq * 8), boff = lds_byte(wc * 32 + fr, FP8 ? fq * 16 : fq * 8);
#define PG8_SA(b, h) (((b) * 2 + (h)) * HTB)
#define PG8_SB(b, h) ((4 + (b) * 2 + (h)) * HTB)
#define PG8_STAGE(bufoff, gbase, voff) do { _Pragma("unroll") for (int _i = 0; _i < 2; ++_i) \
        __builtin_amdgcn_global_load_lds((const unsigned*)((const char*)(gbase) + (voff)[_i]), (PG8_LAS unsigned*)(lds + (bufoff) + ldsw + _i * 8192), 16, 0, 0); } while (0)
#define PG8_LDA(dst, b, h) do { _Pragma("unroll") for (int m = 0; m < 4; ++m) { if constexpr (FP8) dst##8[m] = cat8(*(const PG8_LAS bf16x8*)(lds + PG8_SA(b, h) + aoff + m * 2048), *(const PG8_LAS bf16x8*)(lds + PG8_SA(b, h) + aoff + m * 2048 + 16)); \
        else { _Pragma("unroll") for (int k = 0; k < 2; ++k) dst[m][k] = *(const PG8_LAS bf16x8*)(lds + PG8_SA(b, h) + aoff + m * 2048 + k * 1024); } } } while (0)
#define PG8_LDB(dst, b, h) do { _Pragma("unroll") for (int n = 0; n < 2; ++n) { if constexpr (FP8) dst##8[n] = cat8(*(const PG8_LAS bf16x8*)(lds + PG8_SB(b, h) + boff + n * 2048), *(const PG8_LAS bf16x8*)(lds + PG8_SB(b, h) + boff + n * 2048 + 16)); \
        else { _Pragma("unroll") for (int k = 0; k < 2; ++k) dst[n][k] = *(const PG8_LAS bf16x8*)(lds + PG8_SB(b, h) + boff + n * 2048 + k * 1024); } } } while (0)
#define PG8_MMA(ai, bj, At, Bt) do { __builtin_amdgcn_s_setprio(1); _Pragma("unroll") for (int m = 0; m < 4; ++m) _Pragma("unroll") for (int n = 0; n < 2; ++n) { \
        if constexpr (FP8) asm volatile("v_mfma_scale_f32_16x16x128_f8f6f4 %0, %1, %2, %0, %3, %4 op_sel_hi:[0,0,0]" : "+v"(acc[ai][bj][m][n]) : "v"(Bt##8[n]), "v"(At##8[m]), "v"(sw_), "v"(sa_)); \
        else { _Pragma("unroll") for (int k = 0; k < 2; ++k) acc[ai][bj][m][n] = __builtin_amdgcn_mfma_f32_16x16x32_bf16(Bt[n][k], At[m][k], acc[ai][bj][m][n], 0, 0, 0); } } \
        __builtin_amdgcn_s_setprio(0); } while (0)
#define PG8_WAIT_V(n) asm volatile("s_waitcnt vmcnt(" #n ")" ::: "memory")
#define PG8_WAIT_L(n) asm volatile("s_waitcnt lgkmcnt(" #n ")" ::: "memory")
#define PG8_BAR __builtin_amdgcn_s_barrier()
#define PG8_SCHED __builtin_amdgcn_sched_barrier(0)
    Unit cur, nxt; int ui = 0;
    if (!S.next(0, cur)) return;
    f32x4 acc[2][2][4][2];
#pragma unroll
    for (int a = 0; a < 2; ++a)
#pragma unroll
        for (int b = 0; b < 2; ++b)
#pragma unroll
            for (int m = 0; m < 4; ++m)
#pragma unroll
                for (int n = 0; n < 2; ++n) acc[a][b][m][n] = (f32x4){0.f, 0.f, 0.f, 0.f};
    const int sw_ = g.sw, sa_ = g.sa;
    bf16x8 At[4][2], B0[2][2], B1[2][2]; i32x8 At8[4], B08[2], B18[2];
    const char* cA = (const char*)g.A + (size_t)cur.pm * tstep; const char* cB = (const char*)g.Bt + (size_t)cur.pn * tstep;
    S.a_ready(cur);
    if constexpr (SP2) {
        PG8_STAGE(PG8_SB(0, 0), cB, voffB); PG8_STAGE(PG8_SB(0, 1), cB + hstep, voffB); PG8_STAGE(PG8_SA(0, 0), cA, voffA); PG8_STAGE(PG8_SA(0, 1), cA + hstep, voffA);
        if (wr == 1) PG8_BAR;
        PG8_WAIT_V(2); PG8_BAR;
        PG8_STAGE(PG8_SB(1, 0), cB + kstep, voffB); PG8_STAGE(PG8_SA(1, 0), cA + kstep, voffA); PG8_STAGE(PG8_SB(1, 1), cB + hstep + kstep, voffB);
        PG8_WAIT_V(6); PG8_BAR;
    } else {
        PG8_STAGE(PG8_SB(0, 0), cB, voffB); PG8_STAGE(PG8_SA(0, 0), cA, voffA); PG8_STAGE(PG8_SB(0, 1), cB + hstep, voffB); PG8_STAGE(PG8_SA(0, 1), cA + hstep, voffA);
        if (wr == 1) PG8_BAR;
        PG8_WAIT_V(4); PG8_BAR;
        PG8_STAGE(PG8_SB(1, 0), cB + kstep, voffB); PG8_STAGE(PG8_SA(1, 0), cA + kstep, voffA); PG8_STAGE(PG8_SB(1, 1), cB + hstep + kstep, voffB);
        PG8_WAIT_V(6); PG8_BAR;
    }
    for (;;) {
        const bool has_next = S.next(ui + 1, nxt);
        const char* nA = has_next ? (const char*)g.A + (size_t)nxt.pm * tstep : cA; const char* nB = has_next ? (const char*)g.Bt + (size_t)nxt.pn * tstep : cB;
        for (int t = 0; t < nt; t += 2) {
            if constexpr (Epi::MID_HOOK && HOOK_ON) { if (t == (nt >> 1)) E.mid(acc, cur, wr, wc, fr, fq); }
            const bool last = (t == nt - 2);
            const char* a1 = cA + (size_t)(t + 1) * kstep;
            const char* a2 = last ? nA : cA + (size_t)(t + 2) * kstep; const char* b2 = last ? nB : cB + (size_t)(t + 2) * kstep;
            const char* a3 = a2 + kstep; const char* b3 = b2 + kstep;
            if (last && has_next) S.a_ready(nxt);
            if constexpr (SP2) {
            PG8_LDB(B0, 0, 0); PG8_LDB(B1, 0, 1); PG8_SCHED; PG8_LDA(At, 0, 0); PG8_STAGE(PG8_SA(1, 1), a1 + hstep, voffA);
            PG8_WAIT_V(8); PG8_WAIT_L(0); PG8_BAR; PG8_MMA(0, 0, At, B0); PG8_MMA(0, 1, At, B1); PG8_BAR; PG8_SCHED;
            PG8_LDA(At, 0, 1); PG8_STAGE(PG8_SB(0, 0), b2, voffB); PG8_STAGE(PG8_SB(0, 1), b2 + hstep, voffB); PG8_STAGE(PG8_SA(0, 0), a2, voffA);
            PG8_WAIT_V(8); PG8_WAIT_L(0); PG8_BAR; PG8_MMA(1, 0, At, B0); PG8_MMA(1, 1, At, B1); PG8_BAR; PG8_SCHED;
            PG8_LDB(B0, 1, 0); PG8_LDB(B1, 1, 1); PG8_SCHED; PG8_LDA(At, 1, 0); PG8_STAGE(PG8_SA(0, 1), a2 + hstep, voffA);
            PG8_WAIT_V(8); PG8_WAIT_L(0); PG8_BAR; PG8_MMA(0, 0, At, B0); PG8_MMA(0, 1, At, B1); PG8_BAR; PG8_SCHED;
            PG8_LDA(At, 1, 1); PG8_STAGE(PG8_SB(1, 0), b3, voffB); PG8_STAGE(PG8_SB(1, 1), b3 + hstep, voffB); PG8_STAGE(PG8_SA(1, 0), a3, voffA);
            PG8_WAIT_V(8); PG8_WAIT_L(0); PG8_BAR; PG8_MMA(1, 0, At, B0); PG8_MMA(1, 1, At, B1); PG8_BAR; PG8_SCHED;
            } else {
            PG8_LDB(B0, 0, 0); PG8_SCHED; PG8_LDA(At, 0, 0); PG8_STAGE(PG8_SA(1, 1), a1 + hstep, voffA);
            PG8_WAIT_L(8); PG8_BAR; PG8_WAIT_L(0); PG8_MMA(0, 0, At, B0); PG8_BAR; PG8_SCHED;
            PG8_LDB(B1, 0, 1); PG8_STAGE(PG8_SB(0, 0), b2, voffB);
            PG8_BAR; PG8_WAIT_L(0); PG8_MMA(0, 1, At, B1); PG8_BAR;
            PG8_LDA(At, 0, 1); PG8_STAGE(PG8_SA(0, 0), a2, voffA);
            PG8_BAR; PG8_WAIT_L(0); PG8_MMA(1, 0, At, B0); PG8_BAR; PG8_SCHED;
            PG8_STAGE(PG8_SB(0, 1), b2 + hstep, voffB);
            PG8_WAIT_V(6); PG8_BAR; PG8_MMA(1, 1, At, B1); PG8_BAR;
            PG8_LDB(B0, 1, 0); PG8_SCHED; PG8_LDA(At, 1, 0); PG8_STAGE(PG8_SA(0, 1), a2 + hstep, voffA);
            PG8_WAIT_L(8); PG8_BAR; PG8_WAIT_L(0); PG8_MMA(0, 0, At, B0); PG8_BAR; PG8_SCHED;
            PG8_LDB(B1, 1, 1); PG8_STAGE(PG8_SB(1, 0), b3, voffB);
            PG8_BAR; PG8_WAIT_L(0); PG8_MMA(0, 1, At, B1); PG8_BAR;
            PG8_LDA(At, 1, 1); PG8_STAGE(PG8_SA(1, 0), a3, voffA);
            PG8_BAR; PG8_WAIT_L(0); PG8_MMA(1, 0, At, B0); PG8_BAR; PG8_SCHED;
            PG8_STAGE(PG8_SB(1, 1), b3 + hstep, voffB);
            PG8_WAIT_V(6); PG8_BAR; PG8_MMA(1, 1, At, B1); PG8_BAR;
            }
        }
        if constexpr (ALIGN_EPI) { if (wr == 0) PG8_BAR; }
        if constexpr (FP8) asm volatile("s_nop 15\n\ts_nop 15" ::: "memory");
        if constexpr (!Epi::AFTER_DRAIN) { E(acc, cur, wr, wc, fr, fq); S.done(cur); }
        if (!has_next) break;
#pragma unroll
        for (int a = 0; a < 2; ++a)
#pragma unroll
            for (int b = 0; b < 2; ++b)
#pragma unroll
                for (int m = 0; m < 4; ++m)
#pragma unroll
                    for (int n = 0; n < 2; ++n) acc[a][b][m][n] = (f32x4){0.f, 0.f, 0.f, 0.f};
        cur = nxt; cA = nA; cB = nB; ++ui;
        if constexpr (ALIGN_EPI) { if (wr == 1) PG8_BAR; }
    }
    PG8_WAIT_V(0);
    if constexpr (!ALIGN_EPI) { if (wr == 0) PG8_BAR; }
    PG8_BAR;
    if constexpr (Epi::AFTER_DRAIN) { if constexpr (FP8) asm volatile("s_nop 15\n\ts_nop 15" ::: "memory"); E.fused(acc, cur, wr, wc, fr, fq, lds, wid, lane); S.done(cur); }
#undef PG8_SA
#undef PG8_SB
#undef PG8_STAGE
#undef PG8_LDA
#undef PG8_LDB
#undef PG8_MMA
#undef PG8_WAIT_V
#undef PG8_WAIT_L
#undef PG8_BAR
#undef PG8_SCHED
}
}

constexpr int NWAVES = 8;
constexpr size_t MiB = 1u << 20;
constexpr size_t WS_CTL = 0, CTL_ZERO_BYTES = 1 * MiB;
constexpr size_t WS_ADA = 1 * MiB;
constexpr size_t WS_RAGG = 2 * MiB;
constexpr size_t WS_MIX = 288 * MiB; constexpr size_t WS_T16 = WS_MIX;
constexpr size_t WS_TOK = 3 * MiB;
constexpr size_t WS_WL = 4 * MiB, WL_STRIDE = 18 * MiB;
constexpr size_t WL_WIN = 0, WL_WB = 11 * MiB, WL_WO = 15 * MiB, WL_WRA = 17 * MiB, WL_WRX = 17 * MiB + 256 * 1024;
constexpr size_t WS_WD = 76 * MiB, WD_STRIDE = 18 * MiB;
constexpr size_t WD_FIN = 0, WD_FOUT = 12 * MiB;
constexpr size_t WS_WM = 112 * MiB, WM_STRIDE = 72 * MiB;
constexpr size_t WM_MIN = 0, WM_MOUT = 48 * MiB;
constexpr size_t WS_XN = 256 * MiB;
constexpr size_t WS_R = 352 * MiB;
constexpr size_t WS_XR = WS_R, WS_GG = WS_R + 32 * MiB, WS_Q = WS_R + 64 * MiB, WS_KB = WS_R + 96 * MiB, WS_VB = WS_R + 104 * MiB, WS_GT = WS_R + 112 * MiB;
constexpr size_t WS_RO = WS_R + 176 * MiB, WS_AO = WS_R + 208 * MiB, WS_MGP = WS_R + 240 * MiB, WS_MG = WS_R + 304 * MiB;
constexpr size_t WS_PS = WS_MGP;
constexpr size_t WS_XC = WS_MG;
constexpr size_t WS_ACT = WS_R;
constexpr size_t WS_AP = WS_R;
constexpr size_t WS_YP = WS_R;
constexpr size_t WS_ACTP = WS_R + 256 * MiB;
constexpr size_t WS_XB = WS_ACTP + 102 * MiB;
constexpr size_t WS_XS = WS_XB + 32 * MiB;
constexpr size_t WS_END = WS_XS + 2 * MiB;
constexpr int MAXPANELS = 136;

constexpr int CW_CNT = 64;
constexpr int CW_BAR = 4096;
constexpr int CW_SEAM = 16384, SEAM_BANK = 8192;
static_assert((CW_SEAM + 8 * SEAM_BANK) * 4 <= (int)CTL_ZERO_BYTES, "panel counters inside the memset region");

constexpr int RING_OFF = 0, RING_BYTES = 139264;
constexpr int LDSCTL_OFF = RING_BYTES, MISC_OFF = LDSCTL_OFF + 320;
constexpr int LDS_BYTES = 147456;

#define XB_TMO      128
#define XB_XCNT(j)  (256  + 64 * (j))
#define XB_XSUB(j)  (1280 + 64 * (j))
#define XB_XGEN(j)  (2304 + 64 * (j))
#define XB_TOP      3328
#define XB_TOPGEN   3392
#define XCD_BAR_WORDS 3456
#define XB_SPIN_CAP (1u << 18)

__device__ __forceinline__ unsigned xb_ld(unsigned* p)              { return __hip_atomic_load(p, __ATOMIC_RELAXED, __HIP_MEMORY_SCOPE_AGENT); }
__device__ __forceinline__ unsigned xb_add(unsigned* p, unsigned v) { return __hip_atomic_fetch_add(p, v, __ATOMIC_RELAXED, __HIP_MEMORY_SCOPE_AGENT); }
__device__ __forceinline__ unsigned xb_xcc_id() { return (unsigned)__builtin_amdgcn_s_getreg((3 << 11) | 20) & 0xFu; }
#define XB_SPIN(cond, bar) do { unsigned _sp = 0; while (cond) { __builtin_amdgcn_s_sleep(1); \
    if ((++_sp & 255u) == 0u) { if (xb_ld(&(bar)[XB_TMO])) break; if (_sp > XB_SPIN_CAP) { atomicAdd(&(bar)[XB_TMO], 1u); break; } } } } while (0)

struct XcdBarrier {
    unsigned* bar; unsigned x;
    volatile LAS unsigned* st;
};

__device__ __forceinline__ XcdBarrier xcd_barrier_post(unsigned* bar, volatile LAS unsigned* st) {
    XcdBarrier b; b.bar = bar; b.x = xb_xcc_id(); b.st = st;
    if (threadIdx.x == 0) (void)xb_add(&bar[XB_XCNT(b.x)], 1u);
    return b;
}
__device__ __forceinline__ void xcd_barrier_complete(unsigned* bar, unsigned x, unsigned& nloc, unsigned& nx) {
    const unsigned G = gridDim.x * gridDim.y * gridDim.z;
    unsigned sum, cnt, mine, sp = 0u;
    for (;;) {
        sum = 0u; cnt = 0u; mine = 0u;
#pragma unroll
        for (unsigned j = 0; j < 16; ++j) { const unsigned c = xb_ld(&bar[XB_XCNT(j)]); sum += c; cnt += (c > 0u) ? 1u : 0u; mine = (j == x) ? c : mine; }
        if (sum == G) break;
        __builtin_amdgcn_s_sleep(1);
        if ((++sp & 255u) == 0u) { if (xb_ld(&bar[XB_TMO])) break; if (sp > XB_SPIN_CAP) { atomicAdd(&bar[XB_TMO], 1u); break; } }
    }
    nloc = mine > 0u ? mine : 1u; nx = cnt > 0u ? cnt : 1u;
}

__device__ __forceinline__ void xcd_barrier(const XcdBarrier& b) {
    asm volatile("s_waitcnt vmcnt(0)" ::: "memory");
    __syncthreads();
    if (threadIdx.x == 0) {
        unsigned* bar = b.bar;
        __builtin_amdgcn_s_waitcnt(0);
        unsigned nloc = b.st[0], nx = b.st[1];
        if (nloc == 0u) { xcd_barrier_complete(bar, b.x, nloc, nx); b.st[0] = nloc; b.st[1] = nx; }
        const unsigned old = xb_add(&bar[XB_XSUB(b.x)], 1u);
        const unsigned gen = old / nloc;
        if (old + 1u == (gen + 1u) * nloc) {
            __builtin_amdgcn_fence(__ATOMIC_RELEASE, "agent");
            asm volatile("s_waitcnt vmcnt(0)" ::: "memory");
            const unsigned og = xb_add(&bar[XB_TOP], 1u);
            const unsigned tg = og / nx;
            if (og + 1u == (tg + 1u) * nx) xb_add(&bar[XB_TOPGEN], 1u);
            else XB_SPIN(xb_ld(&bar[XB_TOPGEN]) == tg, bar);
            __builtin_amdgcn_fence(__ATOMIC_ACQUIRE, "agent");
            xb_add(&bar[XB_XGEN(b.x)], 1u);
            asm volatile("s_waitcnt vmcnt(0)" ::: "memory");
        } else {
            XB_SPIN(xb_ld(&bar[XB_XGEN(b.x)]) == gen, bar);
            __builtin_amdgcn_fence(__ATOMIC_ACQUIRE, "agent");
            asm volatile("s_waitcnt vmcnt(0)" ::: "memory");
        }
    }
    __syncthreads();
}
struct Args { const float* in[24]; float* out; unsigned char* ws; int ph_lo, ph_hi; };
typedef const __attribute__((address_space(4))) unsigned char* kargp_t;
DI kargp_t kargs() { kargp_t p = (kargp_t)__builtin_amdgcn_kernarg_segment_ptr(); asm volatile("" : "+s"(p)); return p; }
DI const float* karg_in(kargp_t p, int i) { return *(const float* const __attribute__((address_space(4)))*)(p + 8 * i); }
DI float* karg_out(kargp_t p) { return *(float* const __attribute__((address_space(4)))*)(p + 192); }
DI unsigned char* karg_ws(kargp_t p) { return *(unsigned char* const __attribute__((address_space(4)))*)(p + 200); }
static_assert(sizeof(Args) == 216, "kernarg offsets");

DI void p0_transpose_item(const float* W, int K, int N, bf16* WT, int mode, int H, LAS float* scr, int item, int lane, int ldk = 0, float mult = 1.0f) {
    if (ldk == 0) ldk = K;
    const int nblk = N / 32, kb = item / nblk, nb = item % nblk, k0 = 64 * kb, n0 = 32 * nb;
    int dr0 = n0;
    if (mode == 1) { if (n0 < H) dr0 = (n0 >> 7) * 256 + (n0 & 127); else { const int n1 = n0 - H; dr0 = (n1 >> 7) * 256 + 128 + (n1 & 127); } }
#pragma unroll 8
    for (int i = 0; i < 32; ++i) { const int kk = 2 * i + (lane >> 5); scr[kk * 33 + (lane & 31)] = __builtin_nontemporal_load(W + (size_t)(k0 + kk) * N + n0 + (lane & 31)) * mult; }
    LDS_WAIT(); asm volatile("" ::: "memory");
    const int c = lane & 7;
#pragma unroll
    for (int j = 0; j < 4; ++j) { const int n = (lane >> 3) + 8 * j; const LAS float* s = scr + (8 * c) * 33 + n;
        u32x4 o; o.x = pk2(s[0 * 33], s[1 * 33]); o.y = pk2(s[2 * 33], s[3 * 33]); o.z = pk2(s[4 * 33], s[5 * 33]); o.w = pk2(s[6 * 33], s[7 * 33]);
        *(GAS u32x4*)(WT + (size_t)(dr0 + n) * ldk + k0 + 8 * c) = o; }
    LDS_WAIT(); asm volatile("" ::: "memory");
}
DI void p0_transpose_item8(const float* W, int K, int N, unsigned char* WT, int mode, int H, float mult, LAS float* scr, int item, int lane) {
    const int nblk = N / 32, kb = item / nblk, nb = item % nblk, k0 = 64 * kb, n0 = 32 * nb;
    int dr0 = n0;
    if (mode == 1) { if (n0 < H) dr0 = (n0 >> 7) * 256 + (n0 & 127); else { const int n1 = n0 - H; dr0 = (n1 >> 7) * 256 + 128 + (n1 & 127); } }
#pragma unroll 8
    for (int i = 0; i < 32; ++i) { const int kk = 2 * i + (lane >> 5); scr[kk * 33 + (lane & 31)] = __builtin_nontemporal_load(W + (size_t)(k0 + kk) * N + n0 + (lane & 31)) * mult; }
    LDS_WAIT(); asm volatile("" ::: "memory");
#pragma unroll
    for (int j = 0; j < 2; ++j) { const int idx = lane + 64 * j, n = idx >> 2, c = idx & 3; const LAS float* s = scr + (16 * c) * 33 + n;
        u32x4 o;
        o.x = pg8::pk4fp8((f32x4){s[0 * 33], s[1 * 33], s[2 * 33], s[3 * 33]}); o.y = pg8::pk4fp8((f32x4){s[4 * 33], s[5 * 33], s[6 * 33], s[7 * 33]});
        o.z = pg8::pk4fp8((f32x4){s[8 * 33], s[9 * 33], s[10 * 33], s[11 * 33]}); o.w = pg8::pk4fp8((f32x4){s[12 * 33], s[13 * 33], s[14 * 33], s[15 * 33]});
        *(GAS u32x4*)(WT + (size_t)(dr0 + n) * K + k0 + 16 * c) = o; }
    LDS_WAIT(); asm volatile("" ::: "memory");
}
constexpr int CI_WIN = 16 * 176, CI_SQ = 16 * 32, CI_RG = 64, CI_LAYER = CI_WIN + 3 * CI_SQ + 2 * CI_RG;
constexpr int CI_FIN = 16 * 192, CI_FOUT = 48 * 32, CI_DENSE = CI_FIN + CI_FOUT;
constexpr int CI_MIN = 16 * 96, CI_MOUT = 24 * 32, CI_EXP = CI_MIN + CI_MOUT, CI_MOE = 8 * CI_EXP;
constexpr int CI_TOTAL = 4 * CI_LAYER + 2 * CI_DENSE + 2 * CI_MOE;
DI void p0_convert_item(kargp_t kp, int it, LAS float* scr, int lane) {
    unsigned char* ws = karg_ws(kp);
    if (it < 4 * CI_LAYER) {
        const int l = it / CI_LAYER; int r = it % CI_LAYER; unsigned char* wl = ws + WS_WL + (size_t)l * WL_STRIDE;
        if (r < CI_WIN) { p0_transpose_item(karg_in(kp, 8) + (size_t)l * 1024 * D_IN, 1024, D_IN, (bf16*)(wl + WL_WIN), 0, 0, scr, r, lane); return; } r -= CI_WIN;
        if (r < 2 * CI_SQ) { const int br = r / CI_SQ; p0_transpose_item(karg_in(kp, 17) + (size_t)(l * 2 + br) * 1024 * 1024, 1024, 1024, (bf16*)(wl + WL_WB) + (size_t)br * 1024, 0, 0, scr, r % CI_SQ, lane, 2048); return; }   r -= 2 * CI_SQ;
        if (r < CI_SQ) { p0_transpose_item(karg_in(kp, 18) + (size_t)l * 1024 * 1024, 1024, 1024, (bf16*)(wl + WL_WO), 0, 0, scr, r, lane); return; } r -= CI_SQ;
        if (r < CI_RG) { const int nb = r >> 3; p0_transpose_item(karg_in(kp, 11) + (size_t)(l * 8 + nb) * 16384, 128, 128, (bf16*)(wl + WL_WRA) + nb * 16384, 0, 0, scr, r & 7, lane, 0, -LOG2E); return; }     r -= CI_RG;
        { const int nb = r >> 3; p0_transpose_item(karg_in(kp, 13) + (size_t)(l * 8 + nb) * 16384, 128, 128, (bf16*)(wl + WL_WRX) + nb * 16384, 0, 0, scr, r & 7, lane, 0, -LOG2E); return; }
    }
    it -= 4 * CI_LAYER;
    if (it < 2 * CI_DENSE) {
        const int j = it / CI_DENSE; int r = it % CI_DENSE; unsigned char* wd = ws + WS_WD + (size_t)j * WD_STRIDE;
        const bool f8 = (FP8_LAYERS >> (2 * j)) & 1u;
        if (r < CI_FIN) { if (f8) p0_transpose_item8(karg_in(kp, 19) + (size_t)j * 1024 * 6144, 1024, 6144, wd + WD_FIN, 1, 3072, 32.0f, scr, r, lane); else p0_transpose_item(karg_in(kp, 19) + (size_t)j * 1024 * 6144, 1024, 6144, (bf16*)(wd + WD_FIN), 1, 3072, scr, r, lane); return; } r -= CI_FIN;
        if (f8) p0_transpose_item8(karg_in(kp, 20) + (size_t)j * 3072 * 1024, 3072, 1024, wd + WD_FOUT, 0, 0, 64.0f, scr, r, lane); else p0_transpose_item(karg_in(kp, 20) + (size_t)j * 3072 * 1024, 3072, 1024, (bf16*)(wd + WD_FOUT), 0, 0, scr, r, lane); return;
    }
    it -= 2 * CI_DENSE;
    {
        const int j = it / CI_MOE; int r = it % CI_MOE; const int e = r / CI_EXP; r %= CI_EXP; unsigned char* wm = ws + WS_WM + (size_t)j * WM_STRIDE;
        const bool f8 = (FP8_LAYERS >> (2 * j + 1)) & 1u;
        if (r < CI_MIN) { if (f8) p0_transpose_item8(karg_in(kp, 22) + (size_t)(j * 8 + e) * 1024 * 3072, 1024, 3072, wm + WM_MIN + (size_t)e * 3072 * 1024, 1, 1536, 32.0f, scr, r, lane); else p0_transpose_item(karg_in(kp, 22) + (size_t)(j * 8 + e) * 1024 * 3072, 1024, 3072, (bf16*)(wm + WM_MIN) + (size_t)e * 3072 * 1024, 1, 1536, scr, r, lane); return; } r -= CI_MIN;
        if (f8) p0_transpose_item8(karg_in(kp, 23) + (size_t)(j * 8 + e) * 1536 * 1024, 1536, 1024, wm + WM_MOUT + (size_t)e * 1024 * 1536, 0, 0, 32.0f, scr, r, lane); else p0_transpose_item(karg_in(kp, 23) + (size_t)(j * 8 + e) * 1536 * 1024, 1536, 1024, (bf16*)(wm + WM_MOUT) + (size_t)e * 1024 * 1536, 0, 0, scr, r, lane);
    }
}
DI void p0_prologue(LAS unsigned char* lds, int tid, int wave, int lane) {
    const kargp_t kp = kargs();
    LAS float* cact = (LAS float*)lds; LAS float* red = (LAS float*)(lds + 8192);
    float* ADA = (float*)(karg_ws(kp) + WS_ADA);
    for (int i = tid; i < 2 * D; i += NWAVES * 64) { const float c = karg_in(kp, 1)[i]; cact[i] = c / (1.0f + expf(-c)); }
    __syncthreads();
    const int col = tid & 31, ks = tid >> 5;
    for (int it = blockIdx.x; it < 4 * 192; it += gridDim.x) {
        const int l = it / 192, n0 = (it % 192) * 32;
        const float* w = karg_in(kp, 2) + (size_t)l * 1024 * 6144 + (size_t)(ks * 64) * 6144 + n0 + col;
        float s0 = 0.f, s1 = 0.f;
#pragma unroll 32
        for (int k = 0; k < 64; ++k) { const float wv = __builtin_nontemporal_load(w + (size_t)k * 6144); s0 += cact[ks * 64 + k] * wv; s1 += cact[1024 + ks * 64 + k] * wv; }
        red[(ks * 2 + 0) * 32 + col] = s0; red[(ks * 2 + 1) * 32 + col] = s1;
        __syncthreads();
        if (tid < 64) { const int b = tid >> 5, c2 = tid & 31; float s = karg_in(kp, 3)[l * 6144 + n0 + c2];
#pragma unroll
            for (int k2 = 0; k2 < 16; ++k2) s += red[(k2 * 2 + b) * 32 + c2];
            ADA[(l * 2 + b) * 6144 + n0 + c2] = s; }
        __syncthreads();
    }
    __syncthreads();
    LAS float* scr = (LAS float*)(lds + wave * 16384);
    const int gw = blockIdx.x * NWAVES + wave, NGW = gridDim.x * NWAVES;
    for (int it = gw; it < CI_TOTAL; it += NGW) p0_convert_item(kp, it, scr, lane);
}

DI int vcu_index() { const int G = (int)gridDim.x, bx = (int)blockIdx.x; return (G % 8 == 0) ? (bx % 8) * (G / 8) + bx / 8 : bx; }
DI float row_ss(const f32x4 (&v)[4]) { float s = 0.f;
#pragma unroll
    for (int j = 0; j < 4; ++j) s += (v[j].x * v[j].x + v[j].y * v[j].y) + (v[j].z * v[j].z + v[j].w * v[j].w);
    return wave_sum(s); }
DI void ld_row(const float* p, int lane, f32x4 (&v)[4]) {
#pragma unroll
    for (int j = 0; j < 4; ++j) v[j] = *(const f32x4*)(p + 256 * j + 4 * lane); }
DI void st_row(float* p, int lane, const f32x4 (&v)[4]) {
#pragma unroll
    for (int j = 0; j < 4; ++j) *(f32x4*)(p + 256 * j + 4 * lane) = v[j]; }
DI void st_row_f8(unsigned char* p, int lane, const f32x4 (&v)[4]) {
#pragma unroll
    for (int j = 0; j < 4; ++j) *(unsigned*)(p + 256 * j + 4 * lane) = pg8::pk4fp8(v[j]); }
DI void st_row_bf(bf16* p, int lane, const f32x4 (&v)[4]) {
#pragma unroll
    for (int j = 0; j < 4; ++j) { u32x2 w; w.x = pk2(v[j].x, v[j].y); w.y = pk2(v[j].z, v[j].w); *(u32x2*)(p + 256 * j + 4 * lane) = w; } }
DI void ld_row_bfraw(const bf16* p, int lane, u32x2 (&w)[4]) {
#pragma unroll
    for (int j = 0; j < 4; ++j) w[j] = *(const u32x2*)(p + 256 * j + 4 * lane); }
DI void cvt_row_bf(const u32x2 (&w)[4], f32x4 (&v)[4]) {
#pragma unroll
    for (int j = 0; j < 4; ++j) v[j] = (f32x4){bflo(w[j].x), bfhi(w[j].x), bflo(w[j].y), bfhi(w[j].y)}; }
DI void ld_row_bf(const bf16* p, int lane, f32x4 (&v)[4]) {
#pragma unroll
    for (int j = 0; j < 4; ++j) { const u32x2 w = *(const u32x2*)(p + 256 * j + 4 * lane); v[j] = (f32x4){bflo(w.x), bfhi(w.x), bflo(w.y), bfhi(w.y)}; } }

DI void thin_start(int wave, int lane) {
    const kargp_t kp = kargs(); unsigned char* ws = karg_ws(kp);
    const float* ADA = (const float*)(ws + WS_ADA); bf16* XN = (bf16*)(ws + WS_XN);
    const int NGW = gridDim.x * NWAVES, gw = vcu_index() * NWAVES + wave;
    for (int base = gw * 8; base < M; base += NGW * 8) {
        const int b = base >> 13; const float* ada = ADA + (size_t)b * 6144;
        f32x4 g[4], sc[4], sh[4]; ld_row(karg_in(kp, 4), lane, g); ld_row(ada + 1024, lane, sc); ld_row(ada, lane, sh);
#pragma unroll
        for (int j = 0; j < 4; ++j) sc[j] = g[j] * (sc[j] + 1.0f);
        const float* xin = karg_in(kp, 0);
        f32x4 xn[4]; ld_row(xin + (size_t)base * D, lane, xn);
#pragma unroll
        for (int i = 0; i < 8; ++i) { const size_t m = (size_t)(base + i);
            f32x4 x[4];
#pragma unroll
            for (int j = 0; j < 4; ++j) x[j] = xn[j];
            if (i < 7) ld_row(xin + (m + 1) * D, lane, xn);
            const float rs = rsqrtf(row_ss(x) * (1.0f / D) + EPS);
#pragma unroll
            for (int j = 0; j < 4; ++j) x[j] = x[j] * rs * sc[j] + sh[j];
            st_row_bf(XN + m * D, lane, x); }
    }
}
DI void thin_mid_dense(int l, int wave, int lane) {
    const kargp_t kp = kargs(); unsigned char* ws = karg_ws(kp); bf16* XB = (bf16*)(ws + WS_XB);
    const float* ADA = (const float*)(ws + WS_ADA); bf16* XN = (bf16*)(ws + WS_XN); const bf16* MIX = (const bf16*)(ws + WS_MIX);
    const float* xin = karg_in(kp, 0); const bool l0 = (l == 0);
    const int NGW = gridDim.x * NWAVES, gw = vcu_index() * NWAVES + wave;
    for (int base = gw * 8; base < M; base += NGW * 8) {
        const int b = base >> 13; const float* ada = ADA + (size_t)(l * 2 + b) * 6144;
        f32x4 pg[4], fg[4], fs[4], t[4];
        ld_row(karg_in(kp, 5) + l * D, lane, pg); ld_row(ada + 2048, lane, t);
#pragma unroll
        for (int j = 0; j < 4; ++j) pg[j] = pg[j] * t[j];
        ld_row(karg_in(kp, 6) + l * D, lane, fg); ld_row(ada + 4096, lane, t); ld_row(ada + 3072, lane, fs);
#pragma unroll
        for (int j = 0; j < 4; ++j) fg[j] = fg[j] * (t[j] + 1.0f);
        u32x2 yn[4], xr[4]; f32x4 xn[4]; ld_row_bfraw(MIX + (size_t)base * D, lane, yn); if (l0) ld_row(xin + (size_t)base * D, lane, xn); else ld_row_bfraw(XB + (size_t)base * D, lane, xr);
#pragma unroll
        for (int i = 0; i < 8; ++i) { const size_t m = (size_t)(base + i);
            f32x4 y[4], x[4]; cvt_row_bf(yn, y);
            if (l0) {
#pragma unroll
                for (int j = 0; j < 4; ++j) x[j] = xn[j];
            } else cvt_row_bf(xr, x);
            if (i < 7) { ld_row_bfraw(MIX + (m + 1) * D, lane, yn); if (l0) ld_row(xin + (m + 1) * D, lane, xn); else ld_row_bfraw(XB + (m + 1) * D, lane, xr); }
            const float rs = rsqrtf(row_ss(y) * (1.0f / D) + EPS);
#pragma unroll
            for (int j = 0; j < 4; ++j) x[j] = x[j] + pg[j] * (y[j] * rs);
            st_row_bf(XB + m * D, lane, x);
            const float rs2 = rsqrtf(row_ss(x) * (1.0f / D) + EPS);
#pragma unroll
            for (int j = 0; j < 4; ++j) x[j] = x[j] * rs2 * fg[j] + fs[j];
            if ((FP8_LAYERS >> l) & 1u) st_row_f8((unsigned char*)XN + m * D, lane, x); else st_row_bf(XN + m * D, lane, x); }
    }
}
DI void thin_mid_moe(LAS unsigned char* lds, int l, int tid, int wave, int lane) {
    const kargp_t kp = kargs(); unsigned char* ws = karg_ws(kp); bf16* XB = (bf16*)(ws + WS_XB);
    const float* ADA = (const float*)(ws + WS_ADA); const bf16* MIX = (const bf16*)(ws + WS_MIX);
    unsigned char* AP = ws + WS_AP; int* TOK = (int*)(ws + WS_TOK);
    unsigned* cntg = (unsigned*)(ws + WS_CTL) + CW_CNT + 64 * (l >> 1);
    const float* wr = karg_in(kp, 21) + (size_t)(l >> 1) * D * NE;
    LAS float* RT = (LAS float*)lds;
    LAS unsigned* cntL = (LAS unsigned*)(lds + 32768);
    for (int i = tid; i < D * NE; i += NWAVES * 64) RT[i] = wr[i];
    for (int rb = vcu_index(); rb < M / 64; rb += gridDim.x) {
        if (tid < 16) cntL[tid] = 0u;
        __syncthreads();
        const int base = rb * 64 + wave * 8; const int b = base >> 13; const float* ada = ADA + (size_t)(l * 2 + b) * 6144;
        f32x4 pg[4], fg[4], fs[4], t[4];
        ld_row(karg_in(kp, 5) + l * D, lane, pg); ld_row(ada + 2048, lane, t);
#pragma unroll
        for (int j = 0; j < 4; ++j) pg[j] = pg[j] * t[j];
        ld_row(karg_in(kp, 6) + l * D, lane, fg); ld_row(ada + 4096, lane, t); ld_row(ada + 3072, lane, fs);
#pragma unroll
        for (int j = 0; j < 4; ++j) fg[j] = fg[j] * (t[j] + 1.0f);
        int e0s[8], e1s[8], lp0[8], lp1[8]; float w0s[8], rs2s[8];
        u32x2 yn[4], xr[4]; ld_row_bfraw(MIX + (size_t)base * D, lane, yn); ld_row_bfraw(XB + (size_t)base * D, lane, xr);
#pragma unroll
        for (int i = 0; i < 8; ++i) { const size_t m = (size_t)(base + i);
            f32x4 y[4], x[4]; cvt_row_bf(yn, y);
            cvt_row_bf(xr, x);
            if (i < 7) { ld_row_bfraw(MIX + (m + 1) * D, lane, yn); ld_row_bfraw(XB + (m + 1) * D, lane, xr); }
            const float rs = rsqrtf(row_ss(y) * (1.0f / D) + EPS);
#pragma unroll
            for (int j = 0; j < 4; ++j) x[j] = x[j] + pg[j] * (y[j] * rs);
            st_row_bf(XB + m * D, lane, x);
            const float rs2 = rsqrtf(row_ss(x) * (1.0f / D) + EPS);
            float lg[8];
#pragma unroll
            for (int e = 0; e < 8; ++e) lg[e] = 0.f;
#pragma unroll
            for (int j = 0; j < 4; ++j) { x[j] = x[j] * rs2 * fg[j] + fs[j];
#pragma unroll
                for (int q = 0; q < 4; ++q) { const LAS f32x4* tr = (const LAS f32x4*)(RT + (256 * j + 4 * lane + q) * 8); const f32x4 t0 = tr[0], t1 = tr[1]; const float hv = x[j][q];
                    lg[0] += hv * t0.x; lg[1] += hv * t0.y; lg[2] += hv * t0.z; lg[3] += hv * t0.w; lg[4] += hv * t1.x; lg[5] += hv * t1.y; lg[6] += hv * t1.z; lg[7] += hv * t1.w; } }
#pragma unroll
            for (int e = 0; e < 8; ++e) lg[e] = wave_sum(lg[e]);
            int e0 = 0; float v0 = lg[0];
#pragma unroll
            for (int e = 1; e < 8; ++e) if (lg[e] > v0) { v0 = lg[e]; e0 = e; }
            int e1 = (e0 == 0) ? 1 : 0; float v1 = -INFINITY;
#pragma unroll
            for (int e = 0; e < 8; ++e) if (e != e0 && lg[e] > v1) { v1 = lg[e]; e1 = e; }
            e0 = __builtin_amdgcn_readfirstlane(e0); e1 = __builtin_amdgcn_readfirstlane(e1);
            const float w0 = 1.0f / (1.0f + expf(v1 - v0));
            unsigned q0 = 0u, q1 = 0u;
            if (lane == 0) { q0 = __hip_atomic_fetch_add(cntL + e0, 1u, __ATOMIC_RELAXED, __HIP_MEMORY_SCOPE_WORKGROUP); q1 = __hip_atomic_fetch_add(cntL + e1, 1u, __ATOMIC_RELAXED, __HIP_MEMORY_SCOPE_WORKGROUP); }
            e0s[i] = e0; e1s[i] = e1; lp0[i] = __builtin_amdgcn_readfirstlane((int)q0); lp1[i] = __builtin_amdgcn_readfirstlane((int)q1); w0s[i] = w0; rs2s[i] = rs2;
        }
        __syncthreads();
        if (tid < 8) cntL[8 + tid] = __hip_atomic_fetch_add(cntg + tid, cntL[tid], RLX_AGENT);
        __syncthreads();
#pragma unroll
        for (int i = 0; i < 8; ++i) { const size_t m = (size_t)(base + i);
            const int p0 = (int)cntL[8 + e0s[i]] + lp0[i], p1 = (int)cntL[8 + e1s[i]] + lp1[i];
            const int esz = ((FP8_LAYERS >> l) & 1u) ? 1 : 2; unsigned char* r0 = AP + ((size_t)e0s[i] * ECAP + p0) * D * esz; unsigned char* r1 = AP + ((size_t)e1s[i] * ECAP + p1) * D * esz;
            f32x4 x[4]; ld_row_bf(XB + m * D, lane, x);
#pragma unroll
            for (int j = 0; j < 4; ++j) { x[j] = x[j] * rs2s[i] * fg[j] + fs[j];
                if (esz == 1) { const unsigned hpk = pg8::pk4fp8(x[j]); *(unsigned*)(r0 + 256 * j + 4 * lane) = hpk; *(unsigned*)(r1 + 256 * j + 4 * lane) = hpk; }
                else { u32x2 hpk; hpk.x = pk2(x[j].x, x[j].y); hpk.y = pk2(x[j].z, x[j].w); *(u32x2*)(r0 + 512 * j + 8 * lane) = hpk; *(u32x2*)(r1 + 512 * j + 8 * lane) = hpk; } }
            if (lane == 0) { int4 ti; ti.x = e0s[i] | (e1s[i] << 8); ti.y = p0; ti.z = p1; ti.w = __float_as_int(w0s[i]); *(int4*)(TOK + 4 * m) = ti; }
        }
        __syncthreads();
    }
}
DI void thin_end(int l, int wave, int lane) {
    const kargp_t kp = kargs(); unsigned char* ws = karg_ws(kp); float* outp = karg_out(kp); bf16* XB = (bf16*)(ws + WS_XB);
    const float* ADA = (const float*)(ws + WS_ADA); bf16* XN = (bf16*)(ws + WS_XN); const bf16* MIX = (const bf16*)(ws + WS_MIX);
    const bf16* YP = (const bf16*)(ws + WS_YP); const int* TOK = (const int*)(ws + WS_TOK);
    const bool moe = (l & 1) != 0; const bool last = (l == DEPTH - 1);
    int pp[8];
    { const unsigned* cntg = (const unsigned*)(ws + WS_CTL) + CW_CNT + 64 * (l >> 1); int acc = 0;
#pragma unroll
      for (int e = 0; e < 8; ++e) { pp[e] = acc; const unsigned n = moe ? (unsigned)__builtin_amdgcn_readfirstlane((int)__hip_atomic_load(cntg + e, RLX_AGENT)) : 0u; acc += (int)((n + 255u) >> 8); } }
    const int NGW = gridDim.x * NWAVES, gw = vcu_index() * NWAVES + wave;
    for (int base = gw * 8; base < M; base += NGW * 8) {
        const int b = base >> 13; const float* ada = ADA + (size_t)(l * 2 + b) * 6144; const float* adan = ADA + (size_t)((last ? l : l + 1) * 2 + b) * 6144;
        f32x4 pg[4], ng[4], ns[4], t[4];
        ld_row(karg_in(kp, 7) + l * D, lane, pg); ld_row(ada + 5120, lane, t);
#pragma unroll
        for (int j = 0; j < 4; ++j) pg[j] = pg[j] * t[j];
        ld_row(karg_in(kp, 4) + (last ? l : l + 1) * D, lane, ng); ld_row(adan + 1024, lane, t); ld_row(adan, lane, ns);
#pragma unroll
        for (int j = 0; j < 4; ++j) ng[j] = ng[j] * (t[j] + 1.0f);
        u32x2 yn[4], zn[4], xr[4]; float w0n = 1.0f;
#define TE_LOAD(mm) do { if (moe) { const int4 ti = *(const int4*)(TOK + 4 * (mm)); const int e0 = ti.x & 255, e1 = (ti.x >> 8) & 255; int b0 = 0, b1 = 0; \
                _Pragma("unroll") for (int e = 1; e < 8; ++e) { if (e0 == e) b0 = pp[e]; if (e1 == e) b1 = pp[e]; } \
                w0n = __int_as_float(ti.w); ld_row_bfraw(YP + ((size_t)b0 * 256 + ti.y) * D, lane, yn); ld_row_bfraw(YP + ((size_t)b1 * 256 + ti.z) * D, lane, zn); } \
            else ld_row_bfraw(MIX + (mm) * D, lane, yn); \
            ld_row_bfraw(XB + (mm) * D, lane, xr); } while (0)
        TE_LOAD((size_t)base);
#pragma unroll
        for (int i = 0; i < 8; ++i) { const size_t m = (size_t)(base + i);
            f32x4 y[4], x[4]; cvt_row_bf(yn, y);
            if (moe) { f32x4 y1[4]; cvt_row_bf(zn, y1); const float w0 = w0n, w1 = 1.0f - w0n;
#pragma unroll
                for (int j = 0; j < 4; ++j) y[j] = y[j] * w0 + y1[j] * w1; }
            cvt_row_bf(xr, x);
            if (i < 7) TE_LOAD(m + 1);
            const float rs = rsqrtf(row_ss(y) * (1.0f / D) + EPS);
#pragma unroll
            for (int j = 0; j < 4; ++j) x[j] = x[j] + pg[j] * (y[j] * rs);
            if (last) st_row(outp + m * D, lane, x); else st_row_bf(XB + m * D, lane, x);
            if (!last) { const float rs2 = rsqrtf(row_ss(x) * (1.0f / D) + EPS);
#pragma unroll
                for (int j = 0; j < 4; ++j) x[j] = x[j] * rs2 * ng[j] + ns[j];
                st_row_bf(XN + m * D, lane, x); }
        }
#undef TE_LOAD
    }
}
constexpr int L_WA = 0, L_WX = 34816, L_XC = 69632, L_PAR = 104448, L_AGG = 108544, L_HST = 116736, L_HINT = 108544;
template <int N> DI float dpp_shr(float oldv, float x) { return __builtin_bit_cast(float, __builtin_amdgcn_update_dpp(__builtin_bit_cast(int, oldv), __builtin_bit_cast(int, x), 0x110 + N, 0xf, 0xf, false)); }
#define RNN_SCAN_STEP(S) \
    "v_fmac_f32_dpp %4, %4, %0 row_shr:" #S " row_mask:0xf bank_mask:0xf\n\t" "v_fmac_f32_dpp %5, %5, %1 row_shr:" #S " row_mask:0xf bank_mask:0xf\n\t" \
    "v_fmac_f32_dpp %6, %6, %2 row_shr:" #S " row_mask:0xf bank_mask:0xf\n\t" "v_fmac_f32_dpp %7, %7, %3 row_shr:" #S " row_mask:0xf bank_mask:0xf\n\t" \
    "v_mul_f32_dpp %0, %0, %0 row_shr:" #S " row_mask:0xf bank_mask:0xf\n\t" "v_mul_f32_dpp %1, %1, %1 row_shr:" #S " row_mask:0xf bank_mask:0xf\n\t" \
    "v_mul_f32_dpp %2, %2, %2 row_shr:" #S " row_mask:0xf bank_mask:0xf\n\t" "v_mul_f32_dpp %3, %3, %3 row_shr:" #S " row_mask:0xf bank_mask:0xf\n\t"
DI void scan16(f32x4& a, f32x4& u) {
    float a0 = a[0], a1 = a[1], a2 = a[2], a3 = a[3], u0 = u[0], u1 = u[1], u2 = u[2], u3 = u[3];
    asm volatile("s_nop 1\n\t" RNN_SCAN_STEP(1) RNN_SCAN_STEP(2) RNN_SCAN_STEP(4) RNN_SCAN_STEP(8) "s_nop 0"
                 : "+v"(a0), "+v"(a1), "+v"(a2), "+v"(a3), "+v"(u0), "+v"(u1), "+v"(u2), "+v"(u3));
    a = (f32x4){a0, a1, a2, a3}; u = (f32x4){u0, u1, u2, u3};
}
template <int N> DI void scan_step(f32x4& a, f32x4& u) {
#pragma unroll
    for (int q = 0; q < 4; ++q) { const float ap = dpp_shr<N>(1.0f, a[q]), up = dpp_shr<N>(0.0f, u[q]); u[q] = a[q] * up + u[q]; a[q] = a[q] * ap; }
}
DI f32x4 mfma16(bf16x8 a, bf16x8 b, f32x4 c) { return __builtin_amdgcn_mfma_f32_16x16x32_bf16(a, b, c, 0, 0, 0); }
DI f32x4 bf4lo(u32x4 v) { return (f32x4){bflo(v.x), bfhi(v.x), bflo(v.y), bfhi(v.y)}; }
DI f32x4 bf4hi(u32x4 v) { return (f32x4){bflo(v.z), bfhi(v.z), bflo(v.w), bfhi(v.w)}; }
DI void rnn_pass1(LAS unsigned char* lds, int l, int tid, int wave, int lane, int it_first, int it_count, int it_stride) {
    const int fr = lane & 15, fq = lane >> 4;
    LAS float* PAR = (LAS float*)(lds + L_PAR); LAS float* AGG = (LAS float*)(lds + L_AGG); LAS float* HST = (LAS float*)(lds + L_HST);
    const int cc = tid & 15, tg4 = (tid >> 4) * 4;
    for (int itk = 0; itk < it_count; ++itk) { const int it = it_first + itk * it_stride;
        const int nb = it & 7, seg = it >> 3, sidx = seg & 15; const int m0 = seg * 512;
        const kargp_t kp = kargs(); unsigned char* ws = karg_ws(kp);
        const bf16* XRp = (const bf16*)(ws + WS_XR);
        __syncthreads();
        u32x4 pre[7];
        f32x4 cw0[4], cw1[4], cb0, cb1;
#define RNN_PREFETCH(stn) do { _Pragma("unroll") for (int j = 0; j < 7; ++j) { const int rl = 128 * (stn) + tg4 - 3 + j; pre[j] = (u32x4){0u, 0u, 0u, 0u}; \
                if (!(sidx == 0 && rl < 0)) pre[j] = *(const u32x4*)(XRp + (size_t)(m0 + rl) * 1024 + nb * 128 + cc * 8); } } while (0)
        RNN_PREFETCH(0);
        { const bf16* WA = (const bf16*)(ws + WS_WL + (size_t)l * WL_STRIDE + WL_WRA) + nb * 16384; const bf16* WX = (const bf16*)(ws + WS_WL + (size_t)l * WL_STRIDE + WL_WRX) + nb * 16384;
          u32x4 wreg[8];
#pragma unroll
          for (int i = 0; i < 4; ++i) { const int q = tid + 512 * i; wreg[i] = *(const u32x4*)(WA + (q >> 4) * 128 + (q & 15) * 8); wreg[4 + i] = *(const u32x4*)(WX + (q >> 4) * 128 + (q & 15) * 8); }
          { const float* cwp = karg_in(kp, 9) + (size_t)l * 4096 + nb * 128 + cc * 8; const float* cbp = karg_in(kp, 10) + l * 1024 + nb * 128 + cc * 8;
#pragma unroll
              for (int k = 0; k < 4; ++k) { cw0[k] = *(const f32x4*)(cwp + k * 1024); cw1[k] = *(const f32x4*)(cwp + k * 1024 + 4); }
              cb0 = *(const f32x4*)cbp; cb1 = *(const f32x4*)(cbp + 4); }
          if (tid < 128) { const int ch = l * 1024 + nb * 128 + tid;
            PAR[0 * 128 + tid] = -LOG2E * karg_in(kp, 12)[ch]; PAR[1 * 128 + tid] = -LOG2E * karg_in(kp, 14)[ch]; PAR[2 * 128 + tid] = 8.0f * log1pf(expf(-karg_in(kp, 15)[ch])) * LOG2E;
            *(LAS f32x2*)(HST + 2 * tid) = (f32x2){1.0f, 0.0f}; }
#pragma unroll
          for (int i = 0; i < 4; ++i) { const int q = tid + 512 * i; *(LAS u32x4*)(lds + L_WA + (q >> 4) * 272 + (q & 15) * 16) = wreg[i]; *(LAS u32x4*)(lds + L_WX + (q >> 4) * 272 + (q & 15) * 16) = wreg[4 + i]; } }
        for (int st = 0; st < 4; ++st) {
#pragma unroll
            for (int i = 0; i < 4; ++i) { f32x4 o0 = cb0, o1 = cb1;
#pragma unroll
                for (int k = 0; k < 4; ++k) { o0 += cw0[k] * bf4lo(pre[i + k]); o1 += cw1[k] * bf4hi(pre[i + k]); }
                u32x4 pk; pk.x = pk2(o0[0], o0[1]); pk.y = pk2(o0[2], o0[3]); pk.z = pk2(o1[0], o1[1]); pk.w = pk2(o1[2], o1[3]);
                *(LAS u32x4*)(lds + L_XC + (tg4 + i) * 272 + cc * 16) = pk; }
            __syncthreads();
            if (st < 3) RNN_PREFETCH(st + 1);
            const int tl = 16 * wave + fr;
            bf16x8 xb[4];
#pragma unroll
            for (int s = 0; s < 4; ++s) xb[s] = *(const LAS bf16x8*)(lds + L_XC + tl * 272 + (32 * s + 8 * fq) * 2);
            unsigned* PSw = (unsigned*)(ws + WS_PS); float* T16w = (float*)(ws + WS_T16);
#define RNN_GATES(nn, CA, CX) do { CA = *(const LAS f32x4*)(PAR + 16 * (nn) + 4 * fq); CX = *(const LAS f32x4*)(PAR + 128 + 16 * (nn) + 4 * fq);     \
                _Pragma("unroll") for (int s = 0; s < 4; ++s) { const bf16x8 af = *(const LAS bf16x8*)(lds + L_WA + (16 * (nn) + fr) * 272 + (32 * s + 8 * fq) * 2), xf = *(const LAS bf16x8*)(lds + L_WX + (16 * (nn) + fr) * 272 + (32 * s + 8 * fq) * 2); \
                    CA = mfma16(af, xb[s], CA); CX = mfma16(xf, xb[s], CX); } } while (0)
            f32x4 ca, cx, can, cxn; RNN_GATES(0, ca, cx);
#pragma unroll
            for (int n = 0; n < 8; ++n) { const int ch0 = 16 * n + 4 * fq;
                if (n < 7) RNN_GATES(n + 1, can, cxn);
                const u32x2 xv = *(const LAS u32x2*)(lds + L_XC + tl * 272 + ch0 * 2); const f32x4 xc = (f32x4){bflo(xv.x), bfhi(xv.x), bflo(xv.y), bfhi(xv.y)};
                const f32x4 sp = *(const LAS f32x4*)(PAR + 256 + ch0);
                f32x4 av, uv;
#pragma unroll
                for (int q = 0; q < 4; ++q) { const float r = frcp(1.0f + fexp2(ca[q])), ig = frcp(1.0f + fexp2(cx[q]));
                    const float aa = fexp2(-r * sp[q]); av[q] = aa; uv[q] = __builtin_amdgcn_sqrtf(1.0f - aa * aa) * ig * xc[q]; }
                scan16(av, uv);
                { u32x4 ps; ps.x = pk2(av[0], uv[0]); ps.y = pk2(av[1], uv[1]); ps.z = pk2(av[2], uv[2]); ps.w = pk2(av[3], uv[3]);
                  *(u32x4*)(PSw + (size_t)(m0 + 128 * st + tl) * 1024 + nb * 128 + ch0) = ps; }
                if (fr == 15) { const f32x4 g0 = (f32x4){av[0], uv[0], av[1], uv[1]}, g1 = (f32x4){av[2], uv[2], av[3], uv[3]};
                    *(LAS f32x4*)(AGG + (wave * 128 + ch0) * 2) = g0; *(LAS f32x4*)(AGG + (wave * 128 + ch0) * 2 + 4) = g1;
                    float* o = T16w + ((size_t)(seg * 32 + st * 8 + wave) * 1024 + nb * 128 + ch0) * 2; *(f32x4*)o = g0; *(f32x4*)(o + 4) = g1; }
                ca = can; cx = cxn;
            }
#undef RNN_GATES
            __syncthreads();
            LAS float* HS0 = HST + 256 * (st & 1); LAS float* HS1 = HST + 256 * ((st + 1) & 1);
            if (fr == 0) { const int ch0 = 16 * wave + 4 * fq;
                const f32x4 h0 = *(const LAS f32x4*)(HS0 + 2 * ch0), h1 = *(const LAS f32x4*)(HS0 + 2 * ch0 + 4);
                f32x4 A = (f32x4){h0[0], h0[2], h1[0], h1[2]}, U = (f32x4){h0[1], h0[3], h1[1], h1[3]};
#pragma unroll
                for (int w2 = 0; w2 < 8; ++w2) { const f32x4 g0 = *(const LAS f32x4*)(AGG + (w2 * 128 + ch0) * 2), g1 = *(const LAS f32x4*)(AGG + (w2 * 128 + ch0) * 2 + 4);
                    const f32x4 a2 = (f32x4){g0[0], g0[2], g1[0], g1[2]}, u2 = (f32x4){g0[1], g0[3], g1[1], g1[3]}; U = a2 * U + u2; A = A * a2; }
                const f32x4 o0 = (f32x4){A[0], U[0], A[1], U[1]}, o1 = (f32x4){A[2], U[2], A[3], U[3]};
                *(LAS f32x4*)(HS1 + 2 * ch0) = o0; *(LAS f32x4*)(HS1 + 2 * ch0 + 4) = o1;
                if (st == 3) { float* o = (float*)(ws + WS_RAGG) + ((size_t)seg * 1024 + nb * 128 + ch0) * 2; *(f32x4*)o = o0; *(f32x4*)(o + 4) = o1; } }
        }
#undef RNN_PREFETCH
    }
}
DI void rnn_pass2(LAS unsigned char* lds, int tid) {
    LAS float* HINT = (LAS float*)lds;
    for (int it = vcu_index(); it < 256; it += gridDim.x) {
        const int nb = it & 7, seg = it >> 3, sidx = seg & 15; const int m0 = seg * 512;
        unsigned char* ws = karg_ws(kargs());
        __syncthreads();
        if (tid < 128) { const float* RAGG = (const float*)(ws + WS_RAGG) + ((size_t)(seg - sidx) * 1024 + nb * 128 + tid) * 2; const float* T16 = (const float*)(ws + WS_T16) + ((size_t)(seg * 32) * 1024 + nb * 128 + tid) * 2;
            f32x2 sa[15], ta[32];
#pragma unroll
            for (int s2 = 0; s2 < 15; ++s2) sa[s2] = *(const f32x2*)(RAGG + (size_t)s2 * 2048);
#pragma unroll
            for (int t2 = 0; t2 < 32; ++t2) ta[t2] = *(const f32x2*)(T16 + (size_t)t2 * 2048);
            float h = 0.f;
#pragma unroll
            for (int s2 = 0; s2 < 15; ++s2) h = (s2 < sidx) ? sa[s2].x * h + sa[s2].y : h;
#pragma unroll
            for (int t2 = 0; t2 < 32; ++t2) { HINT[t2 * 128 + tid] = h; h = ta[t2].x * h + ta[t2].y; } }
        __syncthreads();
        const unsigned* PS = (const unsigned*)(ws + WS_PS); const bf16* GGp = (const bf16*)(ws + WS_GG); bf16* ROp = (bf16*)(ws + WS_RO);
        const int c4 = (tid & 31) * 4, r0 = tid >> 5;
#pragma unroll 4
        for (int i = 0; i < 32; ++i) { const int row = r0 + 16 * i; const size_t off = (size_t)(m0 + row) * 1024 + nb * 128 + c4, offo = (size_t)(m0 + row) * 2048 + nb * 128 + c4;
            const u32x4 ps = *(const u32x4*)(PS + off); const u32x2 gv = *(const u32x2*)(GGp + off); const f32x4 hin = *(const LAS f32x4*)(HINT + (row >> 4) * 128 + c4);
            const float h0 = bflo(ps.x) * hin[0] + bfhi(ps.x), h1 = bflo(ps.y) * hin[1] + bfhi(ps.y), h2 = bflo(ps.z) * hin[2] + bfhi(ps.z), h3 = bflo(ps.w) * hin[3] + bfhi(ps.w);
            u32x2 o; o.x = pk2(h0 * bflo(gv.x), h1 * bfhi(gv.x)); o.y = pk2(h2 * bflo(gv.y), h3 * bfhi(gv.y)); *(u32x2*)(ROp + offo) = o; }
    }
}

constexpr int L_K = 0, L_V = 69632;
DI f32x16 mfma32(bf16x8 a, bf16x8 b, f32x16 c) { return __builtin_amdgcn_mfma_f32_32x32x16_bf16(a, b, c, 0, 0, 0); }
DI void attn_phase(LAS unsigned char* lds, int l, int tid, int wave, int lane, int it_first, int it_count, int it_stride) {
    const int r = lane & 31, h = lane >> 5;
    const kargp_t kp = kargs(); unsigned char* ws = karg_ws(kp);
    const bf16* Q = (const bf16*)(ws + WS_Q); const bf16* KB = (const bf16*)(ws + WS_KB); const bf16* VB = (const bf16*)(ws + WS_VB); bf16* AO = (bf16*)(ws + WS_RO) + 1024;   const float* sinks = karg_in(kp, 16) + l * 8;
    for (int itk = 0; itk < it_count; ++itk) { const int it = it_first + itk * it_stride;
        const int b = it >> 7, qblk = (it >> 1) & 63, kvh = it & 1; const int rowbase = b * SEQ + qblk * 128;
        __syncthreads();
        { u32x4 kreg[8], vreg[8];
#pragma unroll
          for (int i = 0; i < 8; ++i) { const int idx = tid + 512 * i, j = idx >> 4, c = idx & 15; const int jr = (qblk > 0 || j >= 128) ? j : 128;
            kreg[i] = *(const u32x4*)(KB + (size_t)(rowbase - 128 + jr) * 256 + kvh * 128 + c * 8); vreg[i] = *(const u32x4*)(VB + (size_t)(rowbase - 128 + jr) * 256 + kvh * 128 + c * 8); }
#pragma unroll
          for (int i = 0; i < 8; ++i) { const int idx = tid + 512 * i, j = idx >> 4, c = idx & 15; const bool ok = (qblk > 0 || j >= 128); const u32x4 z = (u32x4){0u, 0u, 0u, 0u};
            *(LAS u32x4*)(lds + L_K + j * 272 + c * 16) = ok ? kreg[i] : z; *(LAS u32x4*)(lds + L_V + j * 272 + c * 16) = ok ? vreg[i] : z; } }
        const int g = wave >> 1, head = kvh * 4 + g;
        bf16x8 qf[8], qn[8];
#pragma unroll
        for (int ks = 0; ks < 8; ++ks) qf[ks] = *(const bf16x8*)(Q + (size_t)(rowbase + 64 * (wave & 1) + r) * 1024 + head * 128 + 16 * ks + 8 * h);
        __syncthreads();
        const float slope2 = exp2f(-(float)(head + 1)) * LOG2E, sink2 = sinks[head] * LOG2E;
#pragma unroll 1
        for (int si = 0; si < 2; ++si) {
            const int q0 = 64 * (wave & 1) + 32 * si, kt0 = q0 >> 5; const size_t qrow = (size_t)(rowbase + q0 + r);
            const LAS unsigned char* kbase = lds + L_K + (32 * kt0 + r) * 272 + 16 * h;
            const LAS unsigned char* vbase = lds + L_V + (32 * kt0 + 4 * h + ((lane & 15) >> 2)) * 272 + (16 * ((lane >> 4) & 1) + 4 * (lane & 3)) * 2;
            const int d0 = (q0 + r) + 128 - (32 * kt0 + 4 * h);
            const int jlim = qblk > 0 ? -100000 : 128 - (32 * kt0 + 4 * h);
            const float fd0 = (float)d0, fjl = (float)jlim;
            f32x16 p[5];
#pragma unroll
            for (int t = 0; t < 5; ++t) {
#pragma unroll
                for (int e = 0; e < 16; ++e) p[t][e] = 0.f;
#pragma unroll
                for (int ks = 0; ks < 8; ++ks) { const bf16x8 kf = *(const LAS bf16x8*)(kbase + t * 8704 + ks * 32); p[t] = mfma32(kf, qf[ks], p[t]); } }
            if (si == 0) {
#pragma unroll
                for (int ks = 0; ks < 8; ++ks) qn[ks] = *(const bf16x8*)(Q + (qrow + 32) * 1024 + head * 128 + 16 * ks + 8 * h);
            }
            float mx = sink2;
#pragma unroll
            for (int t = 0; t < 5; ++t) {
                if (t >= 1 && t <= 3 && qblk > 0) {
#pragma unroll
                    for (int e = 0; e < 16; ++e) { const float cte = (float)(32 * t + (e & 3) + 8 * (e >> 2)); p[t][e] = p[t][e] - slope2 * (fd0 - cte); mx = fmaxf(mx, p[t][e]); }
                } else {
#pragma unroll
                    for (int e = 0; e < 16; ++e) { const float cte = (float)(32 * t + (e & 3) + 8 * (e >> 2)); const float fd = fd0 - cte;
                        const float bad = fmaxf(fmaxf(-fd, fd - 127.0f), fjl - cte);
                        p[t][e] = p[t][e] - slope2 * fd + fminf(0.f, -1e30f * bad); mx = fmaxf(mx, p[t][e]); }
                } }
            mx = fmaxf(mx, __shfl_xor(mx, 32));
            float sum = 0.f;
#pragma unroll
            for (int t = 0; t < 5; ++t)
#pragma unroll
                for (int e = 0; e < 16; ++e) { const float ev = fexp2(p[t][e] - mx); p[t][e] = ev; sum += ev; }
            sum += __shfl_xor(sum, 32); sum += fexp2(sink2 - mx);
            const float inv = 1.0f / sum;
            f32x16 o[4];
#pragma unroll
            for (int dt = 0; dt < 4; ++dt)
#pragma unroll
                for (int e = 0; e < 16; ++e) o[dt][e] = 0.f;
#pragma unroll
            for (int t = 0; t < 5; ++t) {
#pragma unroll
                for (int s = 0; s < 2; ++s) { u32x4 pk; pk.x = pk2(p[t][8 * s + 0], p[t][8 * s + 1]); pk.y = pk2(p[t][8 * s + 2], p[t][8 * s + 3]); pk.z = pk2(p[t][8 * s + 4], p[t][8 * s + 5]); pk.w = pk2(p[t][8 * s + 6], p[t][8 * s + 7]);
                    const bf16x8 pf = __builtin_bit_cast(bf16x8, pk);
#pragma unroll
                    for (int dt = 0; dt < 4; ++dt) { const LAS unsigned char* va = vbase + t * 8704 + s * 4352 + dt * 64;
                        const s16x4 lo = __builtin_amdgcn_ds_read_tr16_b64_v4i16((LAS s16x4*)va), hi = __builtin_amdgcn_ds_read_tr16_b64_v4i16((LAS s16x4*)(va + 2176));
                        const bf16x8 vf = __builtin_shufflevector(lo, hi, 0, 1, 2, 3, 4, 5, 6, 7); o[dt] = mfma32(vf, pf, o[dt]); } } }
#pragma unroll
            for (int dt = 0; dt < 4; ++dt)
#pragma unroll
                for (int gg = 0; gg < 4; ++gg) { u32x2 w; w.x = pk2(o[dt][4 * gg] * inv, o[dt][4 * gg + 1] * inv); w.y = pk2(o[dt][4 * gg + 2] * inv, o[dt][4 * gg + 3] * inv);
                    *(u32x2*)(AO + qrow * 2048 + head * 128 + 32 * dt + 8 * gg + 4 * h) = w; }
#pragma unroll
            for (int ks = 0; ks < 8; ++ks) qf[ks] = qn[ks];
        }
    }
}

constexpr int N_PHASES = 2 + 9 * DEPTH;
__global__ void __launch_bounds__(NWAVES * 64, 2) trunk_fwd(Args args) {
    extern __shared__ __attribute__((aligned(16))) unsigned char lds_raw[];
    LAS unsigned char* lds = (LAS unsigned char*)lds_raw;
    volatile LAS unsigned* MISC = (volatile LAS unsigned*)(lds + MISC_OFF);
    const int tid0 = threadIdx.x;
#define TID_DEFS int tid = tid0; asm volatile("" : "+v"(tid)); const int lane = tid & 63, wave = __builtin_amdgcn_readfirstlane(tid >> 6); (void)lane; (void)wave;
    const int G = gridDim.x;
    gu32* ctl = (gu32*)(args.ws + WS_CTL);
    for (int u = tid0; u < (LDS_BYTES - LDSCTL_OFF) / 4; u += NWAVES * 64) ((LAS unsigned*)(lds + LDSCTL_OFF))[u] = 0u;
    __syncthreads();
    XcdBarrier bar = xcd_barrier_post((unsigned*)ctl + CW_BAR, MISC + 8);
    const int lo = args.ph_lo, hi = args.ph_hi;
#ifndef PH_MASK
#define PH_MASK 0xffffffffu
#endif
#define EN(b) ((PH_MASK >> (b)) & 1u)
#ifndef A_ALIGN
#define A_ALIGN true
#endif
#ifndef MIX_DEAL
#define MIX_DEAL 0
#endif
#ifndef BINPACK
#define BINPACK 1
#endif
#ifndef FUSE_DENSE
#define FUSE_DENSE 0
#endif
#ifndef PH_REPEAT
#define PH_REPEAT 0u
#endif
#ifndef PH_NREP
#define PH_NREP 2
#endif
#define REPS(b) (((PH_REPEAT >> (b)) & 1u) ? PH_NREP : 1)
#define REP_BEGIN(b) for (int rep_ = 0; rep_ < REPS(b); ++rep_) { if (rep_) xcd_barrier(bar);
#define REP_END }
#define IN(k) (lo <= (k) && (k) < hi)
#ifndef BAR_TWICE
#define BAR_TWICE 0
#endif
#define SEAM(k) do { if (IN(k) && IN((k) + 1)) { xcd_barrier(bar); if (BAR_TWICE) xcd_barrier(bar); } } while (0)
#if NAIVE_GEMM
#define RUN_GEMM(EPI, SCHED, ALIGN, g, S, E) pg8::gemm_phase_naive<EPI, SCHED>(g, S, E)
#else
#ifndef BF_SP2
#define BF_SP2 true
#endif
#define RUN_GEMM(EPI, SCHED, ALIGN, g, S, E) pg8::gemm_phase<EPI, SCHED, ALIGN, BF_SP2>(lds + RING_OFF, g, S, E)
#endif
#ifndef F8_ALIGN
#define F8_ALIGN(a) (a)
#endif
#ifndef F8_SP2
#define F8_SP2 false
#endif
#define RUN_GEMM8(EPI, SCHED, ALIGN, g, S, E) pg8::gemm_phase<EPI, SCHED, F8_ALIGN(ALIGN), F8_SP2, true>(lds + RING_OFF, g, S, E)
#define SC_ONE 0x7f7f7f7f
#define SC_M5 0x7a7a7a7a
#define SC_M6 0x79797979
    if (EN(0) && IN(0)) { REP_BEGIN(0) TID_DEFS p0_prologue(lds, tid, wave, lane); REP_END } SEAM(0);
    if (EN(1) && IN(1)) { REP_BEGIN(1) TID_DEFS thin_start(wave, lane); REP_END } SEAM(1);

    for (int l = 0; l < DEPTH; ++l) {
        const int pb = 2 + 9 * l;
        const bool binpack = BINPACK && G == 256;
        if (EN(2) && IN(pb + 0)) { REP_BEGIN(2)
            unsigned char* ws = karg_ws(kargs());
            pg8::Gemm g{(const bf16*)(ws + WS_XN), (const bf16*)(ws + WS_WL + (size_t)l * WL_STRIDE + WL_WIN), M, D_IN, D}; pg8::StaticOrder S; S.init(M, binpack ? 16 * 256 : D_IN, G, (int)blockIdx.x);
            pg8::EpiWin E; E.R = ws + WS_R;
            RUN_GEMM(pg8::EpiWin, pg8::StaticOrder, A_ALIGN, g, S, E);
        REP_END } SEAM(pb + 0);
        if (IN(pb + 1)) {
            if (binpack) {
                const int xq = (int)blockIdx.x & 7, qq = (int)blockIdx.x >> 3; const bool gx = qq < 16; const int c = gx ? xq * 16 + qq : 128 + xq * 16 + (qq - 16);
#define MIX_GEMM() do { unsigned char* ws = karg_ws(kargs()); \
                    pg8::Gemm g{(const bf16*)(ws + WS_XN), (const bf16*)(ws + WS_WL + (size_t)l * WL_STRIDE + WL_WIN), M, D_IN, D}; pg8::ListOrder S; S.first = gx ? 48 * xq + qq : 48 * xq + 16 + 2 * (qq - 16); S.count = gx ? 1 : 2; S.ncol = 6; S.pn0 = 16; \
                    pg8::EpiWin E; E.R = ws + WS_R; \
                    RUN_GEMM(pg8::EpiWin, pg8::ListOrder, A_ALIGN, g, S, E); } while (0)
                if (EN(2)) MIX_GEMM();
                if (gx) { if (EN(3)) { TID_DEFS rnn_pass1(lds, l, tid, wave, lane, 2 * c, 2, 1); } }
                else { if (EN(4)) { TID_DEFS attn_phase(lds, l, tid, wave, lane, 2 * (c - 128), 2, 1); } }
#undef MIX_GEMM
            } else {
                const int c = vcu_index(), cnt = c < 256 ? (256 - c + G - 1) / G : 0;
                if (EN(3)) { REP_BEGIN(3) TID_DEFS rnn_pass1(lds, l, tid, wave, lane, c, cnt, G); REP_END }
                if (EN(4)) { REP_BEGIN(4) TID_DEFS attn_phase(lds, l, tid, wave, lane, c, cnt, G); REP_END }
            }
        } SEAM(pb + 1);
        if (EN(5) && IN(pb + 2)) { REP_BEGIN(5) TID_DEFS rnn_pass2(lds, tid); REP_END } SEAM(pb + 2);
        if (EN(6) && IN(pb + 3)) { REP_BEGIN(6)
            unsigned char* ws = karg_ws(kargs());
            pg8::Gemm g{(const bf16*)(ws + WS_RO), (const bf16*)(ws + WS_WL + (size_t)l * WL_STRIDE + WL_WB), M, D, 2 * D}; pg8::StaticOrder S; S.init(M, D, G, (int)blockIdx.x);
            pg8::EpiMerge E; E.R = ws + WS_R; RUN_GEMM(pg8::EpiMerge, pg8::StaticOrder, false, g, S, E);
         REP_END } SEAM(pb + 3);
        const bool fuse = FUSE_DENSE && !(l & 1) && G == 256;
        if (EN(7) && IN(pb + 4)) { REP_BEGIN(7)
            const kargp_t kp = kargs(); unsigned char* ws = karg_ws(kp);
            pg8::Gemm g{(const bf16*)(ws + WS_MG), (const bf16*)(ws + WS_WL + (size_t)l * WL_STRIDE + WL_WO), M, D, D}; pg8::StaticOrder S; S.init(M, D, G, (int)blockIdx.x);
            if (fuse) {
                const float* ada = (const float*)(ws + WS_ADA) + (size_t)(l * 2) * 6144; unsigned* ctlw = (unsigned*)(ws + WS_CTL); const int bank = (l >> 1) * 4;
                pg8::EpiRmsResRms E; E.xin32 = (l == 0) ? karg_in(kp, 0) : nullptr; E.xin16 = (const bf16*)(ws + WS_XB); E.XB = (bf16*)(ws + WS_XB); E.XN = (bf16*)(ws + WS_XN); E.xn_fp8 = (int)((FP8_LAYERS >> l) & 1u);
                E.gainA = karg_in(kp, 5) + l * D; E.gateA = ada + 2048; E.gainB = karg_in(kp, 6) + l * D; E.scB = ada + 4096; E.shB = ada + 3072;
                E.st1.xbuf = (float*)(ws + WS_XS) + (size_t)bank * 65536; E.st1.cnt = ctlw + CW_SEAM + bank * SEAM_BANK; E.st1.tmo = ctlw;
                E.st2.xbuf = (float*)(ws + WS_XS) + (size_t)(bank + 1) * 65536; E.st2.cnt = ctlw + CW_SEAM + (bank + 1) * SEAM_BANK; E.st2.tmo = ctlw;
                RUN_GEMM(pg8::EpiRmsResRms, pg8::StaticOrder, false, g, S, E);
            } else { pg8::EpiBf16N E; E.O = (bf16*)(ws + WS_MIX); RUN_GEMM(pg8::EpiBf16N, pg8::StaticOrder, false, g, S, E); }
        REP_END } SEAM(pb + 4);
        if (IN(pb + 5) && !fuse) { if (l & 1) { if (EN(9)) { TID_DEFS thin_mid_moe(lds, l, tid, wave, lane); } } else { if (EN(8)) { TID_DEFS thin_mid_dense(l, wave, lane); } } }
        if (!fuse) SEAM(pb + 5);
        if (l & 1) {
            if (EN(10) && IN(pb + 6)) { REP_BEGIN(10)
                unsigned char* ws = karg_ws(kargs()); const unsigned* cntg = (const unsigned*)(ws + WS_CTL) + CW_CNT + 64 * (l >> 1);
                pg8::Gemm g{(const bf16*)(ws + WS_AP), (const bf16*)(ws + WS_WM + (size_t)(l >> 1) * WM_STRIDE + WM_MIN), 0, 0, D, SC_M5, SC_ONE}; pg8::MoeOrder S; S.init(cntg, 12, G, (int)blockIdx.x, ECAP / 256);
                if ((FP8_LAYERS >> l) & 1u) { pg8::EpiSwiglu8 E; E.O = ws + WS_ACTP; E.ldc = D_FFE; E.ntile = 12; RUN_GEMM8(pg8::EpiSwiglu8, pg8::MoeOrder, true, g, S, E); }
                else { pg8::EpiSwiglu E; E.O = (bf16*)(ws + WS_ACTP); E.ldc = D_FFE; E.ntile = 12; RUN_GEMM(pg8::EpiSwiglu, pg8::MoeOrder, true, g, S, E); }
             REP_END } SEAM(pb + 6);
            if (EN(11) && IN(pb + 7)) { REP_BEGIN(11)
                unsigned char* ws = karg_ws(kargs()); const unsigned* cntg = (const unsigned*)(ws + WS_CTL) + CW_CNT + 64 * (l >> 1);
                pg8::Gemm g{(const bf16*)(ws + WS_ACTP), (const bf16*)(ws + WS_WM + (size_t)(l >> 1) * WM_STRIDE + WM_MOUT), 0, 0, D_FFE, SC_M5, SC_ONE}; pg8::MoeOrder S; S.init(cntg, 4, G, (int)blockIdx.x, 0);
                pg8::EpiBf16Mod4 E; E.O = (bf16*)(ws + WS_YP);
                if ((FP8_LAYERS >> l) & 1u) RUN_GEMM8(pg8::EpiBf16Mod4, pg8::MoeOrder, true, g, S, E); else RUN_GEMM(pg8::EpiBf16Mod4, pg8::MoeOrder, true, g, S, E);
             REP_END } SEAM(pb + 7);
        } else {
            if (EN(12) && IN(pb + 6)) { REP_BEGIN(12)
                unsigned char* ws = karg_ws(kargs());
                pg8::Gemm g{(const bf16*)(ws + WS_XN), (const bf16*)(ws + WS_WD + (size_t)(l >> 1) * WD_STRIDE + WD_FIN), M, 2 * D_FF, D, SC_M5, SC_ONE}; pg8::StaticOrder S; S.init(M, 2 * D_FF, G, (int)blockIdx.x);
                if ((FP8_LAYERS >> l) & 1u) { pg8::EpiSwiglu8 E; E.O = ws + WS_ACT; E.ldc = D_FF; E.ntile = 24; RUN_GEMM8(pg8::EpiSwiglu8, pg8::StaticOrder, true, g, S, E); }
                else { pg8::EpiSwiglu E; E.O = (bf16*)(ws + WS_ACT); E.ldc = D_FF; E.ntile = 24; RUN_GEMM(pg8::EpiSwiglu, pg8::StaticOrder, true, g, S, E); }
             REP_END } SEAM(pb + 6);
            if (EN(13) && IN(pb + 7)) { REP_BEGIN(13)
                unsigned char* ws = karg_ws(kargs());
                pg8::Gemm g{(const bf16*)(ws + WS_ACT), (const bf16*)(ws + WS_WD + (size_t)(l >> 1) * WD_STRIDE + WD_FOUT), M, D, D_FF, SC_M6, SC_ONE}; pg8::StaticOrder S; S.init(M, D, G, (int)blockIdx.x);
                if (fuse) {
                    const kargp_t kp = kargs(); const float* ada = (const float*)(ws + WS_ADA) + (size_t)(l * 2) * 6144; const float* adan = (const float*)(ws + WS_ADA) + (size_t)((l + 1) * 2) * 6144; unsigned* ctlw = (unsigned*)(ws + WS_CTL); const int bank = (l >> 1) * 4 + 2;
                    pg8::EpiRmsResRms E; E.xin32 = nullptr; E.xin16 = (const bf16*)(ws + WS_XB); E.XB = (bf16*)(ws + WS_XB); E.XN = (bf16*)(ws + WS_XN); E.xn_fp8 = 0;
                    E.gainA = karg_in(kp, 7) + l * D; E.gateA = ada + 5120; E.gainB = karg_in(kp, 4) + (l + 1) * D; E.scB = adan + 1024; E.shB = adan;
                    E.st1.xbuf = (float*)(ws + WS_XS) + (size_t)bank * 65536; E.st1.cnt = ctlw + CW_SEAM + bank * SEAM_BANK; E.st1.tmo = ctlw;
                    E.st2.xbuf = (float*)(ws + WS_XS) + (size_t)(bank + 1) * 65536; E.st2.cnt = ctlw + CW_SEAM + (bank + 1) * SEAM_BANK; E.st2.tmo = ctlw;
                    if ((FP8_LAYERS >> l) & 1u) RUN_GEMM8(pg8::EpiRmsResRms, pg8::StaticOrder, false, g, S, E); else RUN_GEMM(pg8::EpiRmsResRms, pg8::StaticOrder, false, g, S, E);
                } else { pg8::EpiBf16N E; E.O = (bf16*)(ws + WS_MIX);
                    if ((FP8_LAYERS >> l) & 1u) RUN_GEMM8(pg8::EpiBf16N, pg8::StaticOrder, false, g, S, E); else RUN_GEMM(pg8::EpiBf16N, pg8::StaticOrder, false, g, S, E); }
             REP_END } SEAM(pb + 7);
        }
        if (EN(14) && IN(pb + 8) && !fuse) { TID_DEFS thin_end(l, wave, lane); }
        if (!fuse) SEAM(pb + 8);
    }
#undef IN
#undef SEAM
}

extern "C" void kernel_launch(void* const* d_in, const int* in_sizes, int n_in, void* d_out, int out_size, void* d_ws, size_t ws_size, hipStream_t stream) {
    static int grid = 0;
    if (grid == 0) {
        if (n_in != 24 || in_sizes[0] != M * D || out_size != M * D || ws_size < WS_END) { fprintf(stderr, "kernel_launch: unexpected shapes or workspace (n_in %d, in0 %d, out %d, ws %zu < %zu); nothing launched\n", n_in, n_in > 0 ? in_sizes[0] : -1, out_size, ws_size, (size_t)WS_END); grid = -1; return; }
        int dev = 0, cus = 0, per_cu = 0;
        if (hipGetDevice(&dev) != hipSuccess || hipDeviceGetAttribute(&cus, hipDeviceAttributeMultiprocessorCount, dev) != hipSuccess) { grid = -1; return; }
        if (hipFuncSetAttribute((const void*)trunk_fwd, hipFuncAttributeMaxDynamicSharedMemorySize, LDS_BYTES) != hipSuccess) { fprintf(stderr, "kernel_launch: hipFuncSetAttribute failed\n"); grid = -1; return; }
        if (hipOccupancyMaxActiveBlocksPerMultiprocessor(&per_cu, (const void*)trunk_fwd, NWAVES * 64, LDS_BYTES) != hipSuccess || per_cu < 1)
            fprintf(stderr, "kernel_launch: note: occupancy query reports %d workgroups per CU\n", per_cu);
        (void)hipGetLastError();
        grid = cus;
    }
    if (grid < 0) return;
    if (hipMemsetAsync((char*)d_ws + WS_CTL, 0, CTL_ZERO_BYTES, stream) != hipSuccess) return;
    Args a{};
    for (int i = 0; i < 24; ++i) a.in[i] = (const float*)d_in[i];
    a.out = (float*)d_out; a.ws = (unsigned char*)d_ws;
#if MK_ONE_LAUNCH
    a.ph_lo = 0; a.ph_hi = N_PHASES;
    hipLaunchKernelGGL(trunk_fwd, dim3(grid), dim3(NWAVES * 64), LDS_BYTES, stream, a);
#else
    for (int p = 0; p < N_PHASES; ++p) { a.ph_lo = p; a.ph_hi = p + 1; hipLaunchKernelGGL(trunk_fwd, dim3(grid), dim3(NWAVES * 64), LDS_BYTES, stream, a); }
#endif
}
```

```cpp
#include <hip/hip_runtime.h>
#include <cstdio>
#include <cstdint>

#ifndef MK_ONE_LAUNCH
#define MK_ONE_LAUNCH 1
#endif
#ifndef NAIVE_GEMM
#define NAIVE_GEMM 0
#endif

#ifndef FP8_LAYERS
#define FP8_LAYERS 0xEu
#endif
#define DI __device__ __forceinline__
#define GAS __attribute__((address_space(1)))
#define LAS __attribute__((address_space(3)))
typedef unsigned short bf16;
typedef short bf16x8 __attribute__((ext_vector_type(8)));
typedef short s16x4 __attribute__((ext_vector_type(4)));
typedef float f32x2 __attribute__((ext_vector_type(2)));
typedef float f32x4 __attribute__((ext_vector_type(4)));
typedef float f32x16 __attribute__((ext_vector_type(16)));
typedef unsigned u32x2 __attribute__((ext_vector_type(2)));
typedef unsigned u32x4 __attribute__((ext_vector_type(4)));
typedef __bf16 bf16x2_t __attribute__((ext_vector_type(2)));
typedef GAS unsigned gu32;

constexpr int BATCH = 2, SEQ = 8192, D = 1024, DEPTH = 4, M = BATCH * SEQ;
constexpr int D_IN = 5632, D_FF = 3072, NE = 8, D_FFE = 1536, ECAP = 16384;
constexpr float EPS = 1e-6f;
constexpr float LOG2E = 1.4426950408889634f;
constexpr float QSCALE = 0.08838834764831845f * 1.4426950408889634f;

DI unsigned pk2(float lo, float hi) { f32x2 v = {lo, hi}; return __builtin_bit_cast(unsigned, __builtin_convertvector(v, bf16x2_t)); }
DI float bflo(unsigned w) { return __uint_as_float(w << 16); }
DI float bfhi(unsigned w) { return __uint_as_float(w & 0xffff0000u); }
DI float fexp2(float x) { return __builtin_amdgcn_exp2f(x); }
DI float frcp(float x) { return __builtin_amdgcn_rcpf(x); }
DI float sigmoidf_(float v) { return frcp(1.0f + fexp2(-LOG2E * v)); }
DI float siluf_(float v) { return v * sigmoidf_(v); }
DI float gelu_tanh_(float v) { const float t = v + 0.044715f * v * v * v; return v * frcp(1.0f + fexp2(-2.0f * 0.7978845608028654f * LOG2E * t)); }
DI float wave_sum(float v) {
#pragma unroll
    for (int o = 1; o < 64; o <<= 1) v += __shfl_xor(v, o);
    return v;
}
#define LDS_WAIT() asm volatile("s_waitcnt lgkmcnt(0)" ::: "memory")
#define VM_WAIT() asm volatile("s_waitcnt vmcnt(0)" ::: "memory")
#define RLX_AGENT __ATOMIC_RELAXED, __HIP_MEMORY_SCOPE_AGENT
#ifndef HOOK_ON
#define HOOK_ON 1
#endif
#ifndef WGM_SET
#define WGM_SET 8
#endif
namespace pg8 {
#define PG8_LAS __attribute__((address_space(3)))
typedef unsigned short bf16_t;
constexpr int BM = 256, BK = 64, HALF = 128, HTB = HALF * BK * 2  , STAGE_BYTES = 8 * HTB, NXCD = 8, WGM = WGM_SET;

__host__ __device__ __forceinline__ int lds_byte(int r, int c) { const int st = (r >> 4) * 2 + (c >> 5), rr = r & 15, cc = c & 31, ob = rr * 64 + cc * 2; return st * 1024 + (ob ^ (((ob >> 9) & 1) << 5)); }
__host__ __device__ __forceinline__ void stage_rc(int b, int& R, int& C) { const int st = b / 1024, sb = b % 1024, swz = sb ^ (((sb >> 9) & 1) << 5); R = (st >> 1) * 16 + swz / 64; C = (st & 1) * 32 + (swz % 64) / 2; }
__host__ __device__ __forceinline__ int perm32(int rho) { const int n = rho >> 4, i = rho & 15; return 8 * (i >> 2) + 4 * n + (i & 3); }

struct Unit { int pm, pn, po; };
struct Gemm { const bf16_t* A; const bf16_t* Bt; int M, N, K; int sw, sa; };
typedef int i32x8 __attribute__((ext_vector_type(8)));
typedef int i32x4v __attribute__((ext_vector_type(4)));
__device__ __forceinline__ i32x8 cat8(bf16x8 lo, bf16x8 hi) { return __builtin_shufflevector(__builtin_bit_cast(i32x4v, lo), __builtin_bit_cast(i32x4v, hi), 0, 1, 2, 3, 4, 5, 6, 7); }
__device__ __forceinline__ unsigned pk4fp8(f32x4 v) { int w = __builtin_amdgcn_cvt_pk_fp8_f32(v[0], v[1], 0, false); w = __builtin_amdgcn_cvt_pk_fp8_f32(v[2], v[3], w, true); return (unsigned)w; }

struct StaticOrder {
    int nM, nN, nwg, G, c;
    __host__ __device__ void init(int M, int N, int G_, int c_) { nM = M / BM; nN = N / BM; nwg = nM * nN; G = G_; c = c_; }
    __host__ __device__ bool next(int i, Unit& u) const {
        const long L = (long)i * G + c; if (L >= nwg) return false;
        int wgid = (int)L; { const int q = nwg / NXCD, r = nwg % NXCD, xcd = wgid % NXCD, off = wgid / NXCD; wgid = (xcd < r ? xcd * (q + 1) : r * (q + 1) + (xcd - r) * q) + off; }
        const int nig = WGM * nN, gid = wgid / nig, fm = gid * WGM, gsz = (nM - fm) < WGM ? (nM - fm) : WGM;
        u.pm = fm + ((wgid % nig) % gsz); u.pn = (wgid % nig) / gsz; u.po = u.pm; return true;
    }
    __device__ __forceinline__ void a_ready(const Unit&) const {}
    __device__ __forceinline__ void done(const Unit&) const {}
};
struct ListOrder {
    int first, count, ncol, pn0;
    __device__ __forceinline__ bool next(int i, Unit& u) const { if (i >= count) return false; const int g = first + i; u.pm = g / ncol; u.pn = pn0 + g % ncol; u.po = u.pm; return true; }
    __device__ __forceinline__ void a_ready(const Unit&) const {}
    __device__ __forceinline__ void done(const Unit&) const {}
};
struct MoeOrder {
    int pp[9]; int nM, nN, nwg, G, c, astride;
    __device__ __forceinline__ void init(const unsigned* cnt, int NT, int G_, int c_, int astride_) {
        int a = 0;
#pragma unroll
        for (int e = 0; e < 8; ++e) { pp[e] = a; const unsigned n = (unsigned)__builtin_amdgcn_readfirstlane((int)__hip_atomic_load(cnt + e, RLX_AGENT)); a += (int)((n + 255u) >> 8); }
        pp[8] = a; nM = a; nN = NT; nwg = nM * nN; G = G_; c = c_; astride = astride_;
    }
    __device__ __forceinline__ bool next(int i, Unit& u) const {
        const long L = (long)i * G + c; if (L >= nwg) return false;
        int wgid = (int)L; { const int q = nwg / NXCD, r = nwg % NXCD, xcd = wgid % NXCD, off = wgid / NXCD; wgid = (xcd < r ? xcd * (q + 1) : r * (q + 1) + (xcd - r) * q) + off; }
        const int nig = WGM * nN, gid = wgid / nig, fm = gid * WGM, gsz = (nM - fm) < WGM ? (nM - fm) : WGM;
        const int vp = fm + ((wgid % nig) % gsz), t = (wgid % nig) / gsz;
        int e = 0, base = 0;
#pragma unroll
        for (int k = 1; k < 8; ++k) if (vp >= pp[k]) { e = k; base = pp[k]; }
        u.pm = astride ? e * astride + (vp - base) : vp; u.pn = e * nN + t; u.po = vp; return true;
    }
    __device__ __forceinline__ void a_ready(const Unit&) const {}
    __device__ __forceinline__ void done(const Unit&) const {}
};

template <class E> __device__ __forceinline__ void epi_rows(const E& e, const f32x4 (&acc)[2][2][4][2], const Unit& u, int wr, int wc, int fr, int fq) {
    asm volatile("" : "+v"(fr), "+v"(fq));
#pragma unroll
    for (int ai = 0; ai < 2; ++ai)
#pragma unroll
        for (int m = 0; m < 4; ++m) e.row8(u, ai * HALF + wr * 64 + m * 16 + fr, wc * 32 + 8 * fq, acc[ai][0][m][0], acc[ai][0][m][1], acc[ai][1][m][0], acc[ai][1][m][1]);
}
#define PG8_EPI_COMMON static constexpr bool PERM = true, AFTER_DRAIN = false, MID_HOOK = false; \
    __device__ __forceinline__ void operator()(const f32x4 (&acc)[2][2][4][2], const Unit& u, int wr, int wc, int fr, int fq) const { epi_rows(*this, acc, u, wr, wc, fr, fq); }
__device__ __forceinline__ void st8bf(bf16_t* p, f32x4 a, f32x4 b) { u32x4 w; w.x = pk2(a[0], a[1]); w.y = pk2(a[2], a[3]); w.z = pk2(b[0], b[1]); w.w = pk2(b[2], b[3]); *(u32x4*)p = w; }
__device__ __forceinline__ void ld8bf(const bf16_t* p, f32x4& a, f32x4& b) { const u32x4 w = *(const u32x4*)p; a = (f32x4){bflo(w.x), bfhi(w.x), bflo(w.y), bfhi(w.y)}; b = (f32x4){bflo(w.z), bfhi(w.z), bflo(w.w), bfhi(w.w)}; }
__device__ __forceinline__ f32x4 gelu4(f32x4 v) { return (f32x4){gelu_tanh_(v[0]), gelu_tanh_(v[1]), gelu_tanh_(v[2]), gelu_tanh_(v[3])}; }
__device__ __forceinline__ f32x4 sig4(f32x4 v) { return (f32x4){sigmoidf_(v[0]), sigmoidf_(v[1]), sigmoidf_(v[2]), sigmoidf_(v[3])}; }
__device__ __forceinline__ f32x4 silu4(f32x4 v) { return (f32x4){siluf_(v[0]), siluf_(v[1]), siluf_(v[2]), siluf_(v[3])}; }

struct EpiWin { PG8_EPI_COMMON
    unsigned char* R;
    __device__ __forceinline__ void row8(const Unit& u, int r, int cit, f32x4 a0, f32x4 a1, f32x4 b0, f32x4 b1) const {
        const size_t row = (size_t)u.po * BM + r; const int pn = u.pn;
        bf16_t* XR = (bf16_t*)R; bf16_t* GG = (bf16_t*)(R + (32u << 20)); bf16_t* Q = (bf16_t*)(R + (64u << 20)); bf16_t* KB = (bf16_t*)(R + (96u << 20)); bf16_t* VB = (bf16_t*)(R + (104u << 20)); bf16_t* GT = (bf16_t*)(R + (112u << 20));
        if (pn < 4)       { bf16_t* o = XR + row * 1024 + 256 * pn + cit; st8bf(o, a0, a1); st8bf(o + HALF, b0, b1); }
        else if (pn < 8)  { bf16_t* o = GG + row * 1024 + 256 * (pn - 4) + cit; st8bf(o, gelu4(a0), gelu4(a1)); st8bf(o + HALF, gelu4(b0), gelu4(b1)); }
        else if (pn < 12) { bf16_t* o = Q + row * 1024 + 256 * (pn - 8) + cit; st8bf(o, a0 * QSCALE, a1 * QSCALE); st8bf(o + HALF, b0 * QSCALE, b1 * QSCALE); }
        else if (pn == 12) { bf16_t* o = KB + row * 256 + cit; st8bf(o, a0, a1); st8bf(o + HALF, b0, b1); }
        else if (pn == 13) { bf16_t* o = VB + row * 256 + cit; st8bf(o, a0, a1); st8bf(o + HALF, b0, b1); }
        else { bf16_t* o = GT + row * 2048 + 256 * (pn - 14) + cit; st8bf(o, sig4(a0), sig4(a1)); st8bf(o + HALF, sig4(b0), sig4(b1)); }
    }
};
struct EpiMerge {
    static constexpr bool PERM = true, AFTER_DRAIN = false, MID_HOOK = true;
    unsigned char* R;
    __device__ __forceinline__ void operator()(const f32x4 (&acc)[2][2][4][2], const Unit& u, int wr, int wc, int fr, int fq) const { epi_rows(*this, acc, u, wr, wc, fr, fq); }
    __device__ __forceinline__ void mid(f32x4 (&acc)[2][2][4][2], const Unit& u, int wr, int wc, int fr, int fq) const {
        asm volatile("" : "+v"(fr), "+v"(fq));
        const bf16_t* GT = (const bf16_t*)(R + (112u << 20));
#pragma unroll
        for (int ai = 0; ai < 2; ++ai)
#pragma unroll
            for (int m = 0; m < 4; ++m) { const size_t row = (size_t)u.po * BM + ai * HALF + wr * 64 + m * 16 + fr;
#pragma unroll
                for (int bj = 0; bj < 2; ++bj) { const int c = 256 * u.pn + bj * HALF + wc * 32 + 8 * fq; f32x4 g0a, g0b, g1a, g1b; ld8bf(GT + row * 2048 + c, g0a, g0b); ld8bf(GT + row * 2048 + 1024 + c, g1a, g1b);
#pragma unroll
                    for (int i = 0; i < 4; ++i) { acc[ai][bj][m][0][i] *= g0a[i] * frcp(fmaxf(g1a[i], 1e-30f)); acc[ai][bj][m][1][i] *= g0b[i] * frcp(fmaxf(g1b[i], 1e-30f)); } } }
    }
    __device__ __forceinline__ void row8(const Unit& u, int r, int cit, f32x4 a0, f32x4 a1, f32x4 b0, f32x4 b1) const {
        const size_t row = (size_t)u.po * BM + r; const int c = 256 * u.pn + cit;
        const bf16_t* GT = (const bf16_t*)(R + (112u << 20)); bf16_t* MG = (bf16_t*)(R + (304u << 20));
        f32x4 g0, g1; ld8bf(GT + row * 2048 + 1024 + c, g0, g1); st8bf(MG + row * 1024 + c, g0 * a0, g1 * a1);
        ld8bf(GT + row * 2048 + 1024 + c + HALF, g0, g1); st8bf(MG + row * 1024 + c + HALF, g0 * b0, g1 * b1);
    }
};
struct EpiBf16N { PG8_EPI_COMMON
    bf16_t* O;
    __device__ __forceinline__ void row8(const Unit& u, int r, int cit, f32x4 a0, f32x4 a1, f32x4 b0, f32x4 b1) const {
        bf16_t* o = O + ((size_t)u.po * BM + r) * 1024 + 256 * u.pn + cit; st8bf(o, a0, a1); st8bf(o + HALF, b0, b1);
    }
};
struct EpiF32 { PG8_EPI_COMMON
    float* O;
    __device__ __forceinline__ void row8(const Unit& u, int r, int cit, f32x4 a0, f32x4 a1, f32x4 b0, f32x4 b1) const {
        float* o = O + ((size_t)u.po * BM + r) * 1024 + 256 * u.pn + cit; *(f32x4*)o = a0; *(f32x4*)(o + 4) = a1; *(f32x4*)(o + HALF) = b0; *(f32x4*)(o + HALF + 4) = b1;
    }
};
struct EpiSwiglu { PG8_EPI_COMMON
    bf16_t* O; int ldc, ntile;
    __device__ __forceinline__ void row8(const Unit& u, int r, int cit, f32x4 a0, f32x4 a1, f32x4 b0, f32x4 b1) const {
        st8bf(O + ((size_t)u.po * BM + r) * ldc + HALF * (u.pn % ntile) + cit, silu4(a0) * b0, silu4(a1) * b1);
    }
};
struct EpiSwiglu8 { PG8_EPI_COMMON
    unsigned char* O; int ldc, ntile;
    __device__ __forceinline__ void row8(const Unit& u, int r, int cit, f32x4 a0, f32x4 a1, f32x4 b0, f32x4 b1) const {
        u32x2 w; w.x = pk4fp8(silu4(a0) * b0); w.y = pk4fp8(silu4(a1) * b1); *(u32x2*)(O + ((size_t)u.po * BM + r) * ldc + HALF * (u.pn % ntile) + cit) = w;
    }
};
struct EpiBf16Mod4 { PG8_EPI_COMMON
    bf16_t* O;
    __device__ __forceinline__ void row8(const Unit& u, int r, int cit, f32x4 a0, f32x4 a1, f32x4 b0, f32x4 b1) const {
        bf16_t* o = O + ((size_t)u.po * BM + r) * 1024 + 256 * (u.pn & 3) + cit; st8bf(o, a0, a1); st8bf(o + HALF, b0, b1);
    }
};


struct PanelSS {
    float* xbuf;
    unsigned* cnt;
    unsigned* tmo;
    __device__ __forceinline__ void run(const f32x4 (&v)[2][2][4][2], const Unit& u, int wr, int wc, int fr, int fq, PG8_LAS unsigned char* lds, int wid, int lane) const {
        PG8_LAS float* P = (PG8_LAS float*)lds;
        PG8_LAS float* S = (PG8_LAS float*)(lds + 8192);
        PG8_LAS unsigned* flag = (PG8_LAS unsigned*)(lds + 8192 + 2048);
#pragma unroll
        for (int ai = 0; ai < 2; ++ai)
#pragma unroll
            for (int m = 0; m < 4; ++m) { float s = 0.f;
#pragma unroll
                for (int bj = 0; bj < 2; ++bj)
#pragma unroll
                    for (int n = 0; n < 2; ++n) { const f32x4 x = v[ai][bj][m][n]; s += (x[0] * x[0] + x[1] * x[1]) + (x[2] * x[2] + x[3] * x[3]); }
                s += __shfl_xor(s, 16); s += __shfl_xor(s, 32);
                if (fq == 0) P[(ai * HALF + wr * 64 + m * 16 + fr) * 4 + wc] = s; }
        asm volatile("s_waitcnt lgkmcnt(0)" ::: "memory"); __builtin_amdgcn_s_barrier(); asm volatile("" ::: "memory");
        const int row = wid * 32 + (lane & 31);
        if (lane < 32) { const f32x4 p = *(const PG8_LAS f32x4*)(P + row * 4);
            __hip_atomic_store((unsigned*)xbuf + ((size_t)(u.pm * BM + row) * 4 + u.pn), __float_as_uint((p[0] + p[1]) + (p[2] + p[3])), __ATOMIC_RELAXED, __HIP_MEMORY_SCOPE_AGENT); }
        asm volatile("s_waitcnt vmcnt(0)" ::: "memory");
        if (lane == 0) __hip_atomic_fetch_add(cnt + 64 * u.pm, 1u, __ATOMIC_RELAXED, __HIP_MEMORY_SCOPE_AGENT);
        if (wid == 0) {
            const unsigned long long t0 = __builtin_amdgcn_s_memrealtime();
            for (;;) {
                if ((unsigned)__builtin_amdgcn_readfirstlane((int)__hip_atomic_load(cnt + 64 * u.pm, __ATOMIC_RELAXED, __HIP_MEMORY_SCOPE_AGENT)) >= 32u) break;
                if (__builtin_amdgcn_s_memrealtime() - t0 > 2000000ull) { if (lane == 0) __hip_atomic_store(tmo, 1u, __ATOMIC_RELAXED, __HIP_MEMORY_SCOPE_AGENT); break; }
                __builtin_amdgcn_s_sleep(2);
            }
            __builtin_amdgcn_fence(__ATOMIC_ACQUIRE, "agent");
            if (lane == 0) flag[0] = 0u;
        }
        asm volatile("s_waitcnt vmcnt(0) lgkmcnt(0)" ::: "memory"); __builtin_amdgcn_s_barrier(); asm volatile("" ::: "memory");
        if (lane < 32) { const unsigned* slot = (const unsigned*)xbuf + (size_t)(u.pm * BM + row) * 4; float t = 0.f;
#pragma unroll
            for (int k = 0; k < 4; ++k) t += __uint_as_float(__hip_atomic_load(slot + k, __ATOMIC_RELAXED, __HIP_MEMORY_SCOPE_AGENT));
            S[row] = rsqrtf(t * (1.0f / 1024.0f) + 1e-6f); }
        asm volatile("s_waitcnt lgkmcnt(0)" ::: "memory"); __builtin_amdgcn_s_barrier(); asm volatile("" ::: "memory");
    }
};
struct EpiRmsResRms {
    static constexpr bool PERM = true, AFTER_DRAIN = true, MID_HOOK = false;
    const float* xin32; const bf16_t* xin16;
    bf16_t* XB; bf16_t* XN; int xn_fp8;
    const float *gainA, *gateA, *gainB, *scB, *shB;
    PanelSS st1, st2;
    __device__ __forceinline__ void fused(f32x4 (&acc)[2][2][4][2], const Unit& u, int wr, int wc, int fr, int fq, PG8_LAS unsigned char* lds, int wid, int lane) const {
        asm volatile("" : "+v"(fr), "+v"(fq));
        const PG8_LAS float* S = (const PG8_LAS float*)(lds + 8192);
        const int bofs = (((u.pm * BM) >> 13) != 0) ? 6144 : 0;
        const int col0 = 256 * u.pn + wc * 32 + 8 * fq;
        st1.run(acc, u, wr, wc, fr, fq, lds, wid, lane);
        { f32x4 cA[2][2];
#pragma unroll
          for (int bj = 0; bj < 2; ++bj)
#pragma unroll
            for (int n = 0; n < 2; ++n) cA[bj][n] = *(const f32x4*)(gainA + col0 + bj * HALF + 4 * n) * *(const f32x4*)(gateA + bofs + col0 + bj * HALF + 4 * n);
#pragma unroll
          for (int ai = 0; ai < 2; ++ai)
#pragma unroll
            for (int m = 0; m < 4; ++m) { const int r = ai * HALF + wr * 64 + m * 16 + fr; const float rs = S[r]; const size_t off = (size_t)(u.pm * BM + r) * 1024 + col0;
#pragma unroll
                for (int bj = 0; bj < 2; ++bj) { f32x4 x0, x1;
                    if (xin32) { x0 = *(const f32x4*)(xin32 + off + bj * HALF); x1 = *(const f32x4*)(xin32 + off + bj * HALF + 4); } else ld8bf(xin16 + off + bj * HALF, x0, x1);
                    acc[ai][bj][m][0] = x0 + cA[bj][0] * (acc[ai][bj][m][0] * rs); acc[ai][bj][m][1] = x1 + cA[bj][1] * (acc[ai][bj][m][1] * rs);
                    st8bf(XB + off + bj * HALF, acc[ai][bj][m][0], acc[ai][bj][m][1]); }
                asm volatile("" : "+v"(acc[ai][0][m][0]), "+v"(acc[ai][0][m][1]), "+v"(acc[ai][1][m][0]), "+v"(acc[ai][1][m][1])); } }
        st2.run(acc, u, wr, wc, fr, fq, lds, wid, lane);
        { f32x4 cB[2][2], cC[2][2];
#pragma unroll
          for (int bj = 0; bj < 2; ++bj)
#pragma unroll
            for (int n = 0; n < 2; ++n) { cB[bj][n] = *(const f32x4*)(gainB + col0 + bj * HALF + 4 * n) * (*(const f32x4*)(scB + bofs + col0 + bj * HALF + 4 * n) + 1.0f); cC[bj][n] = *(const f32x4*)(shB + bofs + col0 + bj * HALF + 4 * n); }
#pragma unroll
          for (int ai = 0; ai < 2; ++ai)
#pragma unroll
            for (int m = 0; m < 4; ++m) { const int r = ai * HALF + wr * 64 + m * 16 + fr; const float rs = S[r]; const size_t off = (size_t)(u.pm * BM + r) * 1024 + col0;
#pragma unroll
                for (int bj = 0; bj < 2; ++bj) { const f32x4 h0 = acc[ai][bj][m][0] * rs * cB[bj][0] + cC[bj][0], h1 = acc[ai][bj][m][1] * rs * cB[bj][1] + cC[bj][1];
                    if (xn_fp8) { u32x2 w; w.x = pk4fp8(h0); w.y = pk4fp8(h1); *(u32x2*)((unsigned char*)XN + off + bj * HALF) = w; } else st8bf(XN + off + bj * HALF, h0, h1); } } }
    }
};
template <class Epi, class Sched>
__device__ __forceinline__ void gemm_phase_naive(const Gemm g, const Sched& S, const Epi& E) {
    Unit u;
    for (int i = 0; S.next(i, u); ++i) {
        for (int idx = threadIdx.x; idx < 256 * 16; idx += blockDim.x) {
            const int r = idx >> 4, cit = (idx & 15) * 8;
            const bf16_t* a = g.A + ((size_t)u.pm * BM + r) * g.K;
            float o[16];
#pragma unroll
            for (int j = 0; j < 16; ++j) o[j] = 0.f;
            for (int k = 0; k < g.K; k += 8) {
                f32x4 x0, x1; ld8bf(a + k, x0, x1);
#pragma unroll
                for (int j = 0; j < 16; ++j) { const bf16_t* b = g.Bt + ((size_t)u.pn * BM + (j >> 3) * HALF + cit + (j & 7)) * g.K + k; f32x4 y0, y1; ld8bf(b, y0, y1);
                    o[j] += x0[0] * y0[0] + x0[1] * y0[1] + x0[2] * y0[2] + x0[3] * y0[3] + x1[0] * y1[0] + x1[1] * y1[1] + x1[2] * y1[2] + x1[3] * y1[3]; }
            }
            E.row8(u, r, cit, (f32x4){o[0], o[1], o[2], o[3]}, (f32x4){o[4], o[5], o[6], o[7]}, (f32x4){o[8], o[9], o[10], o[11]}, (f32x4){o[12], o[13], o[14], o[15]});
        }
    }
}

template <class Epi, class Sched, bool ALIGN_EPI = false, bool SP2 = false, bool FP8 = false>
__device__ __forceinline__ void gemm_phase(PG8_LAS unsigned char* lds, const Gemm g, const Sched& S, const Epi& E) {
    int tid_ = threadIdx.x; asm volatile("" : "+v"(tid_));
    const int tid = tid_, wid = __builtin_amdgcn_readfirstlane(tid >> 6), lane = tid & 63, wr = wid >> 2, wc = wid & 3, fr = lane & 15, fq = lane >> 4;
    constexpr int ESZ = FP8 ? 1 : 2;
    const int K = g.K, nt = K * ESZ / (BK * 2);
    unsigned voffA[2], voffB[2];
#pragma unroll
    for (int i = 0; i < 2; ++i) { int R, C; stage_rc(tid * 16 + i * 8192, R, C); const int Rb = Epi::PERM ? ((R & ~31) + perm32(R & 31)) : R;
        voffA[i] = (unsigned)(R * K * ESZ + C * 2); voffB[i] = (unsigned)(Rb * K * ESZ + C * 2); }
    const size_t kstep = (size_t)(BK * 2);
    const size_t hstep = (size_t)HALF * K * ESZ;
    const size_t tstep = 2 * hstep;
    const unsigned ldsw = (unsigned)wid * 1024u;
    const int aoff = lds_byte(wr * 64 + fr, FP8 ? fq * 16 : fq * 8), boff = lds_byte(wc * 32 + fr, FP8 ? fq * 16 : fq * 8);
#define PG8_SA(b, h) (((b) * 2 + (h)) * HTB)
#define PG8_SB(b, h) ((4 + (b) * 2 + (h)) * HTB)
#define PG8_STAGE(bufoff, gbase, voff) do { _Pragma("unroll") for (int _i = 0; _i < 2; ++_i) \
        __builtin_amdgcn_global_load_lds((const unsigned*)((const char*)(gbase) + (voff)[_i]), (PG8_LAS unsigned*)(lds + (bufoff) + ldsw + _i * 8192), 16, 0, 0); } while (0)
#define PG8_LDA(dst, b, h) do { _Pragma("unroll") for (int m = 0; m < 4; ++m) { if constexpr (FP8) dst##8[m] = cat8(*(const PG8_LAS bf16x8*)(lds + PG8_SA(b, h) + aoff + m * 2048), *(const PG8_LAS bf16x8*)(lds + PG8_SA(b, h) + aoff + m * 2048 + 16)); \
        else { _Pragma("unroll") for (int k = 0; k < 2; ++k) dst[m][k] = *(const PG8_LAS bf16x8*)(lds + PG8_SA(b, h) + aoff + m * 2048 + k * 1024); } } } while (0)
#define PG8_LDB(dst, b, h) do { _Pragma("unroll") for (int n = 0; n < 2; ++n) { if constexpr (FP8) dst##8[n] = cat8(*(const PG8_LAS bf16x8*)(lds + PG8_SB(b, h) + boff + n * 2048), *(const PG8_LAS bf16x8*)(lds + PG8_SB(b, h) + boff + n * 2048 + 16)); \
        else { _Pragma("unroll") for (int k = 0; k < 2; ++k) dst[n][k] = *(const PG8_LAS bf16x8*)(lds + PG8_SB(b, h) + boff + n * 2048 + k * 1024); } } } while (0)
#define PG8_MMA(ai, bj, At, Bt) do { __builtin_amdgcn_s_setprio(1); _Pragma("unroll") for (int m = 0; m < 4; ++m) _Pragma("unroll") for (int n = 0; n < 2; ++n) { \
        if constexpr (FP8) asm volatile("v_mfma_scale_f32_16x16x128_f8f6f4 %0, %1, %2, %0, %3, %4 op_sel_hi:[0,0,0]" : "+v"(acc[ai][bj][m][n]) : "v"(Bt##8[n]), "v"(At##8[m]), "v"(sw_), "v"(sa_)); \
        else { _Pragma("unroll") for (int k = 0; k < 2; ++k) acc[ai][bj][m][n] = __builtin_amdgcn_mfma_f32_16x16x32_bf16(Bt[n][k], At[m][k], acc[ai][bj][m][n], 0, 0, 0); } } \
        __builtin_amdgcn_s_setprio(0); } while (0)
#define PG8_WAIT_V(n) asm volatile("s_waitcnt vmcnt(" #n ")" ::: "memory")
#define PG8_WAIT_L(n) asm volatile("s_waitcnt lgkmcnt(" #n ")" ::: "memory")
#define PG8_BAR __builtin_amdgcn_s_barrier()
#define PG8_SCHED __builtin_amdgcn_sched_barrier(0)
    Unit cur, nxt; int ui = 0;
    if (!S.next(0, cur)) return;
    f32x4 acc[2][2][4][2];
#pragma unroll
    for (int a = 0; a < 2; ++a)
#pragma unroll
        for (int b = 0; b < 2; ++b)
#pragma unroll
            for (int m = 0; m < 4; ++m)
#pragma unroll
                for (int n = 0; n < 2; ++n) acc[a][b][m][n] = (f32x4){0.f, 0.f, 0.f, 0.f};
    const int sw_ = g.sw, sa_ = g.sa;
    bf16x8 At[4][2], B0[2][2], B1[2][2]; i32x8 At8[4], B08[2], B18[2];
    const char* cA = (const char*)g.A + (size_t)cur.pm * tstep; const char* cB = (const char*)g.Bt + (size_t)cur.pn * tstep;
    S.a_ready(cur);
    if constexpr (SP2) {
        PG8_STAGE(PG8_SB(0, 0), cB, voffB); PG8_STAGE(PG8_SB(0, 1), cB + hstep, voffB); PG8_STAGE(PG8_SA(0, 0), cA, voffA); PG8_STAGE(PG8_SA(0, 1), cA + hstep, voffA);
        if (wr == 1) PG8_BAR;
        PG8_WAIT_V(2); PG8_BAR;
        PG8_STAGE(PG8_SB(1, 0), cB + kstep, voffB); PG8_STAGE(PG8_SA(1, 0), cA + kstep, voffA); PG8_STAGE(PG8_SB(1, 1), cB + hstep + kstep, voffB);
        PG8_WAIT_V(6); PG8_BAR;
    } else {
        PG8_STAGE(PG8_SB(0, 0), cB, voffB); PG8_STAGE(PG8_SA(0, 0), cA, voffA); PG8_STAGE(PG8_SB(0, 1), cB + hstep, voffB); PG8_STAGE(PG8_SA(0, 1), cA + hstep, voffA);
        if (wr == 1) PG8_BAR;
        PG8_WAIT_V(4); PG8_BAR;
        PG8_STAGE(PG8_SB(1, 0), cB + kstep, voffB); PG8_STAGE(PG8_SA(1, 0), cA + kstep, voffA); PG8_STAGE(PG8_SB(1, 1), cB + hstep + kstep, voffB);
        PG8_WAIT_V(6); PG8_BAR;
    }
    for (;;) {
        const bool has_next = S.next(ui + 1, nxt);
        const char* nA = has_next ? (const char*)g.A + (size_t)nxt.pm * tstep : cA; const char* nB = has_next ? (const char*)g.Bt + (size_t)nxt.pn * tstep : cB;
        for (int t = 0; t < nt; t += 2) {
            if constexpr (Epi::MID_HOOK && HOOK_ON) { if (t == (nt >> 1)) E.mid(acc, cur, wr, wc, fr, fq); }
            const bool last = (t == nt - 2);
            const char* a1 = cA + (size_t)(t + 1) * kstep;
            const char* a2 = last ? nA : cA + (size_t)(t + 2) * kstep; const char* b2 = last ? nB : cB + (size_t)(t + 2) * kstep;
            const char* a3 = a2 + kstep; const char* b3 = b2 + kstep;
            if (last && has_next) S.a_ready(nxt);
            if constexpr (SP2) {
            PG8_LDB(B0, 0, 0); PG8_LDB(B1, 0, 1); PG8_SCHED; PG8_LDA(At, 0, 0); PG8_STAGE(PG8_SA(1, 1), a1 + hstep, voffA);
            PG8_WAIT_V(8); PG8_WAIT_L(0); PG8_BAR; PG8_MMA(0, 0, At, B0); PG8_MMA(0, 1, At, B1); PG8_BAR; PG8_SCHED;
            PG8_LDA(At, 0, 1); PG8_STAGE(PG8_SB(0, 0), b2, voffB); PG8_STAGE(PG8_SB(0, 1), b2 + hstep, voffB); PG8_STAGE(PG8_SA(0, 0), a2, voffA);
            PG8_WAIT_V(8); PG8_WAIT_L(0); PG8_BAR; PG8_MMA(1, 0, At, B0); PG8_MMA(1, 1, At, B1); PG8_BAR; PG8_SCHED;
            PG8_LDB(B0, 1, 0); PG8_LDB(B1, 1, 1); PG8_SCHED; PG8_LDA(At, 1, 0); PG8_STAGE(PG8_SA(0, 1), a2 + hstep, voffA);
            PG8_WAIT_V(8); PG8_WAIT_L(0); PG8_BAR; PG8_MMA(0, 0, At, B0); PG8_MMA(0, 1, At, B1); PG8_BAR; PG8_SCHED;
            PG8_LDA(At, 1, 1); PG8_STAGE(PG8_SB(1, 0), b3, voffB); PG8_STAGE(PG8_SB(1, 1), b3 + hstep, voffB); PG8_STAGE(PG8_SA(1, 0), a3, voffA);
            PG8_WAIT_V(8); PG8_WAIT_L(0); PG8_BAR; PG8_MMA(1, 0, At, B0); PG8_MMA(1, 1, At, B1); PG8_BAR; PG8_SCHED;
            } else {
            PG8_LDB(B0, 0, 0); PG8_SCHED; PG8_LDA(At, 0, 0); PG8_STAGE(PG8_SA(1, 1), a1 + hstep, voffA);
            PG8_WAIT_L(8); PG8_BAR; PG8_WAIT_L(0); PG8_MMA(0, 0, At, B0); PG8_BAR; PG8_SCHED;
            PG8_LDB(B1, 0, 1); PG8_STAGE(PG8_SB(0, 0), b2, voffB);
            PG8_BAR; PG8_WAIT_L(0); PG8_MMA(0, 1, At, B1); PG8_BAR;
            PG8_LDA(At, 0, 1); PG8_STAGE(PG8_SA(0, 0), a2, voffA);
            PG8_BAR; PG8_WAIT_L(0); PG8_MMA(1, 0, At, B0); PG8_BAR; PG8_SCHED;
            PG8_STAGE(PG8_SB(0, 1), b2 + hstep, voffB);
            PG8_WAIT_V(6); PG8_BAR; PG8_MMA(1, 1, At, B1); PG8_BAR;
            PG8_LDB(B0, 1, 0); PG8_SCHED; PG8_LDA(At, 1, 0); PG8_STAGE(PG8_SA(0, 1), a2 + hstep, voffA);
            PG8_WAIT_L(8); PG8_BAR; PG8_WAIT_L(0); PG8_MMA(0, 0, At, B0); PG8_BAR; PG8_SCHED;
            PG8_LDB(B1, 1, 1); PG8_STAGE(PG8_SB(1, 0), b3, voffB);
            PG8_BAR; PG8_WAIT_L(0); PG8_MMA(0, 1, At, B1); PG8_BAR;
            PG8_LDA(At, 1, 1); PG8_STAGE(PG8_SA(1, 0), a3, voffA);
            PG8_BAR; PG8_WAIT_L(0); PG8_MMA(1, 0, At, B0); PG8_BAR; PG8_SCHED;
            PG8_STAGE(PG8_SB(1, 1), b3 + hstep, voffB);
            PG8_WAIT_V(6); PG8_BAR; PG8_MMA(1, 1, At, B1); PG8_BAR;
            }
        }
        if constexpr (ALIGN_EPI) { if (wr == 0) PG8_BAR; }
        if constexpr (FP8) asm volatile("s_nop 15\n\ts_nop 15" ::: "memory");
        if constexpr (!Epi::AFTER_DRAIN) { E(acc, cur, wr, wc, fr, fq); S.done(cur); }
        if (!has_next) break;
#pragma unroll
        for (int a = 0; a < 2; ++a)
#pragma unroll
            for (int b = 0; b < 2; ++b)
#pragma unroll
                for (int m = 0; m < 4; ++m)
#pragma unroll
                    for (int n = 0; n < 2; ++n) acc[a][b][m][n] = (f32x4){0.f, 0.f, 0.f, 0.f};
        cur = nxt; cA = nA; cB = nB; ++ui;
        if constexpr (ALIGN_EPI) { if (wr == 1) PG8_BAR; }
    }
    PG8_WAIT_V(0);
    if constexpr (!ALIGN_EPI) { if (wr == 0) PG8_BAR; }
    PG8_BAR;
    if constexpr (Epi::AFTER_DRAIN) { if constexpr (FP8) asm volatile("s_nop 15\n\ts_nop 15" ::: "memory"); E.fused(acc, cur, wr, wc, fr, fq, lds, wid, lane); S.done(cur); }
#undef PG8_SA
#undef PG8_SB
#undef PG8_STAGE
#undef PG8_LDA
#undef PG8_LDB
#undef PG8_MMA
#undef PG8_WAIT_V
#undef PG8_WAIT_L
#undef PG8_BAR
#undef PG8_SCHED
}
}

constexpr int NWAVES = 8;
constexpr size_t MiB = 1u << 20;
constexpr size_t WS_CTL = 0, CTL_ZERO_BYTES = 1 * MiB;
constexpr size_t WS_ADA = 1 * MiB;
constexpr size_t WS_RAGG = 2 * MiB;
constexpr size_t WS_MIX = 288 * MiB; constexpr size_t WS_T16 = WS_MIX;
constexpr size_t WS_TOK = 3 * MiB;
constexpr size_t WS_WL = 4 * MiB, WL_STRIDE = 18 * MiB;
constexpr size_t WL_WIN = 0, WL_WB = 11 * MiB, WL_WO = 15 * MiB, WL_WRA = 17 * MiB, WL_WRX = 17 * MiB + 256 * 1024;
constexpr size_t WS_WD = 76 * MiB, WD_STRIDE = 18 * MiB;
constexpr size_t WD_FIN = 0, WD_FOUT = 12 * MiB;
constexpr size_t WS_WM = 112 * MiB, WM_STRIDE = 72 * MiB;
constexpr size_t WM_MIN = 0, WM_MOUT = 48 * MiB;
constexpr size_t WS_XN = 256 * MiB;
constexpr size_t WS_R = 352 * MiB;
constexpr size_t WS_XR = WS_R, WS_GG = WS_R + 32 * MiB, WS_Q = WS_R + 64 * MiB, WS_KB = WS_R + 96 * MiB, WS_VB = WS_R + 104 * MiB, WS_GT = WS_R + 112 * MiB;
constexpr size_t WS_RO = WS_R + 176 * MiB, WS_AO = WS_R + 208 * MiB, WS_MGP = WS_R + 240 * MiB, WS_MG = WS_R + 304 * MiB;
constexpr size_t WS_PS = WS_MGP;
constexpr size_t WS_XC = WS_MG;
constexpr size_t WS_ACT = WS_R;
constexpr size_t WS_AP = WS_R;
constexpr size_t WS_YP = WS_R;
constexpr size_t WS_ACTP = WS_R + 256 * MiB;
constexpr size_t WS_XB = WS_ACTP + 102 * MiB;
constexpr size_t WS_XS = WS_XB + 32 * MiB;
constexpr size_t WS_END = WS_XS + 2 * MiB;
constexpr int MAXPANELS = 136;

constexpr int CW_CNT = 64;
constexpr int CW_BAR = 4096;
constexpr int CW_SEAM = 16384, SEAM_BANK = 8192;
static_assert((CW_SEAM + 8 * SEAM_BANK) * 4 <= (int)CTL_ZERO_BYTES, "panel counters inside the memset region");

constexpr int RING_OFF = 0, RING_BYTES = 139264;
constexpr int LDSCTL_OFF = RING_BYTES, MISC_OFF = LDSCTL_OFF + 320;
constexpr int LDS_BYTES = 147456;

#define XB_TMO      128
#define XB_XCNT(j)  (256  + 64 * (j))
#define XB_XSUB(j)  (1280 + 64 * (j))
#define XB_XGEN(j)  (2304 + 64 * (j))
#define XB_TOP      3328
#define XB_TOPGEN   3392
#define XCD_BAR_WORDS 3456
#define XB_SPIN_CAP (1u << 18)

__device__ __forceinline__ unsigned xb_ld(unsigned* p)              { return __hip_atomic_load(p, __ATOMIC_RELAXED, __HIP_MEMORY_SCOPE_AGENT); }
__device__ __forceinline__ unsigned xb_add(unsigned* p, unsigned v) { return __hip_atomic_fetch_add(p, v, __ATOMIC_RELAXED, __HIP_MEMORY_SCOPE_AGENT); }
__device__ __forceinline__ unsigned xb_xcc_id() { return (unsigned)__builtin_amdgcn_s_getreg((3 << 11) | 20) & 0xFu; }
#define XB_SPIN(cond, bar) do { unsigned _sp = 0; while (cond) { __builtin_amdgcn_s_sleep(1); \
    if ((++_sp & 255u) == 0u) { if (xb_ld(&(bar)[XB_TMO])) break; if (_sp > XB_SPIN_CAP) { atomicAdd(&(bar)[XB_TMO], 1u); break; } } } } while (0)

struct XcdBarrier {
    unsigned* bar; unsigned x;
    volatile LAS unsigned* st;
};

__device__ __forceinline__ XcdBarrier xcd_barrier_post(unsigned* bar, volatile LAS unsigned* st) {
    XcdBarrier b; b.bar = bar; b.x = xb_xcc_id(); b.st = st;
    if (threadIdx.x == 0) (void)xb_add(&bar[XB_XCNT(b.x)], 1u);
    return b;
}
__device__ __forceinline__ void xcd_barrier_complete(unsigned* bar, unsigned x, unsigned& nloc, unsigned& nx) {
    const unsigned G = gridDim.x * gridDim.y * gridDim.z;
    unsigned sum, cnt, mine, sp = 0u;
    for (;;) {
        sum = 0u; cnt = 0u; mine = 0u;
#pragma unroll
        for (unsigned j = 0; j < 16; ++j) { const unsigned c = xb_ld(&bar[XB_XCNT(j)]); sum += c; cnt += (c > 0u) ? 1u : 0u; mine = (j == x) ? c : mine; }
        if (sum == G) break;
        __builtin_amdgcn_s_sleep(1);
        if ((++sp & 255u) == 0u) { if (xb_ld(&bar[XB_TMO])) break; if (sp > XB_SPIN_CAP) { atomicAdd(&bar[XB_TMO], 1u); break; } }
    }
    nloc = mine > 0u ? mine : 1u; nx = cnt > 0u ? cnt : 1u;
}

__device__ __forceinline__ void xcd_barrier(const XcdBarrier& b) {
    asm volatile("s_waitcnt vmcnt(0)" ::: "memory");
    __syncthreads();
    if (threadIdx.x == 0) {
        unsigned* bar = b.bar;
        __builtin_amdgcn_s_waitcnt(0);
        unsigned nloc = b.st[0], nx = b.st[1];
        if (nloc == 0u) { xcd_barrier_complete(bar, b.x, nloc, nx); b.st[0] = nloc; b.st[1] = nx; }
        const unsigned old = xb_add(&bar[XB_XSUB(b.x)], 1u);
        const unsigned gen = old / nloc;
        if (old + 1u == (gen + 1u) * nloc) {
            __builtin_amdgcn_fence(__ATOMIC_RELEASE, "agent");
            asm volatile("s_waitcnt vmcnt(0)" ::: "memory");
            const unsigned og = xb_add(&bar[XB_TOP], 1u);
            const unsigned tg = og / nx;
            if (og + 1u == (tg + 1u) * nx) xb_add(&bar[XB_TOPGEN], 1u);
            else XB_SPIN(xb_ld(&bar[XB_TOPGEN]) == tg, bar);
            __builtin_amdgcn_fence(__ATOMIC_ACQUIRE, "agent");
            xb_add(&bar[XB_XGEN(b.x)], 1u);
            asm volatile("s_waitcnt vmcnt(0)" ::: "memory");
        } else {
            XB_SPIN(xb_ld(&bar[XB_XGEN(b.x)]) == gen, bar);
            __builtin_amdgcn_fence(__ATOMIC_ACQUIRE, "agent");
            asm volatile("s_waitcnt vmcnt(0)" ::: "memory");
        }
    }
    __syncthreads();
}
struct Args { const float* in[24]; float* out; unsigned char* ws; int ph_lo, ph_hi; };
typedef const __attribute__((address_space(4))) unsigned char* kargp_t;
DI kargp_t kargs() { kargp_t p = (kargp_t)__builtin_amdgcn_kernarg_segment_ptr(); asm volatile("" : "+s"(p)); return p; }
DI const float* karg_in(kargp_t p, int i) { return *(const float* const __attribute__((address_space(4)))*)(p + 8 * i); }
DI float* karg_out(kargp_t p) { return *(float* const __attribute__((address_space(4)))*)(p + 192); }
DI unsigned char* karg_ws(kargp_t p) { return *(unsigned char* const __attribute__((address_space(4)))*)(p + 200); }
static_assert(sizeof(Args) == 216, "kernarg offsets");

DI void p0_transpose_item(const float* W, int K, int N, bf16* WT, int mode, int H, LAS float* scr, int item, int lane, int ldk = 0, float mult = 1.0f) {
    if (ldk == 0) ldk = K;
    const int nblk = N / 32, kb = item / nblk, nb = item % nblk, k0 = 64 * kb, n0 = 32 * nb;
    int dr0 = n0;
    if (mode == 1) { if (n0 < H) dr0 = (n0 >> 7) * 256 + (n0 & 127); else { const int n1 = n0 - H; dr0 = (n1 >> 7) * 256 + 128 + (n1 & 127); } }
#pragma unroll 8
    for (int i = 0; i < 32; ++i) { const int kk = 2 * i + (lane >> 5); scr[kk * 33 + (lane & 31)] = __builtin_nontemporal_load(W + (size_t)(k0 + kk) * N + n0 + (lane & 31)) * mult; }
    LDS_WAIT(); asm volatile("" ::: "memory");
    const int c = lane & 7;
#pragma unroll
    for (int j = 0; j < 4; ++j) { const int n = (lane >> 3) + 8 * j; const LAS float* s = scr + (8 * c) * 33 + n;
        u32x4 o; o.x = pk2(s[0 * 33], s[1 * 33]); o.y = pk2(s[2 * 33], s[3 * 33]); o.z = pk2(s[4 * 33], s[5 * 33]); o.w = pk2(s[6 * 33], s[7 * 33]);
        *(GAS u32x4*)(WT + (size_t)(dr0 + n) * ldk + k0 + 8 * c) = o; }
    LDS_WAIT(); asm volatile("" ::: "memory");
}
DI void p0_transpose_item8(const float* W, int K, int N, unsigned char* WT, int mode, int H, float mult, LAS float* scr, int item, int lane) {
    const int nblk = N / 32, kb = item / nblk, nb = item % nblk, k0 = 64 * kb, n0 = 32 * nb;
    int dr0 = n0;
    if (mode == 1) { if (n0 < H) dr0 = (n0 >> 7) * 256 + (n0 & 127); else { const int n1 = n0 - H; dr0 = (n1 >> 7) * 256 + 128 + (n1 & 127); } }
#pragma unroll 8
    for (int i = 0; i < 32; ++i) { const int kk = 2 * i + (lane >> 5); scr[kk * 33 + (lane & 31)] = __builtin_nontemporal_load(W + (size_t)(k0 + kk) * N + n0 + (lane & 31)) * mult; }
    LDS_WAIT(); asm volatile("" ::: "memory");
#pragma unroll
    for (int j = 0; j < 2; ++j) { const int idx = lane + 64 * j, n = idx >> 2, c = idx & 3; const LAS float* s = scr + (16 * c) * 33 + n;
        u32x4 o;
        o.x = pg8::pk4fp8((f32x4){s[0 * 33], s[1 * 33], s[2 * 33], s[3 * 33]}); o.y = pg8::pk4fp8((f32x4){s[4 * 33], s[5 * 33], s[6 * 33], s[7 * 33]});
        o.z = pg8::pk4fp8((f32x4){s[8 * 33], s[9 * 33], s[10 * 33], s[11 * 33]}); o.w = pg8::pk4fp8((f32x4){s[12 * 33], s[13 * 33], s[14 * 33], s[15 * 33]});
        *(GAS u32x4*)(WT + (size_t)(dr0 + n) * K + k0 + 16 * c) = o; }
    LDS_WAIT(); asm volatile("" ::: "memory");
}
constexpr int CI_WIN = 16 * 176, CI_SQ = 16 * 32, CI_RG = 64, CI_LAYER = CI_WIN + 3 * CI_SQ + 2 * CI_RG;
constexpr int CI_FIN = 16 * 192, CI_FOUT = 48 * 32, CI_DENSE = CI_FIN + CI_FOUT;
constexpr int CI_MIN = 16 * 96, CI_MOUT = 24 * 32, CI_EXP = CI_MIN + CI_MOUT, CI_MOE = 8 * CI_EXP;
constexpr int CI_TOTAL = 4 * CI_LAYER + 2 * CI_DENSE + 2 * CI_MOE;
DI void p0_convert_item(kargp_t kp, int it, LAS float* scr, int lane) {
    unsigned char* ws = karg_ws(kp);
    if (it < 4 * CI_LAYER) {
        const int l = it / CI_LAYER; int r = it % CI_LAYER; unsigned char* wl = ws + WS_WL + (size_t)l * WL_STRIDE;
        if (r < CI_WIN) { p0_transpose_item(karg_in(kp, 8) + (size_t)l * 1024 * D_IN, 1024, D_IN, (bf16*)(wl + WL_WIN), 0, 0, scr, r, lane); return; } r -= CI_WIN;
        if (r < 2 * CI_SQ) { const int br = r / CI_SQ; p0_transpose_item(karg_in(kp, 17) + (size_t)(l * 2 + br) * 1024 * 1024, 1024, 1024, (bf16*)(wl + WL_WB) + (size_t)br * 1024, 0, 0, scr, r % CI_SQ, lane, 2048); return; }   r -= 2 * CI_SQ;
        if (r < CI_SQ) { p0_transpose_item(karg_in(kp, 18) + (size_t)l * 1024 * 1024, 1024, 1024, (bf16*)(wl + WL_WO), 0, 0, scr, r, lane); return; } r -= CI_SQ;
        if (r < CI_RG) { const int nb = r >> 3; p0_transpose_item(karg_in(kp, 11) + (size_t)(l * 8 + nb) * 16384, 128, 128, (bf16*)(wl + WL_WRA) + nb * 16384, 0, 0, scr, r & 7, lane, 0, -LOG2E); return; }     r -= CI_RG;
        { const int nb = r >> 3; p0_transpose_item(karg_in(kp, 13) + (size_t)(l * 8 + nb) * 16384, 128, 128, (bf16*)(wl + WL_WRX) + nb * 16384, 0, 0, scr, r & 7, lane, 0, -LOG2E); return; }
    }
    it -= 4 * CI_LAYER;
    if (it < 2 * CI_DENSE) {
        const int j = it / CI_DENSE; int r = it % CI_DENSE; unsigned char* wd = ws + WS_WD + (size_t)j * WD_STRIDE;
        const bool f8 = (FP8_LAYERS >> (2 * j)) & 1u;
        if (r < CI_FIN) { if (f8) p0_transpose_item8(karg_in(kp, 19) + (size_t)j * 1024 * 6144, 1024, 6144, wd + WD_FIN, 1, 3072, 32.0f, scr, r, lane); else p0_transpose_item(karg_in(kp, 19) + (size_t)j * 1024 * 6144, 1024, 6144, (bf16*)(wd + WD_FIN), 1, 3072, scr, r, lane); return; } r -= CI_FIN;
        if (f8) p0_transpose_item8(karg_in(kp, 20) + (size_t)j * 3072 * 1024, 3072, 1024, wd + WD_FOUT, 0, 0, 64.0f, scr, r, lane); else p0_transpose_item(karg_in(kp, 20) + (size_t)j * 3072 * 1024, 3072, 1024, (bf16*)(wd + WD_FOUT), 0, 0, scr, r, lane); return;
    }
    it -= 2 * CI_DENSE;
    {
        const int j = it / CI_MOE; int r = it % CI_MOE; const int e = r / CI_EXP; r %= CI_EXP; unsigned char* wm = ws + WS_WM + (size_t)j * WM_STRIDE;
        const bool f8 = (FP8_LAYERS >> (2 * j + 1)) & 1u;
        if (r < CI_MIN) { if (f8) p0_transpose_item8(karg_in(kp, 22) + (size_t)(j * 8 + e) * 1024 * 3072, 1024, 3072, wm + WM_MIN + (size_t)e * 3072 * 1024, 1, 1536, 32.0f, scr, r, lane); else p0_transpose_item(karg_in(kp, 22) + (size_t)(j * 8 + e) * 1024 * 3072, 1024, 3072, (bf16*)(wm + WM_MIN) + (size_t)e * 3072 * 1024, 1, 1536, scr, r, lane); return; } r -= CI_MIN;
        if (f8) p0_transpose_item8(karg_in(kp, 23) + (size_t)(j * 8 + e) * 1536 * 1024, 1536, 1024, wm + WM_MOUT + (size_t)e * 1024 * 1536, 0, 0, 32.0f, scr, r, lane); else p0_transpose_item(karg_in(kp, 23) + (size_t)(j * 8 + e) * 1536 * 1024, 1536, 1024, (bf16*)(wm + WM_MOUT) + (size_t)e * 1024 * 1536, 0, 0, scr, r, lane);
    }
}
DI void p0_prologue(LAS unsigned char* lds, int tid, int wave, int lane) {
    const kargp_t kp = kargs();
    LAS float* cact = (LAS float*)lds; LAS float* red = (LAS float*)(lds + 8192);
    float* ADA = (float*)(karg_ws(kp) + WS_ADA);
    for (int i = tid; i < 2 * D; i += NWAVES * 64) { const float c = karg_in(kp, 1)[i]; cact[i] = c / (1.0f + expf(-c)); }
    __syncthreads();
    const int col = tid & 31, ks = tid >> 5;
    for (int it = blockIdx.x; it < 4 * 192; it += gridDim.x) {
        const int l = it / 192, n0 = (it % 192) * 32;
        const float* w = karg_in(kp, 2) + (size_t)l * 1024 * 6144 + (size_t)(ks * 64) * 6144 + n0 + col;
        float s0 = 0.f, s1 = 0.f;
#pragma unroll 32
        for (int k = 0; k < 64; ++k) { const float wv = __builtin_nontemporal_load(w + (size_t)k * 6144); s0 += cact[ks * 64 + k] * wv; s1 += cact[1024 + ks * 64 + k] * wv; }
        red[(ks * 2 + 0) * 32 + col] = s0; red[(ks * 2 + 1) * 32 + col] = s1;
        __syncthreads();
        if (tid < 64) { const int b = tid >> 5, c2 = tid & 31; float s = karg_in(kp, 3)[l * 6144 + n0 + c2];
#pragma unroll
            for (int k2 = 0; k2 < 16; ++k2) s += red[(k2 * 2 + b) * 32 + c2];
            ADA[(l * 2 + b) * 6144 + n0 + c2] = s; }
        __syncthreads();
    }
    __syncthreads();
    LAS float* scr = (LAS float*)(lds + wave * 16384);
    const int gw = blockIdx.x * NWAVES + wave, NGW = gridDim.x * NWAVES;
    for (int it = gw; it < CI_TOTAL; it += NGW) p0_convert_item(kp, it, scr, lane);
}

DI int vcu_index() { const int G = (int)gridDim.x, bx = (int)blockIdx.x; return (G % 8 == 0) ? (bx % 8) * (G / 8) + bx / 8 : bx; }
DI float row_ss(const f32x4 (&v)[4]) { float s = 0.f;
#pragma unroll
    for (int j = 0; j < 4; ++j) s += (v[j].x * v[j].x + v[j].y * v[j].y) + (v[j].z * v[j].z + v[j].w * v[j].w);
    return wave_sum(s); }
DI void ld_row(const float* p, int lane, f32x4 (&v)[4]) {
#pragma unroll
    for (int j = 0; j < 4; ++j) v[j] = *(const f32x4*)(p + 256 * j + 4 * lane); }
DI void st_row(float* p, int lane, const f32x4 (&v)[4]) {
#pragma unroll
    for (int j = 0; j < 4; ++j) *(f32x4*)(p + 256 * j + 4 * lane) = v[j]; }
DI void st_row_f8(unsigned char* p, int lane, const f32x4 (&v)[4]) {
#pragma unroll
    for (int j = 0; j < 4; ++j) *(unsigned*)(p + 256 * j + 4 * lane) = pg8::pk4fp8(v[j]); }
DI void st_row_bf(bf16* p, int lane, const f32x4 (&v)[4]) {
#pragma unroll
    for (int j = 0; j < 4; ++j) { u32x2 w; w.x = pk2(v[j].x, v[j].y); w.y = pk2(v[j].z, v[j].w); *(u32x2*)(p + 256 * j + 4 * lane) = w; } }
DI void ld_row_bfraw(const bf16* p, int lane, u32x2 (&w)[4]) {
#pragma unroll
    for (int j = 0; j < 4; ++j) w[j] = *(const u32x2*)(p + 256 * j + 4 * lane); }
DI void cvt_row_bf(const u32x2 (&w)[4], f32x4 (&v)[4]) {
#pragma unroll
    for (int j = 0; j < 4; ++j) v[j] = (f32x4){bflo(w[j].x), bfhi(w[j].x), bflo(w[j].y), bfhi(w[j].y)}; }
DI void ld_row_bf(const bf16* p, int lane, f32x4 (&v)[4]) {
#pragma unroll
    for (int j = 0; j < 4; ++j) { const u32x2 w = *(const u32x2*)(p + 256 * j + 4 * lane); v[j] = (f32x4){bflo(w.x), bfhi(w.x), bflo(w.y), bfhi(w.y)}; } }

DI void thin_start(int wave, int lane) {
    const kargp_t kp = kargs(); unsigned char* ws = karg_ws(kp);
    const float* ADA = (const float*)(ws + WS_ADA); bf16* XN = (bf16*)(ws + WS_XN);
    const int NGW = gridDim.x * NWAVES, gw = vcu_index() * NWAVES + wave;
    for (int base = gw * 8; base < M; base += NGW * 8) {
        const int b = base >> 13; const float* ada = ADA + (size_t)b * 6144;
        f32x4 g[4], sc[4], sh[4]; ld_row(karg_in(kp, 4), lane, g); ld_row(ada + 1024, lane, sc); ld_row(ada, lane, sh);
#pragma unroll
        for (int j = 0; j < 4; ++j) sc[j] = g[j] * (sc[j] + 1.0f);
        const float* xin = karg_in(kp, 0);
        f32x4 xn[4]; ld_row(xin + (size_t)base * D, lane, xn);
#pragma unroll
        for (int i = 0; i < 8; ++i) { const size_t m = (size_t)(base + i);
            f32x4 x[4];
#pragma unroll
            for (int j = 0; j < 4; ++j) x[j] = xn[j];
            if (i < 7) ld_row(xin + (m + 1) * D, lane, xn);
            const float rs = rsqrtf(row_ss(x) * (1.0f / D) + EPS);
#pragma unroll
            for (int j = 0; j < 4; ++j) x[j] = x[j] * rs * sc[j] + sh[j];
            st_row_bf(XN + m * D, lane, x); }
    }
}
DI void thin_mid_dense(int l, int wave, int lane) {
    const kargp_t kp = kargs(); unsigned char* ws = karg_ws(kp); bf16* XB = (bf16*)(ws + WS_XB);
    const float* ADA = (const float*)(ws + WS_ADA); bf16* XN = (bf16*)(ws + WS_XN); const bf16* MIX = (const bf16*)(ws + WS_MIX);
    const float* xin = karg_in(kp, 0); const bool l0 = (l == 0);
    const int NGW = gridDim.x * NWAVES, gw = vcu_index() * NWAVES + wave;
    for (int base = gw * 8; base < M; base += NGW * 8) {
        const int b = base >> 13; const float* ada = ADA + (size_t)(l * 2 + b) * 6144;
        f32x4 pg[4], fg[4], fs[4], t[4];
        ld_row(karg_in(kp, 5) + l * D, lane, pg); ld_row(ada + 2048, lane, t);
#pragma unroll
        for (int j = 0; j < 4; ++j) pg[j] = pg[j] * t[j];
        ld_row(karg_in(kp, 6) + l * D, lane, fg); ld_row(ada + 4096, lane, t); ld_row(ada + 3072, lane, fs);
#pragma unroll
        for (int j = 0; j < 4; ++j) fg[j] = fg[j] * (t[j] + 1.0f);
        u32x2 yn[4], xr[4]; f32x4 xn[4]; ld_row_bfraw(MIX + (size_t)base * D, lane, yn); if (l0) ld_row(xin + (size_t)base * D, lane, xn); else ld_row_bfraw(XB + (size_t)base * D, lane, xr);
#pragma unroll
        for (int i = 0; i < 8; ++i) { const size_t m = (size_t)(base + i);
            f32x4 y[4], x[4]; cvt_row_bf(yn, y);
            if (l0) {
#pragma unroll
                for (int j = 0; j < 4; ++j) x[j] = xn[j];
            } else cvt_row_bf(xr, x);
            if (i < 7) { ld_row_bfraw(MIX + (m + 1) * D, lane, yn); if (l0) ld_row(xin + (m + 1) * D, lane, xn); else ld_row_bfraw(XB + (m + 1) * D, lane, xr); }
            const float rs = rsqrtf(row_ss(y) * (1.0f / D) + EPS);
#pragma unroll
            for (int j = 0; j < 4; ++j) x[j] = x[j] + pg[j] * (y[j] * rs);
            st_row_bf(XB + m * D, lane, x);
            const float rs2 = rsqrtf(row_ss(x) * (1.0f / D) + EPS);
#pragma unroll
            for (int j = 0; j < 4; ++j) x[j] = x[j] * rs2 * fg[j] + fs[j];
            if ((FP8_LAYERS >> l) & 1u) st_row_f8((unsigned char*)XN + m * D, lane, x); else st_row_bf(XN + m * D, lane, x); }
    }
}
DI void thin_mid_moe(LAS unsigned char* lds, int l, int tid, int wave, int lane) {
    const kargp_t kp = kargs(); unsigned char* ws = karg_ws(kp); bf16* XB = (bf16*)(ws + WS_XB);
    const float* ADA = (const float*)(ws + WS_ADA); const bf16* MIX = (const bf16*)(ws + WS_MIX);
    unsigned char* AP = ws + WS_AP; int* TOK = (int*)(ws + WS_TOK);
    unsigned* cntg = (unsigned*)(ws + WS_CTL) + CW_CNT + 64 * (l >> 1);
    const float* wr = karg_in(kp, 21) + (size_t)(l >> 1) * D * NE;
    LAS float* RT = (LAS float*)lds;
    LAS unsigned* cntL = (LAS unsigned*)(lds + 32768);
    for (int i = tid; i < D * NE; i += NWAVES * 64) RT[i] = wr[i];
    for (int rb = vcu_index(); rb < M / 64; rb += gridDim.x) {
        if (tid < 16) cntL[tid] = 0u;
        __syncthreads();
        const int base = rb * 64 + wave * 8; const int b = base >> 13; const float* ada = ADA + (size_t)(l * 2 + b) * 6144;
        f32x4 pg[4], fg[4], fs[4], t[4];
        ld_row(karg_in(kp, 5) + l * D, lane, pg); ld_row(ada + 2048, lane, t);
#pragma unroll
        for (int j = 0; j < 4; ++j) pg[j] = pg[j] * t[j];
        ld_row(karg_in(kp, 6) + l * D, lane, fg); ld_row(ada + 4096, lane, t); ld_row(ada + 3072, lane, fs);
#pragma unroll
        for (int j = 0; j < 4; ++j) fg[j] = fg[j] * (t[j] + 1.0f);
        int e0s[8], e1s[8], lp0[8], lp1[8]; float w0s[8], rs2s[8];
        u32x2 yn[4], xr[4]; ld_row_bfraw(MIX + (size_t)base * D, lane, yn); ld_row_bfraw(XB + (size_t)base * D, lane, xr);
#pragma unroll
        for (int i = 0; i < 8; ++i) { const size_t m = (size_t)(base + i);
            f32x4 y[4], x[4]; cvt_row_bf(yn, y);
            cvt_row_bf(xr, x);
            if (i < 7) { ld_row_bfraw(MIX + (m + 1) * D, lane, yn); ld_row_bfraw(XB + (m + 1) * D, lane, xr); }
            const float rs = rsqrtf(row_ss(y) * (1.0f / D) + EPS);
#pragma unroll
            for (int j = 0; j < 4; ++j) x[j] = x[j] + pg[j] * (y[j] * rs);
            st_row_bf(XB + m * D, lane, x);
            const float rs2 = rsqrtf(row_ss(x) * (1.0f / D) + EPS);
            float lg[8];
#pragma unroll
            for (int e = 0; e < 8; ++e) lg[e] = 0.f;
#pragma unroll
            for (int j = 0; j < 4; ++j) { x[j] = x[j] * rs2 * fg[j] + fs[j];
#pragma unroll
                for (int q = 0; q < 4; ++q) { const LAS f32x4* tr = (const LAS f32x4*)(RT + (256 * j + 4 * lane + q) * 8); const f32x4 t0 = tr[0], t1 = tr[1]; const float hv = x[j][q];
                    lg[0] += hv * t0.x; lg[1] += hv * t0.y; lg[2] += hv * t0.z; lg[3] += hv * t0.w; lg[4] += hv * t1.x; lg[5] += hv * t1.y; lg[6] += hv * t1.z; lg[7] += hv * t1.w; } }
#pragma unroll
            for (int e = 0; e < 8; ++e) lg[e] = wave_sum(lg[e]);
            int e0 = 0; float v0 = lg[0];
#pragma unroll
            for (int e = 1; e < 8; ++e) if (lg[e] > v0) { v0 = lg[e]; e0 = e; }
            int e1 = (e0 == 0) ? 1 : 0; float v1 = -INFINITY;
#pragma unroll
            for (int e = 0; e < 8; ++e) if (e != e0 && lg[e] > v1) { v1 = lg[e]; e1 = e; }
            e0 = __builtin_amdgcn_readfirstlane(e0); e1 = __builtin_amdgcn_readfirstlane(e1);
            const float w0 = 1.0f / (1.0f + expf(v1 - v0));
            unsigned q0 = 0u, q1 = 0u;
            if (lane == 0) { q0 = __hip_atomic_fetch_add(cntL + e0, 1u, __ATOMIC_RELAXED, __HIP_MEMORY_SCOPE_WORKGROUP); q1 = __hip_atomic_fetch_add(cntL + e1, 1u, __ATOMIC_RELAXED, __HIP_MEMORY_SCOPE_WORKGROUP); }
            e0s[i] = e0; e1s[i] = e1; lp0[i] = __builtin_amdgcn_readfirstlane((int)q0); lp1[i] = __builtin_amdgcn_readfirstlane((int)q1); w0s[i] = w0; rs2s[i] = rs2;
        }
        __syncthreads();
        if (tid < 8) cntL[8 + tid] = __hip_atomic_fetch_add(cntg + tid, cntL[tid], RLX_AGENT);
        __syncthreads();
#pragma unroll
        for (int i = 0; i < 8; ++i) { const size_t m = (size_t)(base + i);
            const int p0 = (int)cntL[8 + e0s[i]] + lp0[i], p1 = (int)cntL[8 + e1s[i]] + lp1[i];
            const int esz = ((FP8_LAYERS >> l) & 1u) ? 1 : 2; unsigned char* r0 = AP + ((size_t)e0s[i] * ECAP + p0) * D * esz; unsigned char* r1 = AP + ((size_t)e1s[i] * ECAP + p1) * D * esz;
            f32x4 x[4]; ld_row_bf(XB + m * D, lane, x);
#pragma unroll
            for (int j = 0; j < 4; ++j) { x[j] = x[j] * rs2s[i] * fg[j] + fs[j];
                if (esz == 1) { const unsigned hpk = pg8::pk4fp8(x[j]); *(unsigned*)(r0 + 256 * j + 4 * lane) = hpk; *(unsigned*)(r1 + 256 * j + 4 * lane) = hpk; }
                else { u32x2 hpk; hpk.x = pk2(x[j].x, x[j].y); hpk.y = pk2(x[j].z, x[j].w); *(u32x2*)(r0 + 512 * j + 8 * lane) = hpk; *(u32x2*)(r1 + 512 * j + 8 * lane) = hpk; } }
            if (lane == 0) { int4 ti; ti.x = e0s[i] | (e1s[i] << 8); ti.y = p0; ti.z = p1; ti.w = __float_as_int(w0s[i]); *(int4*)(TOK + 4 * m) = ti; }
        }
        __syncthreads();
    }
}
DI void thin_end(int l, int wave, int lane) {
    const kargp_t kp = kargs(); unsigned char* ws = karg_ws(kp); float* outp = karg_out(kp); bf16* XB = (bf16*)(ws + WS_XB);
    const float* ADA = (const float*)(ws + WS_ADA); bf16* XN = (bf16*)(ws + WS_XN); const bf16* MIX = (const bf16*)(ws + WS_MIX);
    const bf16* YP = (const bf16*)(ws + WS_YP); const int* TOK = (const int*)(ws + WS_TOK);
    const bool moe = (l & 1) != 0; const bool last = (l == DEPTH - 1);
    int pp[8];
    { const unsigned* cntg = (const unsigned*)(ws + WS_CTL) + CW_CNT + 64 * (l >> 1); int acc = 0;
#pragma unroll
      for (int e = 0; e < 8; ++e) { pp[e] = acc; const unsigned n = moe ? (unsigned)__builtin_amdgcn_readfirstlane((int)__hip_atomic_load(cntg + e, RLX_AGENT)) : 0u; acc += (int)((n + 255u) >> 8); } }
    const int NGW = gridDim.x * NWAVES, gw = vcu_index() * NWAVES + wave;
    for (int base = gw * 8; base < M; base += NGW * 8) {
        const int b = base >> 13; const float* ada = ADA + (size_t)(l * 2 + b) * 6144; const float* adan = ADA + (size_t)((last ? l : l + 1) * 2 + b) * 6144;
        f32x4 pg[4], ng[4], ns[4], t[4];
        ld_row(karg_in(kp, 7) + l * D, lane, pg); ld_row(ada + 5120, lane, t);
#pragma unroll
        for (int j = 0; j < 4; ++j) pg[j] = pg[j] * t[j];
        ld_row(karg_in(kp, 4) + (last ? l : l + 1) * D, lane, ng); ld_row(adan + 1024, lane, t); ld_row(adan, lane, ns);
#pragma unroll
        for (int j = 0; j < 4; ++j) ng[j] = ng[j] * (t[j] + 1.0f);
        u32x2 yn[4], zn[4], xr[4]; float w0n = 1.0f;
#define TE_LOAD(mm) do { if (moe) { const int4 ti = *(const int4*)(TOK + 4 * (mm)); const int e0 = ti.x & 255, e1 = (ti.x >> 8) & 255; int b0 = 0, b1 = 0; \
                _Pragma("unroll") for (int e = 1; e < 8; ++e) { if (e0 == e) b0 = pp[e]; if (e1 == e) b1 = pp[e]; } \
                w0n = __int_as_float(ti.w); ld_row_bfraw(YP + ((size_t)b0 * 256 + ti.y) * D, lane, yn); ld_row_bfraw(YP + ((size_t)b1 * 256 + ti.z) * D, lane, zn); } \
            else ld_row_bfraw(MIX + (mm) * D, lane, yn); \
            ld_row_bfraw(XB + (mm) * D, lane, xr); } while (0)
        TE_LOAD((size_t)base);
#pragma unroll
        for (int i = 0; i < 8; ++i) { const size_t m = (size_t)(base + i);
            f32x4 y[4], x[4]; cvt_row_bf(yn, y);
            if (moe) { f32x4 y1[4]; cvt_row_bf(zn, y1); const float w0 = w0n, w1 = 1.0f - w0n;
#pragma unroll
                for (int j = 0; j < 4; ++j) y[j] = y[j] * w0 + y1[j] * w1; }
            cvt_row_bf(xr, x);
            if (i < 7) TE_LOAD(m + 1);
            const float rs = rsqrtf(row_ss(y) * (1.0f / D) + EPS);
#pragma unroll
            for (int j = 0; j < 4; ++j) x[j] = x[j] + pg[j] * (y[j] * rs);
            if (last) st_row(outp + m * D, lane, x); else st_row_bf(XB + m * D, lane, x);
            if (!last) { const float rs2 = rsqrtf(row_ss(x) * (1.0f / D) + EPS);
#pragma unroll
                for (int j = 0; j < 4; ++j) x[j] = x[j] * rs2 * ng[j] + ns[j];
                st_row_bf(XN + m * D, lane, x); }
        }
#undef TE_LOAD
    }
}
constexpr int L_WA = 0, L_WX = 34816, L_XC = 69632, L_PAR = 104448, L_AGG = 108544, L_HST = 116736, L_HINT = 108544;
template <int N> DI float dpp_shr(float oldv, float x) { return __builtin_bit_cast(float, __builtin_amdgcn_update_dpp(__builtin_bit_cast(int, oldv), __builtin_bit_cast(int, x), 0x110 + N, 0xf, 0xf, false)); }
#define RNN_SCAN_STEP(S) \
    "v_fmac_f32_dpp %4, %4, %0 row_shr:" #S " row_mask:0xf bank_mask:0xf\n\t" "v_fmac_f32_dpp %5, %5, %1 row_shr:" #S " row_mask:0xf bank_mask:0xf\n\t" \
    "v_fmac_f32_dpp %6, %6, %2 row_shr:" #S " row_mask:0xf bank_mask:0xf\n\t" "v_fmac_f32_dpp %7, %7, %3 row_shr:" #S " row_mask:0xf bank_mask:0xf\n\t" \
    "v_mul_f32_dpp %0, %0, %0 row_shr:" #S " row_mask:0xf bank_mask:0xf\n\t" "v_mul_f32_dpp %1, %1, %1 row_shr:" #S " row_mask:0xf bank_mask:0xf\n\t" \
    "v_mul_f32_dpp %2, %2, %2 row_shr:" #S " row_mask:0xf bank_mask:0xf\n\t" "v_mul_f32_dpp %3, %3, %3 row_shr:" #S " row_mask:0xf bank_mask:0xf\n\t"
DI void scan16(f32x4& a, f32x4& u) {
    float a0 = a[0], a1 = a[1], a2 = a[2], a3 = a[3], u0 = u[0], u1 = u[1], u2 = u[2], u3 = u[3];
    asm volatile("s_nop 1\n\t" RNN_SCAN_STEP(1) RNN_SCAN_STEP(2) RNN_SCAN_STEP(4) RNN_SCAN_STEP(8) "s_nop 0"
                 : "+v"(a0), "+v"(a1), "+v"(a2), "+v"(a3), "+v"(u0), "+v"(u1), "+v"(u2), "+v"(u3));
    a = (f32x4){a0, a1, a2, a3}; u = (f32x4){u0, u1, u2, u3};
}
template <int N> DI void scan_step(f32x4& a, f32x4& u) {
#pragma unroll
    for (int q = 0; q < 4; ++q) { const float ap = dpp_shr<N>(1.0f, a[q]), up = dpp_shr<N>(0.0f, u[q]); u[q] = a[q] * up + u[q]; a[q] = a[q] * ap; }
}
DI f32x4 mfma16(bf16x8 a, bf16x8 b, f32x4 c) { return __builtin_amdgcn_mfma_f32_16x16x32_bf16(a, b, c, 0, 0, 0); }
DI f32x4 bf4lo(u32x4 v) { return (f32x4){bflo(v.x), bfhi(v.x), bflo(v.y), bfhi(v.y)}; }
DI f32x4 bf4hi(u32x4 v) { return (f32x4){bflo(v.z), bfhi(v.z), bflo(v.w), bfhi(v.w)}; }
DI void rnn_pass1(LAS unsigned char* lds, int l, int tid, int wave, int lane, int it_first, int it_count, int it_stride) {
    const int fr = lane & 15, fq = lane >> 4;
    LAS float* PAR = (LAS float*)(lds + L_PAR); LAS float* AGG = (LAS float*)(lds + L_AGG); LAS float* HST = (LAS float*)(lds + L_HST);
    const int cc = tid & 15, tg4 = (tid >> 4) * 4;
    for (int itk = 0; itk < it_count; ++itk) { const int it = it_first + itk * it_stride;
        const int nb = it & 7, seg = it >> 3, sidx = seg & 15; const int m0 = seg * 512;
        const kargp_t kp = kargs(); unsigned char* ws = karg_ws(kp);
        const bf16* XRp = (const bf16*)(ws + WS_XR);
        __syncthreads();
        u32x4 pre[7];
        f32x4 cw0[4], cw1[4], cb0, cb1;
#define RNN_PREFETCH(stn) do { _Pragma("unroll") for (int j = 0; j < 7; ++j) { const int rl = 128 * (stn) + tg4 - 3 + j; pre[j] = (u32x4){0u, 0u, 0u, 0u}; \
                if (!(sidx == 0 && rl < 0)) pre[j] = *(const u32x4*)(XRp + (size_t)(m0 + rl) * 1024 + nb * 128 + cc * 8); } } while (0)
        RNN_PREFETCH(0);
        { const bf16* WA = (const bf16*)(ws + WS_WL + (size_t)l * WL_STRIDE + WL_WRA) + nb * 16384; const bf16* WX = (const bf16*)(ws + WS_WL + (size_t)l * WL_STRIDE + WL_WRX) + nb * 16384;
          u32x4 wreg[8];
#pragma unroll
          for (int i = 0; i < 4; ++i) { const int q = tid + 512 * i; wreg[i] = *(const u32x4*)(WA + (q >> 4) * 128 + (q & 15) * 8); wreg[4 + i] = *(const u32x4*)(WX + (q >> 4) * 128 + (q & 15) * 8); }
          { const float* cwp = karg_in(kp, 9) + (size_t)l * 4096 + nb * 128 + cc * 8; const float* cbp = karg_in(kp, 10) + l * 1024 + nb * 128 + cc * 8;
#pragma unroll
              for (int k = 0; k < 4; ++k) { cw0[k] = *(const f32x4*)(cwp + k * 1024); cw1[k] = *(const f32x4*)(cwp + k * 1024 + 4); }
              cb0 = *(const f32x4*)cbp; cb1 = *(const f32x4*)(cbp + 4); }
          if (tid < 128) { const int ch = l * 1024 + nb * 128 + tid;
            PAR[0 * 128 + tid] = -LOG2E * karg_in(kp, 12)[ch]; PAR[1 * 128 + tid] = -LOG2E * karg_in(kp, 14)[ch]; PAR[2 * 128 + tid] = 8.0f * log1pf(expf(-karg_in(kp, 15)[ch])) * LOG2E;
            *(LAS f32x2*)(HST + 2 * tid) = (f32x2){1.0f, 0.0f}; }
#pragma unroll
          for (int i = 0; i < 4; ++i) { const int q = tid + 512 * i; *(LAS u32x4*)(lds + L_WA + (q >> 4) * 272 + (q & 15) * 16) = wreg[i]; *(LAS u32x4*)(lds + L_WX + (q >> 4) * 272 + (q & 15) * 16) = wreg[4 + i]; } }
        for (int st = 0; st < 4; ++st) {
#pragma unroll
            for (int i = 0; i < 4; ++i) { f32x4 o0 = cb0, o1 = cb1;
#pragma unroll
                for (int k = 0; k < 4; ++k) { o0 += cw0[k] * bf4lo(pre[i + k]); o1 += cw1[k] * bf4hi(pre[i + k]); }
                u32x4 pk; pk.x = pk2(o0[0], o0[1]); pk.y = pk2(o0[2], o0[3]); pk.z = pk2(o1[0], o1[1]); pk.w = pk2(o1[2], o1[3]);
                *(LAS u32x4*)(lds + L_XC + (tg4 + i) * 272 + cc * 16) = pk; }
            __syncthreads();
            if (st < 3) RNN_PREFETCH(st + 1);
            const int tp = wave >> 1, nh = (wave & 1) * 4; const int tl0 = 32 * tp + fr;
            bf16x8 xb[2][4];
#pragma unroll
            for (int k = 0; k < 2; ++k)
#pragma unroll
                for (int s = 0; s < 4; ++s) xb[k][s] = *(const LAS bf16x8*)(lds + L_XC + (tl0 + 16 * k) * 272 + (32 * s + 8 * fq) * 2);
            unsigned* PSw = (unsigned*)(ws + WS_PS); float* T16w = (float*)(ws + WS_T16);
#pragma unroll
            for (int j = 0; j < 4; ++j) { const int n = nh + j, ch0 = 16 * n + 4 * fq;
                f32x4 ca[2], cx[2];
#pragma unroll
                for (int k = 0; k < 2; ++k) { ca[k] = *(const LAS f32x4*)(PAR + ch0); cx[k] = *(const LAS f32x4*)(PAR + 128 + ch0); }
#pragma unroll
                for (int s = 0; s < 4; ++s) { const bf16x8 af = *(const LAS bf16x8*)(lds + L_WA + (16 * n + fr) * 272 + (32 * s + 8 * fq) * 2), xf = *(const LAS bf16x8*)(lds + L_WX + (16 * n + fr) * 272 + (32 * s + 8 * fq) * 2);
#pragma unroll
                    for (int k = 0; k < 2; ++k) { ca[k] = mfma16(af, xb[k][s], ca[k]); cx[k] = mfma16(xf, xb[k][s], cx[k]); } }
                const f32x4 sp = *(const LAS f32x4*)(PAR + 256 + ch0);
                f32x4 av[2], uv[2];
#pragma unroll
                for (int k = 0; k < 2; ++k) { const u32x2 xv = *(const LAS u32x2*)(lds + L_XC + (tl0 + 16 * k) * 272 + ch0 * 2); const f32x4 xc = (f32x4){bflo(xv.x), bfhi(xv.x), bflo(xv.y), bfhi(xv.y)};
#pragma unroll
                    for (int q = 0; q < 4; ++q) { const float r = frcp(1.0f + fexp2(ca[k][q])), ig = frcp(1.0f + fexp2(cx[k][q]));
                        const float aa = fexp2(-r * sp[q]); av[k][q] = aa; uv[k][q] = __builtin_amdgcn_sqrtf(1.0f - aa * aa) * ig * xc[q]; } }
                scan16(av[0], uv[0]); scan16(av[1], uv[1]);
#pragma unroll
                for (int k = 0; k < 2; ++k) { const int tix = 2 * tp + k;
                    { u32x4 ps; ps.x = pk2(av[k][0], uv[k][0]); ps.y = pk2(av[k][1], uv[k][1]); ps.z = pk2(av[k][2], uv[k][2]); ps.w = pk2(av[k][3], uv[k][3]);
                      *(u32x4*)(PSw + (size_t)(m0 + 128 * st + tl0 + 16 * k) * 1024 + nb * 128 + ch0) = ps; }
                    if (fr == 15) { const f32x4 g0 = (f32x4){av[k][0], uv[k][0], av[k][1], uv[k][1]}, g1 = (f32x4){av[k][2], uv[k][2], av[k][3], uv[k][3]};
                        *(LAS f32x4*)(AGG + (tix * 128 + ch0) * 2) = g0; *(LAS f32x4*)(AGG + (tix * 128 + ch0) * 2 + 4) = g1;
                        float* o = T16w + ((size_t)(seg * 32 + st * 8 + tix) * 1024 + nb * 128 + ch0) * 2; *(f32x4*)o = g0; *(f32x4*)(o + 4) = g1; } }
            }
            __syncthreads();
            LAS float* HS0 = HST + 256 * (st & 1); LAS float* HS1 = HST + 256 * ((st + 1) & 1);
            if (fr == 0) { const int ch0 = 16 * wave + 4 * fq;
                const f32x4 h0 = *(const LAS f32x4*)(HS0 + 2 * ch0), h1 = *(const LAS f32x4*)(HS0 + 2 * ch0 + 4);
                f32x4 A = (f32x4){h0[0], h0[2], h1[0], h1[2]}, U = (f32x4){h0[1], h0[3], h1[1], h1[3]};
#pragma unroll
                for (int w2 = 0; w2 < 8; ++w2) { const f32x4 g0 = *(const LAS f32x4*)(AGG + (w2 * 128 + ch0) * 2), g1 = *(const LAS f32x4*)(AGG + (w2 * 128 + ch0) * 2 + 4);
                    const f32x4 a2 = (f32x4){g0[0], g0[2], g1[0], g1[2]}, u2 = (f32x4){g0[1], g0[3], g1[1], g1[3]}; U = a2 * U + u2; A = A * a2; }
                const f32x4 o0 = (f32x4){A[0], U[0], A[1], U[1]}, o1 = (f32x4){A[2], U[2], A[3], U[3]};
                *(LAS f32x4*)(HS1 + 2 * ch0) = o0; *(LAS f32x4*)(HS1 + 2 * ch0 + 4) = o1;
                if (st == 3) { float* o = (float*)(ws + WS_RAGG) + ((size_t)seg * 1024 + nb * 128 + ch0) * 2; *(f32x4*)o = o0; *(f32x4*)(o + 4) = o1; } }
        }
#undef RNN_PREFETCH
    }
}
DI void rnn_pass2(LAS unsigned char* lds, int tid) {
    LAS float* HINT = (LAS float*)lds;
    for (int it = vcu_index(); it < 256; it += gridDim.x) {
        const int nb = it & 7, seg = it >> 3, sidx = seg & 15; const int m0 = seg * 512;
        unsigned char* ws = karg_ws(kargs());
        __syncthreads();
        if (tid < 128) { const float* RAGG = (const float*)(ws + WS_RAGG) + ((size_t)(seg - sidx) * 1024 + nb * 128 + tid) * 2; const float* T16 = (const float*)(ws + WS_T16) + ((size_t)(seg * 32) * 1024 + nb * 128 + tid) * 2;
            f32x2 sa[15], ta[32];
#pragma unroll
            for (int s2 = 0; s2 < 15; ++s2) sa[s2] = *(const f32x2*)(RAGG + (size_t)s2 * 2048);
#pragma unroll
            for (int t2 = 0; t2 < 32; ++t2) ta[t2] = *(const f32x2*)(T16 + (size_t)t2 * 2048);
            float h = 0.f;
#pragma unroll
            for (int s2 = 0; s2 < 15; ++s2) h = (s2 < sidx) ? sa[s2].x * h + sa[s2].y : h;
#pragma unroll
            for (int t2 = 0; t2 < 32; ++t2) { HINT[t2 * 128 + tid] = h; h = ta[t2].x * h + ta[t2].y; } }
        __syncthreads();
        const unsigned* PS = (const unsigned*)(ws + WS_PS); const bf16* GGp = (const bf16*)(ws + WS_GG); bf16* ROp = (bf16*)(ws + WS_RO);
        const int c4 = (tid & 31) * 4, r0 = tid >> 5;
#pragma unroll 4
        for (int i = 0; i < 32; ++i) { const int row = r0 + 16 * i; const size_t off = (size_t)(m0 + row) * 1024 + nb * 128 + c4, offo = (size_t)(m0 + row) * 2048 + nb * 128 + c4;
            const u32x4 ps = *(const u32x4*)(PS + off); const u32x2 gv = *(const u32x2*)(GGp + off); const f32x4 hin = *(const LAS f32x4*)(HINT + (row >> 4) * 128 + c4);
            const float h0 = bflo(ps.x) * hin[0] + bfhi(ps.x), h1 = bflo(ps.y) * hin[1] + bfhi(ps.y), h2 = bflo(ps.z) * hin[2] + bfhi(ps.z), h3 = bflo(ps.w) * hin[3] + bfhi(ps.w);
            u32x2 o; o.x = pk2(h0 * bflo(gv.x), h1 * bfhi(gv.x)); o.y = pk2(h2 * bflo(gv.y), h3 * bfhi(gv.y)); *(u32x2*)(ROp + offo) = o; }
    }
}

constexpr int L_K = 0, L_V = 69632;
DI f32x16 mfma32(bf16x8 a, bf16x8 b, f32x16 c) { return __builtin_amdgcn_mfma_f32_32x32x16_bf16(a, b, c, 0, 0, 0); }
DI void attn_phase(LAS unsigned char* lds, int l, int tid, int wave, int lane, int it_first, int it_count, int it_stride) {
    const int r = lane & 31, h = lane >> 5;
    const kargp_t kp = kargs(); unsigned char* ws = karg_ws(kp);
    const bf16* Q = (const bf16*)(ws + WS_Q); const bf16* KB = (const bf16*)(ws + WS_KB); const bf16* VB = (const bf16*)(ws + WS_VB); bf16* AO = (bf16*)(ws + WS_RO) + 1024;   const float* sinks = karg_in(kp, 16) + l * 8;
    for (int itk = 0; itk < it_count; ++itk) { const int it = it_first + itk * it_stride;
        const int b = it >> 7, qblk = (it >> 1) & 63, kvh = it & 1; const int rowbase = b * SEQ + qblk * 128;
        __syncthreads();
        { u32x4 kreg[8], vreg[8];
#pragma unroll
          for (int i = 0; i < 8; ++i) { const int idx = tid + 512 * i, j = idx >> 4, c = idx & 15; const int jr = (qblk > 0 || j >= 128) ? j : 128;
            kreg[i] = *(const u32x4*)(KB + (size_t)(rowbase - 128 + jr) * 256 + kvh * 128 + c * 8); vreg[i] = *(const u32x4*)(VB + (size_t)(rowbase - 128 + jr) * 256 + kvh * 128 + c * 8); }
#pragma unroll
          for (int i = 0; i < 8; ++i) { const int idx = tid + 512 * i, j = idx >> 4, c = idx & 15; const bool ok = (qblk > 0 || j >= 128); const u32x4 z = (u32x4){0u, 0u, 0u, 0u};
            *(LAS u32x4*)(lds + L_K + j * 272 + c * 16) = ok ? kreg[i] : z; *(LAS u32x4*)(lds + L_V + j * 272 + c * 16) = ok ? vreg[i] : z; } }
        const int g = wave >> 1, head = kvh * 4 + g;
        bf16x8 qf[8], qn[8];
#pragma unroll
        for (int ks = 0; ks < 8; ++ks) qf[ks] = *(const bf16x8*)(Q + (size_t)(rowbase + 64 * (wave & 1) + r) * 1024 + head * 128 + 16 * ks + 8 * h);
        __syncthreads();
        const float slope2 = exp2f(-(float)(head + 1)) * LOG2E, sink2 = sinks[head] * LOG2E;
#pragma unroll 1
        for (int si = 0; si < 2; ++si) {
            const int q0 = 64 * (wave & 1) + 32 * si, kt0 = q0 >> 5; const size_t qrow = (size_t)(rowbase + q0 + r);
            const LAS unsigned char* kbase = lds + L_K + (32 * kt0 + r) * 272 + 16 * h;
            const LAS unsigned char* vbase = lds + L_V + (32 * kt0 + 4 * h + ((lane & 15) >> 2)) * 272 + (16 * ((lane >> 4) & 1) + 4 * (lane & 3)) * 2;
            const int d0 = (q0 + r) + 128 - (32 * kt0 + 4 * h);
            const int jlim = qblk > 0 ? -100000 : 128 - (32 * kt0 + 4 * h);
            const float fd0 = (float)d0, fjl = (float)jlim;
            f32x16 p[5];
#pragma unroll
            for (int t = 0; t < 5; ++t) {
#pragma unroll
                for (int e = 0; e < 16; ++e) p[t][e] = 0.f;
#pragma unroll
                for (int ks = 0; ks < 8; ++ks) { const bf16x8 kf = *(const LAS bf16x8*)(kbase + t * 8704 + ks * 32); p[t] = mfma32(kf, qf[ks], p[t]); } }
            if (si == 0) {
#pragma unroll
                for (int ks = 0; ks < 8; ++ks) qn[ks] = *(const bf16x8*)(Q + (qrow + 32) * 1024 + head * 128 + 16 * ks + 8 * h);
            }
            float mx = sink2;
#pragma unroll
            for (int t = 0; t < 5; ++t) {
                if (t >= 1 && t <= 3 && qblk > 0) {
#pragma unroll
                    for (int e = 0; e < 16; ++e) { const float cte = (float)(32 * t + (e & 3) + 8 * (e >> 2)); p[t][e] = p[t][e] - slope2 * (fd0 - cte); mx = fmaxf(mx, p[t][e]); }
                } else {
#pragma unroll
                    for (int e = 0; e < 16; ++e) { const float cte = (float)(32 * t + (e & 3) + 8 * (e >> 2)); const float fd = fd0 - cte;
                        const float bad = fmaxf(fmaxf(-fd, fd - 127.0f), fjl - cte);
                        p[t][e] = p[t][e] - slope2 * fd + fminf(0.f, -1e30f * bad); mx = fmaxf(mx, p[t][e]); }
                } }
            mx = fmaxf(mx, __shfl_xor(mx, 32));
            float sum = 0.f;
#pragma unroll
            for (int t = 0; t < 5; ++t)
#pragma unroll
                for (int e = 0; e < 16; ++e) { const float ev = fexp2(p[t][e] - mx); p[t][e] = ev; sum += ev; }
            sum += __shfl_xor(sum, 32); sum += fexp2(sink2 - mx);
            const float inv = 1.0f / sum;
            f32x16 o[4];
#pragma unroll
            for (int dt = 0; dt < 4; ++dt)
#pragma unroll
                for (int e = 0; e < 16; ++e) o[dt][e] = 0.f;
#pragma unroll
            for (int t = 0; t < 5; ++t) {
#pragma unroll
                for (int s = 0; s < 2; ++s) { u32x4 pk; pk.x = pk2(p[t][8 * s + 0], p[t][8 * s + 1]); pk.y = pk2(p[t][8 * s + 2], p[t][8 * s + 3]); pk.z = pk2(p[t][8 * s + 4], p[t][8 * s + 5]); pk.w = pk2(p[t][8 * s + 6], p[t][8 * s + 7]);
                    const bf16x8 pf = __builtin_bit_cast(bf16x8, pk);
#pragma unroll
                    for (int dt = 0; dt < 4; ++dt) { const LAS unsigned char* va = vbase + t * 8704 + s * 4352 + dt * 64;
                        const s16x4 lo = __builtin_amdgcn_ds_read_tr16_b64_v4i16((LAS s16x4*)va), hi = __builtin_amdgcn_ds_read_tr16_b64_v4i16((LAS s16x4*)(va + 2176));
                        const bf16x8 vf = __builtin_shufflevector(lo, hi, 0, 1, 2, 3, 4, 5, 6, 7); o[dt] = mfma32(vf, pf, o[dt]); } } }
#pragma unroll
            for (int dt = 0; dt < 4; ++dt)
#pragma unroll
                for (int gg = 0; gg < 4; ++gg) { u32x2 w; w.x = pk2(o[dt][4 * gg] * inv, o[dt][4 * gg + 1] * inv); w.y = pk2(o[dt][4 * gg + 2] * inv, o[dt][4 * gg + 3] * inv);
                    *(u32x2*)(AO + qrow * 2048 + head * 128 + 32 * dt + 8 * gg + 4 * h) = w; }
#pragma unroll
            for (int ks = 0; ks < 8; ++ks) qf[ks] = qn[ks];
        }
    }
}

constexpr int N_PHASES = 2 + 9 * DEPTH;
__global__ void __launch_bounds__(NWAVES * 64, 2) trunk_fwd(Args args) {
    extern __shared__ __attribute__((aligned(16))) unsigned char lds_raw[];
    LAS unsigned char* lds = (LAS unsigned char*)lds_raw;
    volatile LAS unsigned* MISC = (volatile LAS unsigned*)(lds + MISC_OFF);
    const int tid0 = threadIdx.x;
#define TID_DEFS int tid = tid0; asm volatile("" : "+v"(tid)); const int lane = tid & 63, wave = __builtin_amdgcn_readfirstlane(tid >> 6); (void)lane; (void)wave;
    const int G = gridDim.x;
    gu32* ctl = (gu32*)(args.ws + WS_CTL);
    for (int u = tid0; u < (LDS_BYTES - LDSCTL_OFF) / 4; u += NWAVES * 64) ((LAS unsigned*)(lds + LDSCTL_OFF))[u] = 0u;
    __syncthreads();
    XcdBarrier bar = xcd_barrier_post((unsigned*)ctl + CW_BAR, MISC + 8);
    const int lo = args.ph_lo, hi = args.ph_hi;
#ifndef PH_MASK
#define PH_MASK 0xffffffffu
#endif
#define EN(b) ((PH_MASK >> (b)) & 1u)
#ifndef A_ALIGN
#define A_ALIGN true
#endif
#ifndef MIX_DEAL
#define MIX_DEAL 0
#endif
#ifndef BINPACK
#define BINPACK 1
#endif
#ifndef FUSE_DENSE
#define FUSE_DENSE 0
#endif
#ifndef PH_REPEAT
#define PH_REPEAT 0u
#endif
#ifndef PH_NREP
#define PH_NREP 2
#endif
#define REPS(b) (((PH_REPEAT >> (b)) & 1u) ? PH_NREP : 1)
#define REP_BEGIN(b) for (int rep_ = 0; rep_ < REPS(b); ++rep_) { if (rep_) xcd_barrier(bar);
#define REP_END }
#define IN(k) (lo <= (k) && (k) < hi)
#ifndef BAR_TWICE
#define BAR_TWICE 0
#endif
#define SEAM(k) do { if (IN(k) && IN((k) + 1)) { xcd_barrier(bar); if (BAR_TWICE) xcd_barrier(bar); } } while (0)
#if NAIVE_GEMM
#define RUN_GEMM(EPI, SCHED, ALIGN, g, S, E) pg8::gemm_phase_naive<EPI, SCHED>(g, S, E)
#else
#ifndef BF_SP2
#define BF_SP2 true
#endif
#define RUN_GEMM(EPI, SCHED, ALIGN, g, S, E) pg8::gemm_phase<EPI, SCHED, ALIGN, BF_SP2>(lds + RING_OFF, g, S, E)
#endif
#ifndef F8_ALIGN
#define F8_ALIGN(a) (a)
#endif
#ifndef F8_SP2
#define F8_SP2 false
#endif
#define RUN_GEMM8(EPI, SCHED, ALIGN, g, S, E) pg8::gemm_phase<EPI, SCHED, F8_ALIGN(ALIGN), F8_SP2, true>(lds + RING_OFF, g, S, E)
#define SC_ONE 0x7f7f7f7f
#define SC_M5 0x7a7a7a7a
#define SC_M6 0x79797979
    if (EN(0) && IN(0)) { REP_BEGIN(0) TID_DEFS p0_prologue(lds, tid, wave, lane); REP_END } SEAM(0);
    if (EN(1) && IN(1)) { REP_BEGIN(1) TID_DEFS thin_start(wave, lane); REP_END } SEAM(1);

    for (int l = 0; l < DEPTH; ++l) {
        const int pb = 2 + 9 * l;
        const bool binpack = BINPACK && G == 256;
        if (EN(2) && IN(pb + 0)) { REP_BEGIN(2)
            unsigned char* ws = karg_ws(kargs());
            pg8::Gemm g{(const bf16*)(ws + WS_XN), (const bf16*)(ws + WS_WL + (size_t)l * WL_STRIDE + WL_WIN), M, D_IN, D}; pg8::StaticOrder S; S.init(M, binpack ? 16 * 256 : D_IN, G, (int)blockIdx.x);
            pg8::EpiWin E; E.R = ws + WS_R;
            RUN_GEMM(pg8::EpiWin, pg8::StaticOrder, A_ALIGN, g, S, E);
        REP_END } SEAM(pb + 0);
        if (IN(pb + 1)) {
            if (binpack) {
                const int xq = (int)blockIdx.x & 7, qq = (int)blockIdx.x >> 3; const bool gx = qq < 16; const int c = gx ? xq * 16 + qq : 128 + xq * 16 + (qq - 16);
#define MIX_GEMM() do { unsigned char* ws = karg_ws(kargs()); \
                    pg8::Gemm g{(const bf16*)(ws + WS_XN), (const bf16*)(ws + WS_WL + (size_t)l * WL_STRIDE + WL_WIN), M, D_IN, D}; pg8::ListOrder S; S.first = gx ? 48 * xq + qq : 48 * xq + 16 + 2 * (qq - 16); S.count = gx ? 1 : 2; S.ncol = 6; S.pn0 = 16; \
                    pg8::EpiWin E; E.R = ws + WS_R; \
                    RUN_GEMM(pg8::EpiWin, pg8::ListOrder, A_ALIGN, g, S, E); } while (0)
                if (EN(2)) MIX_GEMM();
                if (gx) { if (EN(3)) { TID_DEFS rnn_pass1(lds, l, tid, wave, lane, 2 * c, 2, 1); } }
                else { if (EN(4)) { TID_DEFS attn_phase(lds, l, tid, wave, lane, 2 * (c - 128), 2, 1); } }
#undef MIX_GEMM
            } else {
                const int c = vcu_index(), cnt = c < 256 ? (256 - c + G - 1) / G : 0;
                if (EN(3)) { REP_BEGIN(3) TID_DEFS rnn_pass1(lds, l, tid, wave, lane, c, cnt, G); REP_END }
                if (EN(4)) { REP_BEGIN(4) TID_DEFS attn_phase(lds, l, tid, wave, lane, c, cnt, G); REP_END }
            }
        } SEAM(pb + 1);
        if (EN(5) && IN(pb + 2)) { REP_BEGIN(5) TID_DEFS rnn_pass2(lds, tid); REP_END } SEAM(pb + 2);
        if (EN(6) && IN(pb + 3)) { REP_BEGIN(6)
            unsigned char* ws = karg_ws(kargs());
            pg8::Gemm g{(const bf16*)(ws + WS_RO), (const bf16*)(ws + WS_WL + (size_t)l * WL_STRIDE + WL_WB), M, D, 2 * D}; pg8::StaticOrder S; S.init(M, D, G, (int)blockIdx.x);
            pg8::EpiMerge E; E.R = ws + WS_R; RUN_GEMM(pg8::EpiMerge, pg8::StaticOrder, false, g, S, E);
         REP_END } SEAM(pb + 3);
        const bool fuse = FUSE_DENSE && !(l & 1) && G == 256;
        if (EN(7) && IN(pb + 4)) { REP_BEGIN(7)
            const kargp_t kp = kargs(); unsigned char* ws = karg_ws(kp);
            pg8::Gemm g{(const bf16*)(ws + WS_MG), (const bf16*)(ws + WS_WL + (size_t)l * WL_STRIDE + WL_WO), M, D, D}; pg8::StaticOrder S; S.init(M, D, G, (int)blockIdx.x);
            if (fuse) {
                const float* ada = (const float*)(ws + WS_ADA) + (size_t)(l * 2) * 6144; unsigned* ctlw = (unsigned*)(ws + WS_CTL); const int bank = (l >> 1) * 4;
                pg8::EpiRmsResRms E; E.xin32 = (l == 0) ? karg_in(kp, 0) : nullptr; E.xin16 = (const bf16*)(ws + WS_XB); E.XB = (bf16*)(ws + WS_XB); E.XN = (bf16*)(ws + WS_XN); E.xn_fp8 = (int)((FP8_LAYERS >> l) & 1u);
                E.gainA = karg_in(kp, 5) + l * D; E.gateA = ada + 2048; E.gainB = karg_in(kp, 6) + l * D; E.scB = ada + 4096; E.shB = ada + 3072;
                E.st1.xbuf = (float*)(ws + WS_XS) + (size_t)bank * 65536; E.st1.cnt = ctlw + CW_SEAM + bank * SEAM_BANK; E.st1.tmo = ctlw;
                E.st2.xbuf = (float*)(ws + WS_XS) + (size_t)(bank + 1) * 65536; E.st2.cnt = ctlw + CW_SEAM + (bank + 1) * SEAM_BANK; E.st2.tmo = ctlw;
                RUN_GEMM(pg8::EpiRmsResRms, pg8::StaticOrder, false, g, S, E);
            } else { pg8::EpiBf16N E; E.O = (bf16*)(ws + WS_MIX); RUN_GEMM(pg8::EpiBf16N, pg8::StaticOrder, false, g, S, E); }
        REP_END } SEAM(pb + 4);
        if (IN(pb + 5) && !fuse) { if (l & 1) { if (EN(9)) { TID_DEFS thin_mid_moe(lds, l, tid, wave, lane); } } else { if (EN(8)) { TID_DEFS thin_mid_dense(l, wave, lane); } } }
        if (!fuse) SEAM(pb + 5);
        if (l & 1) {
            if (EN(10) && IN(pb + 6)) { REP_BEGIN(10)
                unsigned char* ws = karg_ws(kargs()); const unsigned* cntg = (const unsigned*)(ws + WS_CTL) + CW_CNT + 64 * (l >> 1);
                pg8::Gemm g{(const bf16*)(ws + WS_AP), (const bf16*)(ws + WS_WM + (size_t)(l >> 1) * WM_STRIDE + WM_MIN), 0, 0, D, SC_M5, SC_ONE}; pg8::MoeOrder S; S.init(cntg, 12, G, (int)blockIdx.x, ECAP / 256);
                if ((FP8_LAYERS >> l) & 1u) { pg8::EpiSwiglu8 E; E.O = ws + WS_ACTP; E.ldc = D_FFE; E.ntile = 12; RUN_GEMM8(pg8::EpiSwiglu8, pg8::MoeOrder, true, g, S, E); }
                else { pg8::EpiSwiglu E; E.O = (bf16*)(ws + WS_ACTP); E.ldc = D_FFE; E.ntile = 12; RUN_GEMM(pg8::EpiSwiglu, pg8::MoeOrder, true, g, S, E); }
             REP_END } SEAM(pb + 6);
            if (EN(11) && IN(pb + 7)) { REP_BEGIN(11)
                unsigned char* ws = karg_ws(kargs()); const unsigned* cntg = (const unsigned*)(ws + WS_CTL) + CW_CNT + 64 * (l >> 1);
                pg8::Gemm g{(const bf16*)(ws + WS_ACTP), (const bf16*)(ws + WS_WM + (size_t)(l >> 1) * WM_STRIDE + WM_MOUT), 0, 0, D_FFE, SC_M5, SC_ONE}; pg8::MoeOrder S; S.init(cntg, 4, G, (int)blockIdx.x, 0);
                pg8::EpiBf16Mod4 E; E.O = (bf16*)(ws + WS_YP);
                if ((FP8_LAYERS >> l) & 1u) RUN_GEMM8(pg8::EpiBf16Mod4, pg8::MoeOrder, true, g, S, E); else RUN_GEMM(pg8::EpiBf16Mod4, pg8::MoeOrder, true, g, S, E);
             REP_END } SEAM(pb + 7);
        } else {
            if (EN(12) && IN(pb + 6)) { REP_BEGIN(12)
                unsigned char* ws = karg_ws(kargs());
                pg8::Gemm g{(const bf16*)(ws + WS_XN), (const bf16*)(ws + WS_WD + (size_t)(l >> 1) * WD_STRIDE + WD_FIN), M, 2 * D_FF, D, SC_M5, SC_ONE}; pg8::StaticOrder S; S.init(M, 2 * D_FF, G, (int)blockIdx.x);
                if ((FP8_LAYERS >> l) & 1u) { pg8::EpiSwiglu8 E; E.O = ws + WS_ACT; E.ldc = D_FF; E.ntile = 24; RUN_GEMM8(pg8::EpiSwiglu8, pg8::StaticOrder, true, g, S, E); }
                else { pg8::EpiSwiglu E; E.O = (bf16*)(ws + WS_ACT); E.ldc = D_FF; E.ntile = 24; RUN_GEMM(pg8::EpiSwiglu, pg8::StaticOrder, true, g, S, E); }
             REP_END } SEAM(pb + 6);
            if (EN(13) && IN(pb + 7)) { REP_BEGIN(13)
                unsigned char* ws = karg_ws(kargs());
                pg8::Gemm g{(const bf16*)(ws + WS_ACT), (const bf16*)(ws + WS_WD + (size_t)(l >> 1) * WD_STRIDE + WD_FOUT), M, D, D_FF, SC_M6, SC_ONE}; pg8::StaticOrder S; S.init(M, D, G, (int)blockIdx.x);
                if (fuse) {
                    const kargp_t kp = kargs(); const float* ada = (const float*)(ws + WS_ADA) + (size_t)(l * 2) * 6144; const float* adan = (const float*)(ws + WS_ADA) + (size_t)((l + 1) * 2) * 6144; unsigned* ctlw = (unsigned*)(ws + WS_CTL); const int bank = (l >> 1) * 4 + 2;
                    pg8::EpiRmsResRms E; E.xin32 = nullptr; E.xin16 = (const bf16*)(ws + WS_XB); E.XB = (bf16*)(ws + WS_XB); E.XN = (bf16*)(ws + WS_XN); E.xn_fp8 = 0;
                    E.gainA = karg_in(kp, 7) + l * D; E.gateA = ada + 5120; E.gainB = karg_in(kp, 4) + (l + 1) * D; E.scB = adan + 1024; E.shB = adan;
                    E.st1.xbuf = (float*)(ws + WS_XS) + (size_t)bank * 65536; E.st1.cnt = ctlw + CW_SEAM + bank * SEAM_BANK; E.st1.tmo = ctlw;
                    E.st2.xbuf = (float*)(ws + WS_XS) + (size_t)(bank + 1) * 65536; E.st2.cnt = ctlw + CW_SEAM + (bank + 1) * SEAM_BANK; E.st2.tmo = ctlw;
                    if ((FP8_LAYERS >> l) & 1u) RUN_GEMM8(pg8::EpiRmsResRms, pg8::StaticOrder, false, g, S, E); else RUN_GEMM(pg8::EpiRmsResRms, pg8::StaticOrder, false, g, S, E);
                } else { pg8::EpiBf16N E; E.O = (bf16*)(ws + WS_MIX);
                    if ((FP8_LAYERS >> l) & 1u) RUN_GEMM8(pg8::EpiBf16N, pg8::StaticOrder, false, g, S, E); else RUN_GEMM(pg8::EpiBf16N, pg8::StaticOrder, false, g, S, E); }
             REP_END } SEAM(pb + 7);
        }
        if (EN(14) && IN(pb + 8) && !fuse) { TID_DEFS thin_end(l, wave, lane); }
        if (!fuse) SEAM(pb + 8);
    }
#undef IN
#undef SEAM
}

extern "C" void kernel_launch(void* const* d_in, const int* in_sizes, int n_in, void* d_out, int out_size, void* d_ws, size_t ws_size, hipStream_t stream) {
    static int grid = 0;
    if (grid == 0) {
        if (n_in != 24 || in_sizes[0] != M * D || out_size != M * D || ws_size < WS_END) { fprintf(stderr, "kernel_launch: unexpected shapes or workspace (n_in %d, in0 %d, out %d, ws %zu < %zu); nothing launched\n", n_in, n_in > 0 ? in_sizes[0] : -1, out_size, ws_size, (size_t)WS_END); grid = -1; return; }
        int dev = 0, cus = 0, per_cu = 0;
        if (hipGetDevice(&dev) != hipSuccess || hipDeviceGetAttribute(&cus, hipDeviceAttributeMultiprocessorCount, dev) != hipSuccess) { grid = -1; return; }
        if (hipFuncSetAttribute((const void*)trunk_fwd, hipFuncAttributeMaxDynamicSharedMemorySize, LDS_BYTES) != hipSuccess) { fprintf(stderr, "kernel_launch: hipFuncSetAttribute failed\n"); grid = -1; return; }
        if (hipOccupancyMaxActiveBlocksPerMultiprocessor(&per_cu, (const void*)trunk_fwd, NWAVES * 64, LDS_BYTES) != hipSuccess || per_cu < 1)
            fprintf(stderr, "kernel_launch: note: occupancy query reports %d workgroups per CU\n", per_cu);
        (void)hipGetLastError();
        grid = cus;
    }
    if (grid < 0) return;
    if (hipMemsetAsync((char*)d_ws + WS_CTL, 0, CTL_ZERO_BYTES, stream) != hipSuccess) return;
    Args a{};
    for (int i = 0; i < 24; ++i) a.in[i] = (const float*)d_in[i];
    a.out = (float*)d_out; a.ws = (unsigned char*)d_ws;
#if MK_ONE_LAUNCH
    a.ph_lo = 0; a.ph_hi = N_PHASES;
    hipLaunchKernelGGL(trunk_fwd, dim3(grid), dim3(NWAVES * 64), LDS_BYTES, stream, a);
#else
    for (int p = 0; p < N_PHASES; ++p) { a.ph_lo = p; a.ph_hi = p + 1; hipLaunchKernelGGL(trunk_fwd, dim3(grid), dim3(NWAVES * 64), LDS_BYTES, stream, a); }
#endif
}
```

```cpp
#include <hip/hip_runtime.h>
#include <cstdio>
#include <cstdint>

#ifndef MK_ONE_LAUNCH
#define MK_ONE_LAUNCH 1
#endif
#ifndef NAIVE_GEMM
#define NAIVE_GEMM 0
#endif

#ifndef FP8_LAYERS
#define FP8_LAYERS 0xEu
#endif
#define DI __device__ __forceinline__
#define GAS __attribute__((address_space(1)))
#define LAS __attribute__((address_space(3)))
typedef unsigned short bf16;
typedef short bf16x8 __attribute__((ext_vector_type(8)));
typedef short s16x4 __attribute__((ext_vector_type(4)));
typedef float f32x2 __attribute__((ext_vector_type(2)));
typedef float f32x4 __attribute__((ext_vector_type(4)));
typedef float f32x16 __attribute__((ext_vector_type(16)));
typedef unsigned u32x2 __attribute__((ext_vector_type(2)));
typedef unsigned u32x4 __attribute__((ext_vector_type(4)));
typedef __bf16 bf16x2_t __attribute__((ext_vector_type(2)));
typedef GAS unsigned gu32;

constexpr int BATCH = 2, SEQ = 8192, D = 1024, DEPTH = 4, M = BATCH * SEQ;
constexpr int D_IN = 5632, D_FF = 3072, NE = 8, D_FFE = 1536, ECAP = 16384;
constexpr float EPS = 1e-6f;
constexpr float LOG2E = 1.4426950408889634f;
constexpr float QSCALE = 0.08838834764831845f * 1.4426950408889634f;

DI unsigned pk2(float lo, float hi) { f32x2 v = {lo, hi}; return __builtin_bit_cast(unsigned, __builtin_convertvector(v, bf16x2_t)); }
DI float bflo(unsigned w) { return __uint_as_float(w << 16); }
DI float bfhi(unsigned w) { return __uint_as_float(w & 0xffff0000u); }
DI float fexp2(float x) { return __builtin_amdgcn_exp2f(x); }
DI float frcp(float x) { return __builtin_amdgcn_rcpf(x); }
DI float sigmoidf_(float v) { return frcp(1.0f + fexp2(-LOG2E * v)); }
DI float siluf_(float v) { return v * sigmoidf_(v); }
DI float gelu_tanh_(float v) { const float t = v + 0.044715f * v * v * v; return v * frcp(1.0f + fexp2(-2.0f * 0.7978845608028654f * LOG2E * t)); }
DI float wave_sum(float v) {
#pragma unroll
    for (int o = 1; o < 64; o <<= 1) v += __shfl_xor(v, o);
    return v;
}
#define LDS_WAIT() asm volatile("s_waitcnt lgkmcnt(0)" ::: "memory")
#define VM_WAIT() asm volatile("s_waitcnt vmcnt(0)" ::: "memory")
#define RLX_AGENT __ATOMIC_RELAXED, __HIP_MEMORY_SCOPE_AGENT
#ifndef HOOK_ON
#define HOOK_ON 1
#endif
#ifndef WGM_SET
#define WGM_SET 8
#endif
namespace pg8 {
#define PG8_LAS __attribute__((address_space(3)))
typedef unsigned short bf16_t;
constexpr int BM = 256, BK = 64, HALF = 128, HTB = HALF * BK * 2  , STAGE_BYTES = 8 * HTB, NXCD = 8, WGM = WGM_SET;

__host__ __device__ __forceinline__ int lds_byte(int r, int c) { const int st = (r >> 4) * 2 + (c >> 5), rr = r & 15, cc = c & 31, ob = rr * 64 + cc * 2; return st * 1024 + (ob ^ (((ob >> 9) & 1) << 5)); }
__host__ __device__ __forceinline__ void stage_rc(int b, int& R, int& C) { const int st = b / 1024, sb = b % 1024, swz = sb ^ (((sb >> 9) & 1) << 5); R = (st >> 1) * 16 + swz / 64; C = (st & 1) * 32 + (swz % 64) / 2; }
__host__ __device__ __forceinline__ int perm32(int rho) { const int n = rho >> 4, i = rho & 15; return 8 * (i >> 2) + 4 * n + (i & 3); }

struct Unit { int pm, pn, po; };
struct Gemm { const bf16_t* A; const bf16_t* Bt; int M, N, K; int sw, sa; };
typedef int i32x8 __attribute__((ext_vector_type(8)));
typedef int i32x4v __attribute__((ext_vector_type(4)));
__device__ __forceinline__ i32x8 cat8(bf16x8 lo, bf16x8 hi) { return __builtin_shufflevector(__builtin_bit_cast(i32x4v, lo), __builtin_bit_cast(i32x4v, hi), 0, 1, 2, 3, 4, 5, 6, 7); }
__device__ __forceinline__ unsigned pk4fp8(f32x4 v) { int w = __builtin_amdgcn_cvt_pk_fp8_f32(v[0], v[1], 0, false); w = __builtin_amdgcn_cvt_pk_fp8_f32(v[2], v[3], w, true); return (unsigned)w; }

struct StaticOrder {
    int nM, nN, nwg, G, c;
    __host__ __device__ void init(int M, int N, int G_, int c_) { nM = M / BM; nN = N / BM; nwg = nM * nN; G = G_; c = c_; }
    __host__ __device__ bool next(int i, Unit& u) const {
        const long L = (long)i * G + c; if (L >= nwg) return false;
        int wgid = (int)L; { const int q = nwg / NXCD, r = nwg % NXCD, xcd = wgid % NXCD, off = wgid / NXCD; wgid = (xcd < r ? xcd * (q + 1) : r * (q + 1) + (xcd - r) * q) + off; }
        const int nig = WGM * nN, gid = wgid / nig, fm = gid * WGM, gsz = (nM - fm) < WGM ? (nM - fm) : WGM;
        u.pm = fm + ((wgid % nig) % gsz); u.pn = (wgid % nig) / gsz; u.po = u.pm; return true;
    }
    __device__ __forceinline__ void a_ready(const Unit&) const {}
    __device__ __forceinline__ void done(const Unit&) const {}
};
struct ListOrder {
    int first, count, ncol, pn0;
    __device__ __forceinline__ bool next(int i, Unit& u) const { if (i >= count) return false; const int g = first + i; u.pm = g / ncol; u.pn = pn0 + g % ncol; u.po = u.pm; return true; }
    __device__ __forceinline__ void a_ready(const Unit&) const {}
    __device__ __forceinline__ void done(const Unit&) const {}
};
struct MoeOrder {
    int pp[9]; int nM, nN, nwg, G, c, astride;
    __device__ __forceinline__ void init(const unsigned* cnt, int NT, int G_, int c_, int astride_) {
        int a = 0;
#pragma unroll
        for (int e = 0; e < 8; ++e) { pp[e] = a; const unsigned n = (unsigned)__builtin_amdgcn_readfirstlane((int)__hip_atomic_load(cnt + e, RLX_AGENT)); a += (int)((n + 255u) >> 8); }
        pp[8] = a; nM = a; nN = NT; nwg = nM * nN; G = G_; c = c_; astride = astride_;
    }
    __device__ __forceinline__ bool next(int i, Unit& u) const {
        const long L = (long)i * G + c; if (L >= nwg) return false;
        int wgid = (int)L; { const int q = nwg / NXCD, r = nwg % NXCD, xcd = wgid % NXCD, off = wgid / NXCD; wgid = (xcd < r ? xcd * (q + 1) : r * (q + 1) + (xcd - r) * q) + off; }
        const int nig = WGM * nN, gid = wgid / nig, fm = gid * WGM, gsz = (nM - fm) < WGM ? (nM - fm) : WGM;
        const int vp = fm + ((wgid % nig) % gsz), t = (wgid % nig) / gsz;
        int e = 0, base = 0;
#pragma unroll
        for (int k = 1; k < 8; ++k) if (vp >= pp[k]) { e = k; base = pp[k]; }
        u.pm = astride ? e * astride + (vp - base) : vp; u.pn = e * nN + t; u.po = vp; return true;
    }
    __device__ __forceinline__ void a_ready(const Unit&) const {}
    __device__ __forceinline__ void done(const Unit&) const {}
};

template <class E> __device__ __forceinline__ void epi_rows(const E& e, const f32x4 (&acc)[2][2][4][2], const Unit& u, int wr, int wc, int fr, int fq) {
    asm volatile("" : "+v"(fr), "+v"(fq));
#pragma unroll
    for (int ai = 0; ai < 2; ++ai)
#pragma unroll
        for (int m = 0; m < 4; ++m) e.row8(u, ai * HALF + wr * 64 + m * 16 + fr, wc * 32 + 8 * fq, acc[ai][0][m][0], acc[ai][0][m][1], acc[ai][1][m][0], acc[ai][1][m][1]);
}
#define PG8_EPI_COMMON static constexpr bool PERM = true, AFTER_DRAIN = false, MID_HOOK = false; \
    __device__ __forceinline__ void operator()(const f32x4 (&acc)[2][2][4][2], const Unit& u, int wr, int wc, int fr, int fq) const { epi_rows(*this, acc, u, wr, wc, fr, fq); }
__device__ __forceinline__ void st8bf(bf16_t* p, f32x4 a, f32x4 b) { u32x4 w; w.x = pk2(a[0], a[1]); w.y = pk2(a[2], a[3]); w.z = pk2(b[0], b[1]); w.w = pk2(b[2], b[3]); *(u32x4*)p = w; }
__device__ __forceinline__ void ld8bf(const bf16_t* p, f32x4& a, f32x4& b) { const u32x4 w = *(const u32x4*)p; a = (f32x4){bflo(w.x), bfhi(w.x), bflo(w.y), bfhi(w.y)}; b = (f32x4){bflo(w.z), bfhi(w.z), bflo(w.w), bfhi(w.w)}; }
__device__ __forceinline__ f32x4 gelu4(f32x4 v) { return (f32x4){gelu_tanh_(v[0]), gelu_tanh_(v[1]), gelu_tanh_(v[2]), gelu_tanh_(v[3])}; }
__device__ __forceinline__ f32x4 sig4(f32x4 v) { return (f32x4){sigmoidf_(v[0]), sigmoidf_(v[1]), sigmoidf_(v[2]), sigmoidf_(v[3])}; }
__device__ __forceinline__ f32x4 silu4(f32x4 v) { return (f32x4){siluf_(v[0]), siluf_(v[1]), siluf_(v[2]), siluf_(v[3])}; }

struct EpiWin { PG8_EPI_COMMON
    unsigned char* R;
    __device__ __forceinline__ void row8(const Unit& u, int r, int cit, f32x4 a0, f32x4 a1, f32x4 b0, f32x4 b1) const {
        const size_t row = (size_t)u.po * BM + r; const int pn = u.pn;
        bf16_t* XR = (bf16_t*)R; bf16_t* GG = (bf16_t*)(R + (32u << 20)); bf16_t* Q = (bf16_t*)(R + (64u << 20)); bf16_t* KB = (bf16_t*)(R + (96u << 20)); bf16_t* VB = (bf16_t*)(R + (104u << 20)); bf16_t* GT = (bf16_t*)(R + (112u << 20));
        if (pn < 4)       { bf16_t* o = XR + row * 1024 + 256 * pn + cit; st8bf(o, a0, a1); st8bf(o + HALF, b0, b1); }
        else if (pn < 8)  { bf16_t* o = GG + row * 1024 + 256 * (pn - 4) + cit; st8bf(o, gelu4(a0), gelu4(a1)); st8bf(o + HALF, gelu4(b0), gelu4(b1)); }
        else if (pn < 12) { bf16_t* o = Q + row * 1024 + 256 * (pn - 8) + cit; st8bf(o, a0 * QSCALE, a1 * QSCALE); st8bf(o + HALF, b0 * QSCALE, b1 * QSCALE); }
        else if (pn == 12) { bf16_t* o = KB + row * 256 + cit; st8bf(o, a0, a1); st8bf(o + HALF, b0, b1); }
        else if (pn == 13) { bf16_t* o = VB + row * 256 + cit; st8bf(o, a0, a1); st8bf(o + HALF, b0, b1); }
        else { bf16_t* o = GT + row * 2048 + 256 * (pn - 14) + cit; st8bf(o, sig4(a0), sig4(a1)); st8bf(o + HALF, sig4(b0), sig4(b1)); }
    }
};
struct EpiMerge {
    static constexpr bool PERM = true, AFTER_DRAIN = false, MID_HOOK = true;
    unsigned char* R;
    __device__ __forceinline__ void operator()(const f32x4 (&acc)[2][2][4][2], const Unit& u, int wr, int wc, int fr, int fq) const { epi_rows(*this, acc, u, wr, wc, fr, fq); }
    __device__ __forceinline__ void mid(f32x4 (&acc)[2][2][4][2], const Unit& u, int wr, int wc, int fr, int fq) const {
        asm volatile("" : "+v"(fr), "+v"(fq));
        const bf16_t* GT = (const bf16_t*)(R + (112u << 20));
#pragma unroll
        for (int ai = 0; ai < 2; ++ai)
#pragma unroll
            for (int m = 0; m < 4; ++m) { const size_t row = (size_t)u.po * BM + ai * HALF + wr * 64 + m * 16 + fr;
#pragma unroll
                for (int bj = 0; bj < 2; ++bj) { const int c = 256 * u.pn + bj * HALF + wc * 32 + 8 * fq; f32x4 g0a, g0b, g1a, g1b; ld8bf(GT + row * 2048 + c, g0a, g0b); ld8bf(GT + row * 2048 + 1024 + c, g1a, g1b);
#pragma unroll
                    for (int i = 0; i < 4; ++i) { acc[ai][bj][m][0][i] *= g0a[i] * frcp(fmaxf(g1a[i], 1e-30f)); acc[ai][bj][m][1][i] *= g0b[i] * frcp(fmaxf(g1b[i], 1e-30f)); } } }
    }
    __device__ __forceinline__ void row8(const Unit& u, int r, int cit, f32x4 a0, f32x4 a1, f32x4 b0, f32x4 b1) const {
        const size_t row = (size_t)u.po * BM + r; const int c = 256 * u.pn + cit;
        const bf16_t* GT = (const bf16_t*)(R + (112u << 20)); bf16_t* MG = (bf16_t*)(R + (304u << 20));
        f32x4 g0, g1; ld8bf(GT + row * 2048 + 1024 + c, g0, g1); st8bf(MG + row * 1024 + c, g0 * a0, g1 * a1);
        ld8bf(GT + row * 2048 + 1024 + c + HALF, g0, g1); st8bf(MG + row * 1024 + c + HALF, g0 * b0, g1 * b1);
    }
};
struct EpiBf16N { PG8_EPI_COMMON
    bf16_t* O;
    __device__ __forceinline__ void row8(const Unit& u, int r, int cit, f32x4 a0, f32x4 a1, f32x4 b0, f32x4 b1) const {
        bf16_t* o = O + ((size_t)u.po * BM + r) * 1024 + 256 * u.pn + cit; st8bf(o, a0, a1); st8bf(o + HALF, b0, b1);
    }
};
struct EpiF32 { PG8_EPI_COMMON
    float* O;
    __device__ __forceinline__ void row8(const Unit& u, int r, int cit, f32x4 a0, f32x4 a1, f32x4 b0, f32x4 b1) const {
        float* o = O + ((size_t)u.po * BM + r) * 1024 + 256 * u.pn + cit; *(f32x4*)o = a0; *(f32x4*)(o + 4) = a1; *(f32x4*)(o + HALF) = b0; *(f32x4*)(o + HALF + 4) = b1;
    }
};
struct EpiSwiglu { PG8_EPI_COMMON
    bf16_t* O; int ldc, ntile;
    __device__ __forceinline__ void row8(const Unit& u, int r, int cit, f32x4 a0, f32x4 a1, f32x4 b0, f32x4 b1) const {
        st8bf(O + ((size_t)u.po * BM + r) * ldc + HALF * (u.pn % ntile) + cit, silu4(a0) * b0, silu4(a1) * b1);
    }
};
struct EpiSwiglu8 { PG8_EPI_COMMON
    unsigned char* O; int ldc, ntile;
    __device__ __forceinline__ void row8(const Unit& u, int r, int cit, f32x4 a0, f32x4 a1, f32x4 b0, f32x4 b1) const {
        u32x2 w; w.x = pk4fp8(silu4(a0) * b0); w.y = pk4fp8(silu4(a1) * b1); *(u32x2*)(O + ((size_t)u.po * BM + r) * ldc + HALF * (u.pn % ntile) + cit) = w;
    }
};
struct EpiBf16Mod4 { PG8_EPI_COMMON
    bf16_t* O;
    __device__ __forceinline__ void row8(const Unit& u, int r, int cit, f32x4 a0, f32x4 a1, f32x4 b0, f32x4 b1) const {
        bf16_t* o = O + ((size_t)u.po * BM + r) * 1024 + 256 * (u.pn & 3) + cit; st8bf(o, a0, a1); st8bf(o + HALF, b0, b1);
    }
};


struct PanelSS {
    float* xbuf;
    unsigned* cnt;
    unsigned* tmo;
    __device__ __forceinline__ void run(const f32x4 (&v)[2][2][4][2], const Unit& u, int wr, int wc, int fr, int fq, PG8_LAS unsigned char* lds, int wid, int lane) const {
        PG8_LAS float* P = (PG8_LAS float*)lds;
        PG8_LAS float* S = (PG8_LAS float*)(lds + 8192);
        PG8_LAS unsigned* flag = (PG8_LAS unsigned*)(lds + 8192 + 2048);
#pragma unroll
        for (int ai = 0; ai < 2; ++ai)
#pragma unroll
            for (int m = 0; m < 4; ++m) { float s = 0.f;
#pragma unroll
                for (int bj = 0; bj < 2; ++bj)
#pragma unroll
                    for (int n = 0; n < 2; ++n) { const f32x4 x = v[ai][bj][m][n]; s += (x[0] * x[0] + x[1] * x[1]) + (x[2] * x[2] + x[3] * x[3]); }
                s += __shfl_xor(s, 16); s += __shfl_xor(s, 32);
                if (fq == 0) P[(ai * HALF + wr * 64 + m * 16 + fr) * 4 + wc] = s; }
        asm volatile("s_waitcnt lgkmcnt(0)" ::: "memory"); __builtin_amdgcn_s_barrier(); asm volatile("" ::: "memory");
        const int row = wid * 32 + (lane & 31);
        if (lane < 32) { const f32x4 p = *(const PG8_LAS f32x4*)(P + row * 4);
            __hip_atomic_store((unsigned*)xbuf + ((size_t)(u.pm * BM + row) * 4 + u.pn), __float_as_uint((p[0] + p[1]) + (p[2] + p[3])), __ATOMIC_RELAXED, __HIP_MEMORY_SCOPE_AGENT); }
        asm volatile("s_waitcnt vmcnt(0)" ::: "memory");
        if (lane == 0) __hip_atomic_fetch_add(cnt + 64 * u.pm, 1u, __ATOMIC_RELAXED, __HIP_MEMORY_SCOPE_AGENT);
        if (wid == 0) {
            const unsigned long long t0 = __builtin_amdgcn_s_memrealtime();
            for (;;) {
                if ((unsigned)__builtin_amdgcn_readfirstlane((int)__hip_atomic_load(cnt + 64 * u.pm, __ATOMIC_RELAXED, __HIP_MEMORY_SCOPE_AGENT)) >= 32u) break;
                if (__builtin_amdgcn_s_memrealtime() - t0 > 2000000ull) { if (lane == 0) __hip_atomic_store(tmo, 1u, __ATOMIC_RELAXED, __HIP_MEMORY_SCOPE_AGENT); break; }
                __builtin_amdgcn_s_sleep(2);
            }
            __builtin_amdgcn_fence(__ATOMIC_ACQUIRE, "agent");
            if (lane == 0) flag[0] = 0u;
        }
        asm volatile("s_waitcnt vmcnt(0) lgkmcnt(0)" ::: "memory"); __builtin_amdgcn_s_barrier(); asm volatile("" ::: "memory");
        if (lane < 32) { const unsigned* slot = (const unsigned*)xbuf + (size_t)(u.pm * BM + row) * 4; float t = 0.f;
#pragma unroll
            for (int k = 0; k < 4; ++k) t += __uint_as_float(__hip_atomic_load(slot + k, __ATOMIC_RELAXED, __HIP_MEMORY_SCOPE_AGENT));
            S[row] = rsqrtf(t * (1.0f / 1024.0f) + 1e-6f); }
        asm volatile("s_waitcnt lgkmcnt(0)" ::: "memory"); __builtin_amdgcn_s_barrier(); asm volatile("" ::: "memory");
    }
};
struct EpiRmsResRms {
    static constexpr bool PERM = true, AFTER_DRAIN = true, MID_HOOK = false;
    const float* xin32; const bf16_t* xin16;
    bf16_t* XB; bf16_t* XN; int xn_fp8;
    const float *gainA, *gateA, *gainB, *scB, *shB;
    PanelSS st1, st2;
    __device__ __forceinline__ void fused(f32x4 (&acc)[2][2][4][2], const Unit& u, int wr, int wc, int fr, int fq, PG8_LAS unsigned char* lds, int wid, int lane) const {
        asm volatile("" : "+v"(fr), "+v"(fq));
        const PG8_LAS float* S = (const PG8_LAS float*)(lds + 8192);
        const int bofs = (((u.pm * BM) >> 13) != 0) ? 6144 : 0;
        const int col0 = 256 * u.pn + wc * 32 + 8 * fq;
        st1.run(acc, u, wr, wc, fr, fq, lds, wid, lane);
        { f32x4 cA[2][2];
#pragma unroll
          for (int bj = 0; bj < 2; ++bj)
#pragma unroll
            for (int n = 0; n < 2; ++n) cA[bj][n] = *(const f32x4*)(gainA + col0 + bj * HALF + 4 * n) * *(const f32x4*)(gateA + bofs + col0 + bj * HALF + 4 * n);
#pragma unroll
          for (int ai = 0; ai < 2; ++ai)
#pragma unroll
            for (int m = 0; m < 4; ++m) { const int r = ai * HALF + wr * 64 + m * 16 + fr; const float rs = S[r]; const size_t off = (size_t)(u.pm * BM + r) * 1024 + col0;
#pragma unroll
                for (int bj = 0; bj < 2; ++bj) { f32x4 x0, x1;
                    if (xin32) { x0 = *(const f32x4*)(xin32 + off + bj * HALF); x1 = *(const f32x4*)(xin32 + off + bj * HALF + 4); } else ld8bf(xin16 + off + bj * HALF, x0, x1);
                    acc[ai][bj][m][0] = x0 + cA[bj][0] * (acc[ai][bj][m][0] * rs); acc[ai][bj][m][1] = x1 + cA[bj][1] * (acc[ai][bj][m][1] * rs);
                    st8bf(XB + off + bj * HALF, acc[ai][bj][m][0], acc[ai][bj][m][1]); }
                asm volatile("" : "+v"(acc[ai][0][m][0]), "+v"(acc[ai][0][m][1]), "+v"(acc[ai][1][m][0]), "+v"(acc[ai][1][m][1])); } }
        st2.run(acc, u, wr, wc, fr, fq, lds, wid, lane);
        { f32x4 cB[2][2], cC[2][2];
#pragma unroll
          for (int bj = 0; bj < 2; ++bj)
#pragma unroll
            for (int n = 0; n < 2; ++n) { cB[bj][n] = *(const f32x4*)(gainB + col0 + bj * HALF + 4 * n) * (*(const f32x4*)(scB + bofs + col0 + bj * HALF + 4 * n) + 1.0f); cC[bj][n] = *(const f32x4*)(shB + bofs + col0 + bj * HALF + 4 * n); }
#pragma unroll
          for (int ai = 0; ai < 2; ++ai)
#pragma unroll
            for (int m = 0; m < 4; ++m) { const int r = ai * HALF + wr * 64 + m * 16 + fr; const float rs = S[r]; const size_t off = (size_t)(u.pm * BM + r) * 1024 + col0;
#pragma unroll
                for (int bj = 0; bj < 2; ++bj) { const f32x4 h0 = acc[ai][bj][m][0] * rs * cB[bj][0] + cC[bj][0], h1 = acc[ai][bj][m][1] * rs * cB[bj][1] + cC[bj][1];
                    if (xn_fp8) { u32x2 w; w.x = pk4fp8(h0); w.y = pk4fp8(h1); *(u32x2*)((unsigned char*)XN + off + bj * HALF) = w; } else st8bf(XN + off + bj * HALF, h0, h1); } } }
    }
};
template <class Epi, class Sched>
__device__ __forceinline__ void gemm_phase_naive(const Gemm g, const Sched& S, const Epi& E) {
    Unit u;
    for (int i = 0; S.next(i, u); ++i) {
        for (int idx = threadIdx.x; idx < 256 * 16; idx += blockDim.x) {
            const int r = idx >> 4, cit = (idx & 15) * 8;
            const bf16_t* a = g.A + ((size_t)u.pm * BM + r) * g.K;
            float o[16];
#pragma unroll
            for (int j = 0; j < 16; ++j) o[j] = 0.f;
            for (int k = 0; k < g.K; k += 8) {
                f32x4 x0, x1; ld8bf(a + k, x0, x1);
#pragma unroll
                for (int j = 0; j < 16; ++j) { const bf16_t* b = g.Bt + ((size_t)u.pn * BM + (j >> 3) * HALF + cit + (j & 7)) * g.K + k; f32x4 y0, y1; ld8bf(b, y0, y1);
                    o[j] += x0[0] * y0[0] + x0[1] * y0[1] + x0[2] * y0[2] + x0[3] * y0[3] + x1[0] * y1[0] + x1[1] * y1[1] + x1[2] * y1[2] + x1[3] * y1[3]; }
            }
            E.row8(u, r, cit, (f32x4){o[0], o[1], o[2], o[3]}, (f32x4){o[4], o[5], o[6], o[7]}, (f32x4){o[8], o[9], o[10], o[11]}, (f32x4){o[12], o[13], o[14], o[15]});
        }
    }
}

template <class Epi, class Sched, bool ALIGN_EPI = false, bool SP2 = false, bool FP8 = false>
__device__ __forceinline__ void gemm_phase(PG8_LAS unsigned char* lds, const Gemm g, const Sched& S, const Epi& E) {
    int tid_ = threadIdx.x; asm volatile("" : "+v"(tid_));
    const int tid = tid_, wid = __builtin_amdgcn_readfirstlane(tid >> 6), lane = tid & 63, wr = wid >> 2, wc = wid & 3, fr = lane & 15, fq = lane >> 4;
    constexpr int ESZ = FP8 ? 1 : 2;
    const int K = g.K, nt = K * ESZ / (BK * 2);
    unsigned voffA[2], voffB[2];
#pragma unroll
    for (int i = 0; i < 2; ++i) { int R, C; stage_rc(tid * 16 + i * 8192, R, C); const int Rb = Epi::PERM ? ((R & ~31) + perm32(R & 31)) : R;
        voffA[i] = (unsigned)(R * K * ESZ + C * 2); voffB[i] = (unsigned)(Rb * K * ESZ + C * 2); }
    const size_t kstep = (size_t)(BK * 2);
    const size_t hstep = (size_t)HALF * K * ESZ;
    const size_t tstep = 2 * hstep;
    const unsigned ldsw = (unsigned)wid * 1024u;
    const int aoff = lds_byte(wr * 64 + fr, FP8 ? fq * 16 : fq * 8), boff = lds_byte(wc * 32 + fr, FP8 ? fq * 16 : fq * 8);
#define PG8_SA(b, h) (((b) * 2 + (h)) * HTB)
#define PG8_SB(b, h) ((4 + (b) * 2 + (h)) * HTB)
#define PG8_STAGE(bufoff, gbase, voff) do { _Pragma("unroll") for (int _i = 0; _i < 2; ++_i) \
        __builtin_amdgcn_global_load_lds((const unsigned*)((const char*)(gbase) + (voff)[_i]), (PG8_LAS unsigned*)(lds + (bufoff) + ldsw + _i * 8192), 16, 0, 0); } while (0)
#define PG8_LDA(dst, b, h) do { _Pragma("unroll") for (int m = 0; m < 4; ++m) { if constexpr (FP8) dst##8[m] = cat8(*(const PG8_LAS bf16x8*)(lds + PG8_SA(b, h) + aoff + m * 2048), *(const PG8_LAS bf16x8*)(lds + PG8_SA(b, h) + aoff + m * 2048 + 16)); \
        else { _Pragma("unroll") for (int k = 0; k < 2; ++k) dst[m][k] = *(const PG8_LAS bf16x8*)(lds + PG8_SA(b, h) + aoff + m * 2048 + k * 1024); } } } while (0)
#define PG8_LDB(dst, b, h) do { _Pragma("unroll") for (int n = 0; n < 2; ++n) { if constexpr (FP8) dst##8[n] = cat8(*(const PG8_LAS bf16x8*)(lds + PG8_SB(b, h) + boff + n * 2048), *(const PG8_LAS bf16x8*)(lds + PG8_SB(b, h) + boff + n * 2048 + 16)); \
        else { _Pragma("unroll") for (int k = 0; k < 2; ++k) dst[n][k] = *(const PG8_LAS bf16x8*)(lds + PG8_SB(b, h) + boff + n * 2048 + k * 1024); } } } while (0)
#define PG8_MMA(ai, bj, At, Bt) do { __builtin_amdgcn_s_setprio(1); _Pragma("unroll") for (int m = 0; m < 4; ++m) _Pragma("unroll") for (int n = 0; n < 2; ++n) { \
        if constexpr (FP8) asm volatile("v_mfma_scale_f32_16x16x128_f8f6f4 %0, %1, %2, %0, %3, %4 op_sel_hi:[0,0,0]" : "+v"(acc[ai][bj][m][n]) : "v"(Bt##8[n]), "v"(At##8[m]), "v"(sw_), "v"(sa_)); \
        else { _Pragma("unroll") for (int k = 0; k < 2; ++k) acc[ai][bj][m][n] = __builtin_amdgcn_mfma_f32_16x16x32_bf16(Bt[n][k], At[m][k], acc[ai][bj][m][n], 0, 0, 0); } } \
        __builtin_amdgcn_s_setprio(0); } while (0)
#define PG8_WAIT_V(n) asm volatile("s_waitcnt vmcnt(" #n ")" ::: "memory")
#define PG8_WAIT_L(n) asm volatile("s_waitcnt lgkmcnt(" #n ")" ::: "memory")
#define PG8_BAR __builtin_amdgcn_s_barrier()
#define PG8_SCHED __builtin_amdgcn_sched_barrier(0)
    Unit cur, nxt; int ui = 0;
    if (!S.next(0, cur)) return;
    f32x4 acc[2][2][4][2];
#pragma unroll
    for (int a = 0; a < 2; ++a)
#pragma unroll
        for (int b = 0; b < 2; ++b)
#pragma unroll
            for (int m = 0; m < 4; ++m)
#pragma unroll
                for (int n = 0; n < 2; ++n) acc[a][b][m][n] = (f32x4){0.f, 0.f, 0.f, 0.f};
    const int sw_ = g.sw, sa_ = g.sa;
    bf16x8 At[4][2], B0[2][2], B1[2][2]; i32x8 At8[4], B08[2], B18[2];
    const char* cA = (const char*)g.A + (size_t)cur.pm * tstep; const char* cB = (const char*)g.Bt + (size_t)cur.pn * tstep;
    S.a_ready(cur);
    if constexpr (SP2) {
        PG8_STAGE(PG8_SB(0, 0), cB, voffB); PG8_STAGE(PG8_SB(0, 1), cB + hstep, voffB); PG8_STAGE(PG8_SA(0, 0), cA, voffA); PG8_STAGE(PG8_SA(0, 1), cA + hstep, voffA);
        if (wr == 1) PG8_BAR;
        PG8_WAIT_V(2); PG8_BAR;
        PG8_STAGE(PG8_SB(1, 0), cB + kstep, voffB); PG8_STAGE(PG8_SA(1, 0), cA + kstep, voffA); PG8_STAGE(PG8_SB(1, 1), cB + hstep + kstep, voffB);
        PG8_WAIT_V(6); PG8_BAR;
    } else {
        PG8_STAGE(PG8_SB(0, 0), cB, voffB); PG8_STAGE(PG8_SA(0, 0), cA, voffA); PG8_STAGE(PG8_SB(0, 1), cB + hstep, voffB); PG8_STAGE(PG8_SA(0, 1), cA + hstep, voffA);
        if (wr == 1) PG8_BAR;
        PG8_WAIT_V(4); PG8_BAR;
        PG8_STAGE(PG8_SB(1, 0), cB + kstep, voffB); PG8_STAGE(PG8_SA(1, 0), cA + kstep, voffA); PG8_STAGE(PG8_SB(1, 1), cB + hstep + kstep, voffB);
        PG8_WAIT_V(6); PG8_BAR;
    }
    for (;;) {
        const bool has_next = S.next(ui + 1, nxt);
        const char* nA = has_next ? (const char*)g.A + (size_t)nxt.pm * tstep : cA; const char* nB = has_next ? (const char*)g.Bt + (size_t)nxt.pn * tstep : cB;
        for (int t = 0; t < nt; t += 2) {
            if constexpr (Epi::MID_HOOK && HOOK_ON) { if (t == (nt >> 1)) E.mid(acc, cur, wr, wc, fr, fq); }
            const bool last = (t == nt - 2);
            const char* a1 = cA + (size_t)(t + 1) * kstep;
            const char* a2 = last ? nA : cA + (size_t)(t + 2) * kstep; const char* b2 = last ? nB : cB + (size_t)(t + 2) * kstep;
            const char* a3 = a2 + kstep; const char* b3 = b2 + kstep;
            if (last && has_next) S.a_ready(nxt);
            if constexpr (SP2) {
            PG8_LDB(B0, 0, 0); PG8_LDB(B1, 0, 1); PG8_SCHED; PG8_LDA(At, 0, 0); PG8_STAGE(PG8_SA(1, 1), a1 + hstep, voffA);
            PG8_WAIT_V(8); PG8_WAIT_L(0); PG8_BAR; PG8_MMA(0, 0, At, B0); PG8_MMA(0, 1, At, B1); PG8_BAR; PG8_SCHED;
            PG8_LDA(At, 0, 1); PG8_STAGE(PG8_SB(0, 0), b2, voffB); PG8_STAGE(PG8_SB(0, 1), b2 + hstep, voffB); PG8_STAGE(PG8_SA(0, 0), a2, voffA);
            PG8_WAIT_V(8); PG8_WAIT_L(0); PG8_BAR; PG8_MMA(1, 0, At, B0); PG8_MMA(1, 1, At, B1); PG8_BAR; PG8_SCHED;
            PG8_LDB(B0, 1, 0); PG8_LDB(B1, 1, 1); PG8_SCHED; PG8_LDA(At, 1, 0); PG8_STAGE(PG8_SA(0, 1), a2 + hstep, voffA);
            PG8_WAIT_V(8); PG8_WAIT_L(0); PG8_BAR; PG8_MMA(0, 0, At, B0); PG8_MMA(0, 1, At, B1); PG8_BAR; PG8_SCHED;
            PG8_LDA(At, 1, 1); PG8_STAGE(PG8_SB(1, 0), b3, voffB); PG8_STAGE(PG8_SB(1, 1), b3 + hstep, voffB); PG8_STAGE(PG8_SA(1, 0), a3, voffA);
            PG8_WAIT_V(8); PG8_WAIT_L(0); PG8_BAR; PG8_MMA(1, 0, At, B0); PG8_MMA(1, 1, At, B1); PG8_BAR; PG8_SCHED;
            } else {
            PG8_LDB(B0, 0, 0); PG8_SCHED; PG8_LDA(At, 0, 0); PG8_STAGE(PG8_SA(1, 1), a1 + hstep, voffA);
            PG8_WAIT_L(8); PG8_BAR; PG8_WAIT_L(0); PG8_MMA(0, 0, At, B0); PG8_BAR; PG8_SCHED;
            PG8_LDB(B1, 0, 1); PG8_STAGE(PG8_SB(0, 0), b2, voffB);
            PG8_BAR; PG8_WAIT_L(0); PG8_MMA(0, 1, At, B1); PG8_BAR;
            PG8_LDA(At, 0, 1); PG8_STAGE(PG8_SA(0, 0), a2, voffA);
            PG8_BAR; PG8_WAIT_L(0); PG8_MMA(1, 0, At, B0); PG8_BAR; PG8_SCHED;
            PG8_STAGE(PG8_SB(0, 1), b2 + hstep, voffB);
            PG8_WAIT_V(6); PG8_BAR; PG8_MMA(1, 1, At, B1); PG8_BAR;
            PG8_LDB(B0, 1, 0); PG8_SCHED; PG8_LDA(At, 1, 0); PG8_STAGE(PG8_SA(0, 1), a2 + hstep, voffA);
            PG8_WAIT_L(8); PG8_BAR; PG8_WAIT_L(0); PG8_MMA(0, 0, At, B0); PG8_BAR; PG8_SCHED;
            PG8_LDB(B1, 1, 1); PG8_STAGE(PG8_SB(1, 0), b3, voffB);
            PG8_BAR; PG8_WAIT_L(0); PG8_MMA(0, 1, At, B1); PG8_BAR;
            PG8_LDA(At, 1, 1); PG8_STAGE(PG8_SA(1, 0), a3, voffA);
            PG8_BAR; PG8_WAIT_L(0); PG8_MMA(1, 0, At, B0); PG8_BAR; PG8_SCHED;
            PG8_STAGE(PG8_SB(1, 1), b3 + hstep, voffB);
            PG8_WAIT_V(6); PG8_BAR; PG8_MMA(1, 1, At, B1); PG8_BAR;
            }
        }
        if constexpr (ALIGN_EPI) { if (wr == 0) PG8_BAR; }
        if constexpr (FP8) asm volatile("s_nop 15\n\ts_nop 15" ::: "memory");
        if constexpr (!Epi::AFTER_DRAIN) { E(acc, cur, wr, wc, fr, fq); S.done(cur); }
        if (!has_next) break;
#pragma unroll
        for (int a = 0; a < 2; ++a)
#pragma unroll
            for (int b = 0; b < 2; ++b)
#pragma unroll
                for (int m = 0; m < 4; ++m)
#pragma unroll
                    for (int n = 0; n < 2; ++n) acc[a][b][m][n] = (f32x4){0.f, 0.f, 0.f, 0.f};
        cur = nxt; cA = nA; cB = nB; ++ui;
        if constexpr (ALIGN_EPI) { if (wr == 1) PG8_BAR; }
    }
    PG8_WAIT_V(0);
    if constexpr (!ALIGN_EPI) { if (wr == 0) PG8_BAR; }
    PG8_BAR;
    if constexpr (Epi::AFTER_DRAIN) { if constexpr (FP8) asm volatile("s_nop 15\n\ts_nop 15" ::: "memory"); E.fused(acc, cur, wr, wc, fr, fq, lds, wid, lane); S.done(cur); }
#undef PG8_SA
#undef PG8_SB
#undef PG8_STAGE
#undef PG8_LDA
#undef PG8_LDB
#undef PG8_MMA
#undef PG8_WAIT_V
#undef PG8_WAIT_L
#undef PG8_BAR
#undef PG8_SCHED
}
}

constexpr int NWAVES = 8;
constexpr size_t MiB = 1u << 20;
constexpr size_t WS_CTL = 0, CTL_ZERO_BYTES = 1 * MiB;
constexpr size_t WS_ADA = 1 * MiB;
constexpr size_t WS_RAGG = 2 * MiB;
constexpr size_t WS_MIX = 288 * MiB; constexpr size_t WS_T16 = WS_MIX;
constexpr size_t WS_TOK = 3 * MiB;
constexpr size_t WS_WL = 4 * MiB, WL_STRIDE = 18 * MiB;
constexpr size_t WL_WIN = 0, WL_WB = 11 * MiB, WL_WO = 15 * MiB, WL_WRA = 17 * MiB, WL_WRX = 17 * MiB + 256 * 1024;
constexpr size_t WS_WD = 76 * MiB, WD_STRIDE = 18 * MiB;
constexpr size_t WD_FIN = 0, WD_FOUT = 12 * MiB;
constexpr size_t WS_WM = 112 * MiB, WM_STRIDE = 72 * MiB;
constexpr size_t WM_MIN = 0, WM_MOUT = 48 * MiB;
constexpr size_t WS_XN = 256 * MiB;
constexpr size_t WS_R = 352 * MiB;
constexpr size_t WS_XR = WS_R, WS_GG = WS_R + 32 * MiB, WS_Q = WS_R + 64 * MiB, WS_KB = WS_R + 96 * MiB, WS_VB = WS_R + 104 * MiB, WS_GT = WS_R + 112 * MiB;
constexpr size_t WS_RO = WS_R + 176 * MiB, WS_AO = WS_R + 208 * MiB, WS_MGP = WS_R + 240 * MiB, WS_MG = WS_R + 304 * MiB;
constexpr size_t WS_PS = WS_MGP;
constexpr size_t WS_XC = WS_MG;
constexpr size_t WS_ACT = WS_R;
constexpr size_t WS_AP = WS_R;
constexpr size_t WS_YP = WS_R;
constexpr size_t WS_ACTP = WS_R + 256 * MiB;
constexpr size_t WS_XB = WS_ACTP + 102 * MiB;
constexpr size_t WS_XS = WS_XB + 32 * MiB;
constexpr size_t WS_END = WS_XS + 2 * MiB;
constexpr int MAXPANELS = 136;

constexpr int CW_CNT = 64;
constexpr int CW_BAR = 4096;
constexpr int CW_SEAM = 16384, SEAM_BANK = 8192;
static_assert((CW_SEAM + 8 * SEAM_BANK) * 4 <= (int)CTL_ZERO_BYTES, "panel counters inside the memset region");

constexpr int RING_OFF = 0, RING_BYTES = 139264;
constexpr int LDSCTL_OFF = RING_BYTES, MISC_OFF = LDSCTL_OFF + 320;
constexpr int LDS_BYTES = 147456;

#define XB_TMO      128
#define XB_XCNT(j)  (256  + 64 * (j))
#define XB_XSUB(j)  (1280 + 64 * (j))
#define XB_XGEN(j)  (2304 + 64 * (j))
#define XB_TOP      3328
#define XB_TOPGEN   3392
#define XCD_BAR_WORDS 3456
#define XB_SPIN_CAP (1u << 18)

__device__ __forceinline__ unsigned xb_ld(unsigned* p)              { return __hip_atomic_load(p, __ATOMIC_RELAXED, __HIP_MEMORY_SCOPE_AGENT); }
__device__ __forceinline__ unsigned xb_add(unsigned* p, unsigned v) { return __hip_atomic_fetch_add(p, v, __ATOMIC_RELAXED, __HIP_MEMORY_SCOPE_AGENT); }
__device__ __forceinline__ unsigned xb_xcc_id() { return (unsigned)__builtin_amdgcn_s_getreg((3 << 11) | 20) & 0xFu; }
#define XB_SPIN(cond, bar) do { unsigned _sp = 0; while (cond) { __builtin_amdgcn_s_sleep(1); \
    if ((++_sp & 255u) == 0u) { if (xb_ld(&(bar)[XB_TMO])) break; if (_sp > XB_SPIN_CAP) { atomicAdd(&(bar)[XB_TMO], 1u); break; } } } } while (0)

struct XcdBarrier {
    unsigned* bar; unsigned x;
    volatile LAS unsigned* st;
};

__device__ __forceinline__ XcdBarrier xcd_barrier_post(unsigned* bar, volatile LAS unsigned* st) {
    XcdBarrier b; b.bar = bar; b.x = xb_xcc_id(); b.st = st;
    if (threadIdx.x == 0) (void)xb_add(&bar[XB_XCNT(b.x)], 1u);
    return b;
}
__device__ __forceinline__ void xcd_barrier_complete(unsigned* bar, unsigned x, unsigned& nloc, unsigned& nx) {
    const unsigned G = gridDim.x * gridDim.y * gridDim.z;
    unsigned sum, cnt, mine, sp = 0u;
    for (;;) {
        sum = 0u; cnt = 0u; mine = 0u;
#pragma unroll
        for (unsigned j = 0; j < 16; ++j) { const unsigned c = xb_ld(&bar[XB_XCNT(j)]); sum += c; cnt += (c > 0u) ? 1u : 0u; mine = (j == x) ? c : mine; }
        if (sum == G) break;
        __builtin_amdgcn_s_sleep(1);
        if ((++sp & 255u) == 0u) { if (xb_ld(&bar[XB_TMO])) break; if (sp > XB_SPIN_CAP) { atomicAdd(&bar[XB_TMO], 1u); break; } }
    }
    nloc = mine > 0u ? mine : 1u; nx = cnt > 0u ? cnt : 1u;
}

__device__ __forceinline__ void xcd_barrier(const XcdBarrier& b) {
    asm volatile("s_waitcnt vmcnt(0)" ::: "memory");
    __syncthreads();
    if (threadIdx.x == 0) {
        unsigned* bar = b.bar;
        __builtin_amdgcn_s_waitcnt(0);
        unsigned nloc = b.st[0], nx = b.st[1];
        if (nloc == 0u) { xcd_barrier_complete(bar, b.x, nloc, nx); b.st[0] = nloc; b.st[1] = nx; }
        const unsigned old = xb_add(&bar[XB_XSUB(b.x)], 1u);
        const unsigned gen = old / nloc;
        if (old + 1u == (gen + 1u) * nloc) {
            __builtin_amdgcn_fence(__ATOMIC_RELEASE, "agent");
            asm volatile("s_waitcnt vmcnt(0)" ::: "memory");
            const unsigned og = xb_add(&bar[XB_TOP], 1u);
            const unsigned tg = og / nx;
            if (og + 1u == (tg + 1u) * nx) xb_add(&bar[XB_TOPGEN], 1u);
            else XB_SPIN(xb_ld(&bar[XB_TOPGEN]) == tg, bar);
            __builtin_amdgcn_fence(__ATOMIC_ACQUIRE, "agent");
            xb_add(&bar[XB_XGEN(b.x)], 1u);
            asm volatile("s_waitcnt vmcnt(0)" ::: "memory");
        } else {
            XB_SPIN(xb_ld(&bar[XB_XGEN(b.x)]) == gen, bar);
            __builtin_amdgcn_fence(__ATOMIC_ACQUIRE, "agent");
            asm volatile("s_waitcnt vmcnt(0)" ::: "memory");
        }
    }
    __syncthreads();
}
struct Args { const float* in[24]; float* out; unsigned char* ws; int ph_lo, ph_hi; };
typedef const __attribute__((address_space(4))) unsigned char* kargp_t;
DI kargp_t kargs() { kargp_t p = (kargp_t)__builtin_amdgcn_kernarg_segment_ptr(); asm volatile("" : "+s"(p)); return p; }
DI const float* karg_in(kargp_t p, int i) { return *(const float* const __attribute__((address_space(4)))*)(p + 8 * i); }
DI float* karg_out(kargp_t p) { return *(float* const __attribute__((address_space(4)))*)(p + 192); }
DI unsigned char* karg_ws(kargp_t p) { return *(unsigned char* const __attribute__((address_space(4)))*)(p + 200); }
static_assert(sizeof(Args) == 216, "kernarg offsets");

DI void p0_transpose_item(const float* W, int K, int N, bf16* WT, int mode, int H, LAS float* scr, int item, int lane, int ldk = 0, float mult = 1.0f) {
    if (ldk == 0) ldk = K;
    const int nblk = N / 32, kb = item / nblk, nb = item % nblk, k0 = 64 * kb, n0 = 32 * nb;
    int dr0 = n0;
    if (mode == 1) { if (n0 < H) dr0 = (n0 >> 7) * 256 + (n0 & 127); else { const int n1 = n0 - H; dr0 = (n1 >> 7) * 256 + 128 + (n1 & 127); } }
    { float wv[32];
#pragma unroll
      for (int i = 0; i < 32; ++i) wv[i] = __builtin_nontemporal_load(W + (size_t)(k0 + 2 * i + (lane >> 5)) * N + n0 + (lane & 31));
#pragma unroll
      for (int i = 0; i < 32; ++i) scr[(2 * i + (lane >> 5)) * 33 + (lane & 31)] = wv[i] * mult; }
    LDS_WAIT(); asm volatile("" ::: "memory");
    const int c = lane & 7;
#pragma unroll
    for (int j = 0; j < 4; ++j) { const int n = (lane >> 3) + 8 * j; const LAS float* s = scr + (8 * c) * 33 + n;
        u32x4 o; o.x = pk2(s[0 * 33], s[1 * 33]); o.y = pk2(s[2 * 33], s[3 * 33]); o.z = pk2(s[4 * 33], s[5 * 33]); o.w = pk2(s[6 * 33], s[7 * 33]);
        *(GAS u32x4*)(WT + (size_t)(dr0 + n) * ldk + k0 + 8 * c) = o; }
    LDS_WAIT(); asm volatile("" ::: "memory");
}
DI void p0_transpose_item8(const float* W, int K, int N, unsigned char* WT, int mode, int H, float mult, LAS float* scr, int item, int lane) {
    const int nblk = N / 32, kb = item / nblk, nb = item % nblk, k0 = 64 * kb, n0 = 32 * nb;
    int dr0 = n0;
    if (mode == 1) { if (n0 < H) dr0 = (n0 >> 7) * 256 + (n0 & 127); else { const int n1 = n0 - H; dr0 = (n1 >> 7) * 256 + 128 + (n1 & 127); } }
    { float wv[32];
#pragma unroll
      for (int i = 0; i < 32; ++i) wv[i] = __builtin_nontemporal_load(W + (size_t)(k0 + 2 * i + (lane >> 5)) * N + n0 + (lane & 31));
#pragma unroll
      for (int i = 0; i < 32; ++i) scr[(2 * i + (lane >> 5)) * 33 + (lane & 31)] = wv[i] * mult; }
    LDS_WAIT(); asm volatile("" ::: "memory");
#pragma unroll
    for (int j = 0; j < 2; ++j) { const int idx = lane + 64 * j, n = idx >> 2, c = idx & 3; const LAS float* s = scr + (16 * c) * 33 + n;
        u32x4 o;
        o.x = pg8::pk4fp8((f32x4){s[0 * 33], s[1 * 33], s[2 * 33], s[3 * 33]}); o.y = pg8::pk4fp8((f32x4){s[4 * 33], s[5 * 33], s[6 * 33], s[7 * 33]});
        o.z = pg8::pk4fp8((f32x4){s[8 * 33], s[9 * 33], s[10 * 33], s[11 * 33]}); o.w = pg8::pk4fp8((f32x4){s[12 * 33], s[13 * 33], s[14 * 33], s[15 * 33]});
        *(GAS u32x4*)(WT + (size_t)(dr0 + n) * K + k0 + 16 * c) = o; }
    LDS_WAIT(); asm volatile("" ::: "memory");
}
constexpr int CI_WIN = 16 * 176, CI_SQ = 16 * 32, CI_RG = 64, CI_LAYER = CI_WIN + 3 * CI_SQ + 2 * CI_RG;
constexpr int CI_FIN = 16 * 192, CI_FOUT = 48 * 32, CI_DENSE = CI_FIN + CI_FOUT;
constexpr int CI_MIN = 16 * 96, CI_MOUT = 24 * 32, CI_EXP = CI_MIN + CI_MOUT, CI_MOE = 8 * CI_EXP;
constexpr int CI_TOTAL = 4 * CI_LAYER + 2 * CI_DENSE + 2 * CI_MOE;
DI void p0_convert_item(kargp_t kp, int it, LAS float* scr, int lane) {
    unsigned char* ws = karg_ws(kp);
    if (it < 4 * CI_LAYER) {
        const int l = it / CI_LAYER; int r = it % CI_LAYER; unsigned char* wl = ws + WS_WL + (size_t)l * WL_STRIDE;
        if (r < CI_WIN) { p0_transpose_item(karg_in(kp, 8) + (size_t)l * 1024 * D_IN, 1024, D_IN, (bf16*)(wl + WL_WIN), 0, 0, scr, r, lane); return; } r -= CI_WIN;
        if (r < 2 * CI_SQ) { const int br = r / CI_SQ; p0_transpose_item(karg_in(kp, 17) + (size_t)(l * 2 + br) * 1024 * 1024, 1024, 1024, (bf16*)(wl + WL_WB) + (size_t)br * 1024, 0, 0, scr, r % CI_SQ, lane, 2048); return; }   r -= 2 * CI_SQ;
        if (r < CI_SQ) { p0_transpose_item(karg_in(kp, 18) + (size_t)l * 1024 * 1024, 1024, 1024, (bf16*)(wl + WL_WO), 0, 0, scr, r, lane); return; } r -= CI_SQ;
        if (r < CI_RG) { const int nb = r >> 3; p0_transpose_item(karg_in(kp, 11) + (size_t)(l * 8 + nb) * 16384, 128, 128, (bf16*)(wl + WL_WRA) + nb * 16384, 0, 0, scr, r & 7, lane, 0, -LOG2E); return; }     r -= CI_RG;
        { const int nb = r >> 3; p0_transpose_item(karg_in(kp, 13) + (size_t)(l * 8 + nb) * 16384, 128, 128, (bf16*)(wl + WL_WRX) + nb * 16384, 0, 0, scr, r & 7, lane, 0, -LOG2E); return; }
    }
    it -= 4 * CI_LAYER;
    if (it < 2 * CI_DENSE) {
        const int j = it / CI_DENSE; int r = it % CI_DENSE; unsigned char* wd = ws + WS_WD + (size_t)j * WD_STRIDE;
        const bool f8 = (FP8_LAYERS >> (2 * j)) & 1u;
        if (r < CI_FIN) { if (f8) p0_transpose_item8(karg_in(kp, 19) + (size_t)j * 1024 * 6144, 1024, 6144, wd + WD_FIN, 1, 3072, 32.0f, scr, r, lane); else p0_transpose_item(karg_in(kp, 19) + (size_t)j * 1024 * 6144, 1024, 6144, (bf16*)(wd + WD_FIN), 1, 3072, scr, r, lane); return; } r -= CI_FIN;
        if (f8) p0_transpose_item8(karg_in(kp, 20) + (size_t)j * 3072 * 1024, 3072, 1024, wd + WD_FOUT, 0, 0, 64.0f, scr, r, lane); else p0_transpose_item(karg_in(kp, 20) + (size_t)j * 3072 * 1024, 3072, 1024, (bf16*)(wd + WD_FOUT), 0, 0, scr, r, lane); return;
    }
    it -= 2 * CI_DENSE;
    {
        const int j = it / CI_MOE; int r = it % CI_MOE; const int e = r / CI_EXP; r %= CI_EXP; unsigned char* wm = ws + WS_WM + (size_t)j * WM_STRIDE;
        const bool f8 = (FP8_LAYERS >> (2 * j + 1)) & 1u;
        if (r < CI_MIN) { if (f8) p0_transpose_item8(karg_in(kp, 22) + (size_t)(j * 8 + e) * 1024 * 3072, 1024, 3072, wm + WM_MIN + (size_t)e * 3072 * 1024, 1, 1536, 32.0f, scr, r, lane); else p0_transpose_item(karg_in(kp, 22) + (size_t)(j * 8 + e) * 1024 * 3072, 1024, 3072, (bf16*)(wm + WM_MIN) + (size_t)e * 3072 * 1024, 1, 1536, scr, r, lane); return; } r -= CI_MIN;
        if (f8) p0_transpose_item8(karg_in(kp, 23) + (size_t)(j * 8 + e) * 1536 * 1024, 1536, 1024, wm + WM_MOUT + (size_t)e * 1024 * 1536, 0, 0, 32.0f, scr, r, lane); else p0_transpose_item(karg_in(kp, 23) + (size_t)(j * 8 + e) * 1536 * 1024, 1536, 1024, (bf16*)(wm + WM_MOUT) + (size_t)e * 1024 * 1536, 0, 0, scr, r, lane);
    }
}
DI void p0_prologue(LAS unsigned char* lds, int tid, int wave, int lane) {
    const kargp_t kp = kargs();
    LAS float* cact = (LAS float*)lds; LAS float* red = (LAS float*)(lds + 8192);
    float* ADA = (float*)(karg_ws(kp) + WS_ADA);
    for (int i = tid; i < 2 * D; i += NWAVES * 64) { const float c = karg_in(kp, 1)[i]; cact[i] = c / (1.0f + expf(-c)); }
    __syncthreads();
    const int col = tid & 31, ks = tid >> 5;
    for (int it = blockIdx.x; it < 4 * 192; it += gridDim.x) {
        const int l = it / 192, n0 = (it % 192) * 32;
        const float* w = karg_in(kp, 2) + (size_t)l * 1024 * 6144 + (size_t)(ks * 64) * 6144 + n0 + col;
        float s0 = 0.f, s1 = 0.f;
#pragma unroll 32
        for (int k = 0; k < 64; ++k) { const float wv = __builtin_nontemporal_load(w + (size_t)k * 6144); s0 += cact[ks * 64 + k] * wv; s1 += cact[1024 + ks * 64 + k] * wv; }
        red[(ks * 2 + 0) * 32 + col] = s0; red[(ks * 2 + 1) * 32 + col] = s1;
        __syncthreads();
        if (tid < 64) { const int b = tid >> 5, c2 = tid & 31; float s = karg_in(kp, 3)[l * 6144 + n0 + c2];
#pragma unroll
            for (int k2 = 0; k2 < 16; ++k2) s += red[(k2 * 2 + b) * 32 + c2];
            ADA[(l * 2 + b) * 6144 + n0 + c2] = s; }
        __syncthreads();
    }
    __syncthreads();
    LAS float* scr = (LAS float*)(lds + wave * 16384);
    const int gw = blockIdx.x * NWAVES + wave, NGW = gridDim.x * NWAVES;
    for (int it = gw; it < CI_TOTAL; it += NGW) p0_convert_item(kp, it, scr, lane);
}

DI int vcu_index() { const int G = (int)gridDim.x, bx = (int)blockIdx.x; return (G % 8 == 0) ? (bx % 8) * (G / 8) + bx / 8 : bx; }
DI float row_ss(const f32x4 (&v)[4]) { float s = 0.f;
#pragma unroll
    for (int j = 0; j < 4; ++j) s += (v[j].x * v[j].x + v[j].y * v[j].y) + (v[j].z * v[j].z + v[j].w * v[j].w);
    return wave_sum(s); }
DI void ld_row(const float* p, int lane, f32x4 (&v)[4]) {
#pragma unroll
    for (int j = 0; j < 4; ++j) v[j] = *(const f32x4*)(p + 256 * j + 4 * lane); }
DI void st_row(float* p, int lane, const f32x4 (&v)[4]) {
#pragma unroll
    for (int j = 0; j < 4; ++j) *(f32x4*)(p + 256 * j + 4 * lane) = v[j]; }
DI void st_row_f8(unsigned char* p, int lane, const f32x4 (&v)[4]) {
#pragma unroll
    for (int j = 0; j < 4; ++j) *(unsigned*)(p + 256 * j + 4 * lane) = pg8::pk4fp8(v[j]); }
DI void st_row_bf(bf16* p, int lane, const f32x4 (&v)[4]) {
#pragma unroll
    for (int j = 0; j < 4; ++j) { u32x2 w; w.x = pk2(v[j].x, v[j].y); w.y = pk2(v[j].z, v[j].w); *(u32x2*)(p + 256 * j + 4 * lane) = w; } }
DI void ld_row_bfraw(const bf16* p, int lane, u32x2 (&w)[4]) {
#pragma unroll
    for (int j = 0; j < 4; ++j) w[j] = *(const u32x2*)(p + 256 * j + 4 * lane); }
DI void cvt_row_bf(const u32x2 (&w)[4], f32x4 (&v)[4]) {
#pragma unroll
    for (int j = 0; j < 4; ++j) v[j] = (f32x4){bflo(w[j].x), bfhi(w[j].x), bflo(w[j].y), bfhi(w[j].y)}; }
DI void ld_row_bf(const bf16* p, int lane, f32x4 (&v)[4]) {
#pragma unroll
    for (int j = 0; j < 4; ++j) { const u32x2 w = *(const u32x2*)(p + 256 * j + 4 * lane); v[j] = (f32x4){bflo(w.x), bfhi(w.x), bflo(w.y), bfhi(w.y)}; } }

DI void thin_start(int wave, int lane) {
    const kargp_t kp = kargs(); unsigned char* ws = karg_ws(kp);
    const float* ADA = (const float*)(ws + WS_ADA); bf16* XN = (bf16*)(ws + WS_XN);
    const int NGW = gridDim.x * NWAVES, gw = vcu_index() * NWAVES + wave;
    for (int base = gw * 8; base < M; base += NGW * 8) {
        const int b = base >> 13; const float* ada = ADA + (size_t)b * 6144;
        f32x4 g[4], sc[4], sh[4]; ld_row(karg_in(kp, 4), lane, g); ld_row(ada + 1024, lane, sc); ld_row(ada, lane, sh);
#pragma unroll
        for (int j = 0; j < 4; ++j) sc[j] = g[j] * (sc[j] + 1.0f);
        const float* xin = karg_in(kp, 0);
        f32x4 xn[4]; ld_row(xin + (size_t)base * D, lane, xn);
#pragma unroll
        for (int i = 0; i < 8; ++i) { const size_t m = (size_t)(base + i);
            f32x4 x[4];
#pragma unroll
            for (int j = 0; j < 4; ++j) x[j] = xn[j];
            if (i < 7) ld_row(xin + (m + 1) * D, lane, xn);
            const float rs = rsqrtf(row_ss(x) * (1.0f / D) + EPS);
#pragma unroll
            for (int j = 0; j < 4; ++j) x[j] = x[j] * rs * sc[j] + sh[j];
            st_row_bf(XN + m * D, lane, x); }
    }
}
DI void thin_mid_dense(int l, int wave, int lane) {
    const kargp_t kp = kargs(); unsigned char* ws = karg_ws(kp); bf16* XB = (bf16*)(ws + WS_XB);
    const float* ADA = (const float*)(ws + WS_ADA); bf16* XN = (bf16*)(ws + WS_XN); const bf16* MIX = (const bf16*)(ws + WS_MIX);
    const float* xin = karg_in(kp, 0); const bool l0 = (l == 0);
    const int NGW = gridDim.x * NWAVES, gw = vcu_index() * NWAVES + wave;
    for (int base = gw * 8; base < M; base += NGW * 8) {
        const int b = base >> 13; const float* ada = ADA + (size_t)(l * 2 + b) * 6144;
        f32x4 pg[4], fg[4], fs[4], t[4];
        ld_row(karg_in(kp, 5) + l * D, lane, pg); ld_row(ada + 2048, lane, t);
#pragma unroll
        for (int j = 0; j < 4; ++j) pg[j] = pg[j] * t[j];
        ld_row(karg_in(kp, 6) + l * D, lane, fg); ld_row(ada + 4096, lane, t); ld_row(ada + 3072, lane, fs);
#pragma unroll
        for (int j = 0; j < 4; ++j) fg[j] = fg[j] * (t[j] + 1.0f);
        u32x2 yn[4], xr[4]; f32x4 xn[4]; ld_row_bfraw(MIX + (size_t)base * D, lane, yn); if (l0) ld_row(xin + (size_t)base * D, lane, xn); else ld_row_bfraw(XB + (size_t)base * D, lane, xr);
#pragma unroll
        for (int i = 0; i < 8; ++i) { const size_t m = (size_t)(base + i);
            f32x4 y[4], x[4]; cvt_row_bf(yn, y);
            if (l0) {
#pragma unroll
                for (int j = 0; j < 4; ++j) x[j] = xn[j];
            } else cvt_row_bf(xr, x);
            if (i < 7) { ld_row_bfraw(MIX + (m + 1) * D, lane, yn); if (l0) ld_row(xin + (m + 1) * D, lane, xn); else ld_row_bfraw(XB + (m + 1) * D, lane, xr); }
            const float rs = rsqrtf(row_ss(y) * (1.0f / D) + EPS);
#pragma unroll
            for (int j = 0; j < 4; ++j) x[j] = x[j] + pg[j] * (y[j] * rs);
            st_row_bf(XB + m * D, lane, x);
            const float rs2 = rsqrtf(row_ss(x) * (1.0f / D) + EPS);
#pragma unroll
            for (int j = 0; j < 4; ++j) x[j] = x[j] * rs2 * fg[j] + fs[j];
            if ((FP8_LAYERS >> l) & 1u) st_row_f8((unsigned char*)XN + m * D, lane, x); else st_row_bf(XN + m * D, lane, x); }
    }
}
DI void thin_mid_moe(LAS unsigned char* lds, int l, int tid, int wave, int lane) {
    const kargp_t kp = kargs(); unsigned char* ws = karg_ws(kp); bf16* XB = (bf16*)(ws + WS_XB);
    const float* ADA = (const float*)(ws + WS_ADA); const bf16* MIX = (const bf16*)(ws + WS_MIX);
    unsigned char* AP = ws + WS_AP; int* TOK = (int*)(ws + WS_TOK);
    unsigned* cntg = (unsigned*)(ws + WS_CTL) + CW_CNT + 64 * (l >> 1);
    const float* wr = karg_in(kp, 21) + (size_t)(l >> 1) * D * NE;
    LAS float* RT = (LAS float*)lds;
    LAS unsigned* cntL = (LAS unsigned*)(lds + 32768);
    for (int i = tid; i < D * NE; i += NWAVES * 64) RT[i] = wr[i];
    for (int rb = vcu_index(); rb < M / 64; rb += gridDim.x) {
        if (tid < 16) cntL[tid] = 0u;
        __syncthreads();
        const int base = rb * 64 + wave * 8; const int b = base >> 13; const float* ada = ADA + (size_t)(l * 2 + b) * 6144;
        f32x4 pg[4], fg[4], fs[4], t[4];
        ld_row(karg_in(kp, 5) + l * D, lane, pg); ld_row(ada + 2048, lane, t);
#pragma unroll
        for (int j = 0; j < 4; ++j) pg[j] = pg[j] * t[j];
        ld_row(karg_in(kp, 6) + l * D, lane, fg); ld_row(ada + 4096, lane, t); ld_row(ada + 3072, lane, fs);
#pragma unroll
        for (int j = 0; j < 4; ++j) fg[j] = fg[j] * (t[j] + 1.0f);
        int e0s[8], e1s[8], lp0[8], lp1[8]; float w0s[8], rs2s[8];
        u32x2 yn[4], xr[4]; ld_row_bfraw(MIX + (size_t)base * D, lane, yn); ld_row_bfraw(XB + (size_t)base * D, lane, xr);
#pragma unroll
        for (int i = 0; i < 8; ++i) { const size_t m = (size_t)(base + i);
            f32x4 y[4], x[4]; cvt_row_bf(yn, y);
            cvt_row_bf(xr, x);
            if (i < 7) { ld_row_bfraw(MIX + (m + 1) * D, lane, yn); ld_row_bfraw(XB + (m + 1) * D, lane, xr); }
            const float rs = rsqrtf(row_ss(y) * (1.0f / D) + EPS);
#pragma unroll
            for (int j = 0; j < 4; ++j) x[j] = x[j] + pg[j] * (y[j] * rs);
            st_row_bf(XB + m * D, lane, x);
            const float rs2 = rsqrtf(row_ss(x) * (1.0f / D) + EPS);
            float lg[8];
#pragma unroll
            for (int e = 0; e < 8; ++e) lg[e] = 0.f;
#pragma unroll
            for (int j = 0; j < 4; ++j) { x[j] = x[j] * rs2 * fg[j] + fs[j];
#pragma unroll
                for (int q = 0; q < 4; ++q) { const LAS f32x4* tr = (const LAS f32x4*)(RT + (256 * j + 4 * lane + q) * 8); const f32x4 t0 = tr[0], t1 = tr[1]; const float hv = x[j][q];
                    lg[0] += hv * t0.x; lg[1] += hv * t0.y; lg[2] += hv * t0.z; lg[3] += hv * t0.w; lg[4] += hv * t1.x; lg[5] += hv * t1.y; lg[6] += hv * t1.z; lg[7] += hv * t1.w; } }
#pragma unroll
            for (int e = 0; e < 8; ++e) lg[e] = wave_sum(lg[e]);
            int e0 = 0; float v0 = lg[0];
#pragma unroll
            for (int e = 1; e < 8; ++e) if (lg[e] > v0) { v0 = lg[e]; e0 = e; }
            int e1 = (e0 == 0) ? 1 : 0; float v1 = -INFINITY;
#pragma unroll
            for (int e = 0; e < 8; ++e) if (e != e0 && lg[e] > v1) { v1 = lg[e]; e1 = e; }
            e0 = __builtin_amdgcn_readfirstlane(e0); e1 = __builtin_amdgcn_readfirstlane(e1);
            const float w0 = 1.0f / (1.0f + expf(v1 - v0));
            unsigned q0 = 0u, q1 = 0u;
            if (lane == 0) { q0 = __hip_atomic_fetch_add(cntL + e0, 1u, __ATOMIC_RELAXED, __HIP_MEMORY_SCOPE_WORKGROUP); q1 = __hip_atomic_fetch_add(cntL + e1, 1u, __ATOMIC_RELAXED, __HIP_MEMORY_SCOPE_WORKGROUP); }
            e0s[i] = e0; e1s[i] = e1; lp0[i] = __builtin_amdgcn_readfirstlane((int)q0); lp1[i] = __builtin_amdgcn_readfirstlane((int)q1); w0s[i] = w0; rs2s[i] = rs2;
        }
        __syncthreads();
        if (tid < 8) cntL[8 + tid] = __hip_atomic_fetch_add(cntg + tid, cntL[tid], RLX_AGENT);
        __syncthreads();
#pragma unroll
        for (int i = 0; i < 8; ++i) { const size_t m = (size_t)(base + i);
            const int p0 = (int)cntL[8 + e0s[i]] + lp0[i], p1 = (int)cntL[8 + e1s[i]] + lp1[i];
            const int esz = ((FP8_LAYERS >> l) & 1u) ? 1 : 2; unsigned char* r0 = AP + ((size_t)e0s[i] * ECAP + p0) * D * esz; unsigned char* r1 = AP + ((size_t)e1s[i] * ECAP + p1) * D * esz;
            f32x4 x[4]; ld_row_bf(XB + m * D, lane, x);
#pragma unroll
            for (int j = 0; j < 4; ++j) { x[j] = x[j] * rs2s[i] * fg[j] + fs[j];
                if (esz == 1) { const unsigned hpk = pg8::pk4fp8(x[j]); *(unsigned*)(r0 + 256 * j + 4 * lane) = hpk; *(unsigned*)(r1 + 256 * j + 4 * lane) = hpk; }
                else { u32x2 hpk; hpk.x = pk2(x[j].x, x[j].y); hpk.y = pk2(x[j].z, x[j].w); *(u32x2*)(r0 + 512 * j + 8 * lane) = hpk; *(u32x2*)(r1 + 512 * j + 8 * lane) = hpk; } }
            if (lane == 0) { int4 ti; ti.x = e0s[i] | (e1s[i] << 8); ti.y = p0; ti.z = p1; ti.w = __float_as_int(w0s[i]); *(int4*)(TOK + 4 * m) = ti; }
        }
        __syncthreads();
    }
}
DI void thin_end(int l, int wave, int lane) {
    const kargp_t kp = kargs(); unsigned char* ws = karg_ws(kp); float* outp = karg_out(kp); bf16* XB = (bf16*)(ws + WS_XB);
    const float* ADA = (const float*)(ws + WS_ADA); bf16* XN = (bf16*)(ws + WS_XN); const bf16* MIX = (const bf16*)(ws + WS_MIX);
    const bf16* YP = (const bf16*)(ws + WS_YP); const int* TOK = (const int*)(ws + WS_TOK);
    const bool moe = (l & 1) != 0; const bool last = (l == DEPTH - 1);
    int pp[8];
    { const unsigned* cntg = (const unsigned*)(ws + WS_CTL) + CW_CNT + 64 * (l >> 1); int acc = 0;
#pragma unroll
      for (int e = 0; e < 8; ++e) { pp[e] = acc; const unsigned n = moe ? (unsigned)__builtin_amdgcn_readfirstlane((int)__hip_atomic_load(cntg + e, RLX_AGENT)) : 0u; acc += (int)((n + 255u) >> 8); } }
    const int NGW = gridDim.x * NWAVES, gw = vcu_index() * NWAVES + wave;
    for (int base = gw * 8; base < M; base += NGW * 8) {
        const int b = base >> 13; const float* ada = ADA + (size_t)(l * 2 + b) * 6144; const float* adan = ADA + (size_t)((last ? l : l + 1) * 2 + b) * 6144;
        f32x4 pg[4], ng[4], ns[4], t[4];
        ld_row(karg_in(kp, 7) + l * D, lane, pg); ld_row(ada + 5120, lane, t);
#pragma unroll
        for (int j = 0; j < 4; ++j) pg[j] = pg[j] * t[j];
        ld_row(karg_in(kp, 4) + (last ? l : l + 1) * D, lane, ng); ld_row(adan + 1024, lane, t); ld_row(adan, lane, ns);
#pragma unroll
        for (int j = 0; j < 4; ++j) ng[j] = ng[j] * (t[j] + 1.0f);
        u32x2 yn[4], zn[4], xr[4]; float w0n = 1.0f;
#define TE_LOAD(mm) do { if (moe) { const int4 ti = *(const int4*)(TOK + 4 * (mm)); const int e0 = ti.x & 255, e1 = (ti.x >> 8) & 255; int b0 = 0, b1 = 0; \
                _Pragma("unroll") for (int e = 1; e < 8; ++e) { if (e0 == e) b0 = pp[e]; if (e1 == e) b1 = pp[e]; } \
                w0n = __int_as_float(ti.w); ld_row_bfraw(YP + ((size_t)b0 * 256 + ti.y) * D, lane, yn); ld_row_bfraw(YP + ((size_t)b1 * 256 + ti.z) * D, lane, zn); } \
            else ld_row_bfraw(MIX + (mm) * D, lane, yn); \
            ld_row_bfraw(XB + (mm) * D, lane, xr); } while (0)
        TE_LOAD((size_t)base);
#pragma unroll
        for (int i = 0; i < 8; ++i) { const size_t m = (size_t)(base + i);
            f32x4 y[4], x[4]; cvt_row_bf(yn, y);
            if (moe) { f32x4 y1[4]; cvt_row_bf(zn, y1); const float w0 = w0n, w1 = 1.0f - w0n;
#pragma unroll
                for (int j = 0; j < 4; ++j) y[j] = y[j] * w0 + y1[j] * w1; }
            cvt_row_bf(xr, x);
            if (i < 7) TE_LOAD(m + 1);
            const float rs = rsqrtf(row_ss(y) * (1.0f / D) + EPS);
#pragma unroll
            for (int j = 0; j < 4; ++j) x[j] = x[j] + pg[j] * (y[j] * rs);
            if (last) st_row(outp + m * D, lane, x); else st_row_bf(XB + m * D, lane, x);
            if (!last) { const float rs2 = rsqrtf(row_ss(x) * (1.0f / D) + EPS);
#pragma unroll
                for (int j = 0; j < 4; ++j) x[j] = x[j] * rs2 * ng[j] + ns[j];
                st_row_bf(XN + m * D, lane, x); }
        }
#undef TE_LOAD
    }
}
constexpr int L_WA = 0, L_WX = 34816, L_XC = 69632, L_PAR = 104448, L_AGG = 108544, L_HST = 116736, L_HINT = 108544;
template <int N> DI float dpp_shr(float oldv, float x) { return __builtin_bit_cast(float, __builtin_amdgcn_update_dpp(__builtin_bit_cast(int, oldv), __builtin_bit_cast(int, x), 0x110 + N, 0xf, 0xf, false)); }
#define RNN_SCAN_STEP(S) \
    "v_fmac_f32_dpp %4, %4, %0 row_shr:" #S " row_mask:0xf bank_mask:0xf\n\t" "v_fmac_f32_dpp %5, %5, %1 row_shr:" #S " row_mask:0xf bank_mask:0xf\n\t" \
    "v_fmac_f32_dpp %6, %6, %2 row_shr:" #S " row_mask:0xf bank_mask:0xf\n\t" "v_fmac_f32_dpp %7, %7, %3 row_shr:" #S " row_mask:0xf bank_mask:0xf\n\t" \
    "v_mul_f32_dpp %0, %0, %0 row_shr:" #S " row_mask:0xf bank_mask:0xf\n\t" "v_mul_f32_dpp %1, %1, %1 row_shr:" #S " row_mask:0xf bank_mask:0xf\n\t" \
    "v_mul_f32_dpp %2, %2, %2 row_shr:" #S " row_mask:0xf bank_mask:0xf\n\t" "v_mul_f32_dpp %3, %3, %3 row_shr:" #S " row_mask:0xf bank_mask:0xf\n\t"
DI void scan16(f32x4& a, f32x4& u) {
    float a0 = a[0], a1 = a[1], a2 = a[2], a3 = a[3], u0 = u[0], u1 = u[1], u2 = u[2], u3 = u[3];
    asm volatile("s_nop 1\n\t" RNN_SCAN_STEP(1) RNN_SCAN_STEP(2) RNN_SCAN_STEP(4) RNN_SCAN_STEP(8) "s_nop 0"
                 : "+v"(a0), "+v"(a1), "+v"(a2), "+v"(a3), "+v"(u0), "+v"(u1), "+v"(u2), "+v"(u3));
    a = (f32x4){a0, a1, a2, a3}; u = (f32x4){u0, u1, u2, u3};
}
template <int N> DI void scan_step(f32x4& a, f32x4& u) {
#pragma unroll
    for (int q = 0; q < 4; ++q) { const float ap = dpp_shr<N>(1.0f, a[q]), up = dpp_shr<N>(0.0f, u[q]); u[q] = a[q] * up + u[q]; a[q] = a[q] * ap; }
}
DI f32x4 mfma16(bf16x8 a, bf16x8 b, f32x4 c) { return __builtin_amdgcn_mfma_f32_16x16x32_bf16(a, b, c, 0, 0, 0); }
DI f32x4 bf4lo(u32x4 v) { return (f32x4){bflo(v.x), bfhi(v.x), bflo(v.y), bfhi(v.y)}; }
DI f32x4 bf4hi(u32x4 v) { return (f32x4){bflo(v.z), bfhi(v.z), bflo(v.w), bfhi(v.w)}; }
DI void rnn_pass1(LAS unsigned char* lds, int l, int tid, int wave, int lane, int it_first, int it_count, int it_stride) {
    const int fr = lane & 15, fq = lane >> 4;
    LAS float* PAR = (LAS float*)(lds + L_PAR); LAS float* AGG = (LAS float*)(lds + L_AGG); LAS float* HST = (LAS float*)(lds + L_HST);
    const int cc = tid & 15, tg4 = (tid >> 4) * 4;
    for (int itk = 0; itk < it_count; ++itk) { const int it = it_first + itk * it_stride;
        const int nb = it & 7, seg = it >> 3, sidx = seg & 15; const int m0 = seg * 512;
        const kargp_t kp = kargs(); unsigned char* ws = karg_ws(kp);
        const bf16* XRp = (const bf16*)(ws + WS_XR);
        __syncthreads();
        u32x4 pre[7];
        f32x4 cw0[4], cw1[4], cb0, cb1;
#define RNN_PREFETCH(stn) do { _Pragma("unroll") for (int j = 0; j < 7; ++j) { const int rl = 128 * (stn) + tg4 - 3 + j; pre[j] = (u32x4){0u, 0u, 0u, 0u}; \
                if (!(sidx == 0 && rl < 0)) pre[j] = *(const u32x4*)(XRp + (size_t)(m0 + rl) * 1024 + nb * 128 + cc * 8); } } while (0)
        RNN_PREFETCH(0);
        { const bf16* WA = (const bf16*)(ws + WS_WL + (size_t)l * WL_STRIDE + WL_WRA) + nb * 16384; const bf16* WX = (const bf16*)(ws + WS_WL + (size_t)l * WL_STRIDE + WL_WRX) + nb * 16384;
          u32x4 wreg[8];
#pragma unroll
          for (int i = 0; i < 4; ++i) { const int q = tid + 512 * i; wreg[i] = *(const u32x4*)(WA + (q >> 4) * 128 + (q & 15) * 8); wreg[4 + i] = *(const u32x4*)(WX + (q >> 4) * 128 + (q & 15) * 8); }
          { const float* cwp = karg_in(kp, 9) + (size_t)l * 4096 + nb * 128 + cc * 8; const float* cbp = karg_in(kp, 10) + l * 1024 + nb * 128 + cc * 8;
#pragma unroll
              for (int k = 0; k < 4; ++k) { cw0[k] = *(const f32x4*)(cwp + k * 1024); cw1[k] = *(const f32x4*)(cwp + k * 1024 + 4); }
              cb0 = *(const f32x4*)cbp; cb1 = *(const f32x4*)(cbp + 4); }
          if (tid < 128) { const int ch = l * 1024 + nb * 128 + tid;
            PAR[0 * 128 + tid] = -LOG2E * karg_in(kp, 12)[ch]; PAR[1 * 128 + tid] = -LOG2E * karg_in(kp, 14)[ch]; PAR[2 * 128 + tid] = 8.0f * log1pf(expf(-karg_in(kp, 15)[ch])) * LOG2E;
            *(LAS f32x2*)(HST + 2 * tid) = (f32x2){1.0f, 0.0f}; }
#pragma unroll
          for (int i = 0; i < 4; ++i) { const int q = tid + 512 * i; *(LAS u32x4*)(lds + L_WA + (q >> 4) * 272 + (q & 15) * 16) = wreg[i]; *(LAS u32x4*)(lds + L_WX + (q >> 4) * 272 + (q & 15) * 16) = wreg[4 + i]; } }
        for (int st = 0; st < 4; ++st) {
#pragma unroll
            for (int i = 0; i < 4; ++i) { f32x4 o0 = cb0, o1 = cb1;
#pragma unroll
                for (int k = 0; k < 4; ++k) { o0 += cw0[k] * bf4lo(pre[i + k]); o1 += cw1[k] * bf4hi(pre[i + k]); }
                u32x4 pk; pk.x = pk2(o0[0], o0[1]); pk.y = pk2(o0[2], o0[3]); pk.z = pk2(o1[0], o1[1]); pk.w = pk2(o1[2], o1[3]);
                *(LAS u32x4*)(lds + L_XC + (tg4 + i) * 272 + cc * 16) = pk; }
            __syncthreads();
            if (st < 3) RNN_PREFETCH(st + 1);
            const int tl = 16 * wave + fr;
            bf16x8 xb[4];
#pragma unroll
            for (int s = 0; s < 4; ++s) xb[s] = *(const LAS bf16x8*)(lds + L_XC + tl * 272 + (32 * s + 8 * fq) * 2);
            unsigned* PSw = (unsigned*)(ws + WS_PS); float* T16w = (float*)(ws + WS_T16);
#pragma unroll
            for (int n = 0; n < 8; ++n) { const int ch0 = 16 * n + 4 * fq;
                f32x4 ca = *(const LAS f32x4*)(PAR + ch0), cx = *(const LAS f32x4*)(PAR + 128 + ch0);
#pragma unroll
                for (int s = 0; s < 4; ++s) { const bf16x8 af = *(const LAS bf16x8*)(lds + L_WA + (16 * n + fr) * 272 + (32 * s + 8 * fq) * 2), xf = *(const LAS bf16x8*)(lds + L_WX + (16 * n + fr) * 272 + (32 * s + 8 * fq) * 2);
                    ca = mfma16(af, xb[s], ca); cx = mfma16(xf, xb[s], cx); }
                const u32x2 xv = *(const LAS u32x2*)(lds + L_XC + tl * 272 + ch0 * 2); const f32x4 xc = (f32x4){bflo(xv.x), bfhi(xv.x), bflo(xv.y), bfhi(xv.y)};
                const f32x4 sp = *(const LAS f32x4*)(PAR + 256 + ch0);
                f32x4 av, uv;
#pragma unroll
                for (int q = 0; q < 4; ++q) { const float r = frcp(1.0f + fexp2(ca[q])), ig = frcp(1.0f + fexp2(cx[q]));
                    const float aa = fexp2(-r * sp[q]); av[q] = aa; uv[q] = __builtin_amdgcn_sqrtf(1.0f - aa * aa) * ig * xc[q]; }
                scan16(av, uv);
                { u32x4 ps; ps.x = pk2(av[0], uv[0]); ps.y = pk2(av[1], uv[1]); ps.z = pk2(av[2], uv[2]); ps.w = pk2(av[3], uv[3]);
                  *(u32x4*)(PSw + (size_t)(m0 + 128 * st + tl) * 1024 + nb * 128 + ch0) = ps; }
                if (fr == 15) { const f32x4 g0 = (f32x4){av[0], uv[0], av[1], uv[1]}, g1 = (f32x4){av[2], uv[2], av[3], uv[3]};
                    *(LAS f32x4*)(AGG + (wave * 128 + ch0) * 2) = g0; *(LAS f32x4*)(AGG + (wave * 128 + ch0) * 2 + 4) = g1;
                    float* o = T16w + ((size_t)(seg * 32 + st * 8 + wave) * 1024 + nb * 128 + ch0) * 2; *(f32x4*)o = g0; *(f32x4*)(o + 4) = g1; }
            }
            __syncthreads();
            LAS float* HS0 = HST + 256 * (st & 1); LAS float* HS1 = HST + 256 * ((st + 1) & 1);
            if (fr == 0) { const int ch0 = 16 * wave + 4 * fq;
                const f32x4 h0 = *(const LAS f32x4*)(HS0 + 2 * ch0), h1 = *(const LAS f32x4*)(HS0 + 2 * ch0 + 4);
                f32x4 A = (f32x4){h0[0], h0[2], h1[0], h1[2]}, U = (f32x4){h0[1], h0[3], h1[1], h1[3]};
#pragma unroll
                for (int w2 = 0; w2 < 8; ++w2) { const f32x4 g0 = *(const LAS f32x4*)(AGG + (w2 * 128 + ch0) * 2), g1 = *(const LAS f32x4*)(AGG + (w2 * 128 + ch0) * 2 + 4);
                    const f32x4 a2 = (f32x4){g0[0], g0[2], g1[0], g1[2]}, u2 = (f32x4){g0[1], g0[3], g1[1], g1[3]}; U = a2 * U + u2; A = A * a2; }
                const f32x4 o0 = (f32x4){A[0], U[0], A[1], U[1]}, o1 = (f32x4){A[2], U[2], A[3], U[3]};
                *(LAS f32x4*)(HS1 + 2 * ch0) = o0; *(LAS f32x4*)(HS1 + 2 * ch0 + 4) = o1;
                if (st == 3) { float* o = (float*)(ws + WS_RAGG) + ((size_t)seg * 1024 + nb * 128 + ch0) * 2; *(f32x4*)o = o0; *(f32x4*)(o + 4) = o1; } }
        }
#undef RNN_PREFETCH
    }
}
DI void rnn_pass2(LAS unsigned char* lds, int tid) {
    LAS float* HINT = (LAS float*)lds;
    for (int it = vcu_index(); it < 256; it += gridDim.x) {
        const int nb = it & 7, seg = it >> 3, sidx = seg & 15; const int m0 = seg * 512;
        unsigned char* ws = karg_ws(kargs());
        __syncthreads();
        if (tid < 128) { const float* RAGG = (const float*)(ws + WS_RAGG) + ((size_t)(seg - sidx) * 1024 + nb * 128 + tid) * 2; const float* T16 = (const float*)(ws + WS_T16) + ((size_t)(seg * 32) * 1024 + nb * 128 + tid) * 2;
            f32x2 sa[15], ta[32];
#pragma unroll
            for (int s2 = 0; s2 < 15; ++s2) sa[s2] = *(const f32x2*)(RAGG + (size_t)s2 * 2048);
#pragma unroll
            for (int t2 = 0; t2 < 32; ++t2) ta[t2] = *(const f32x2*)(T16 + (size_t)t2 * 2048);
            float h = 0.f;
#pragma unroll
            for (int s2 = 0; s2 < 15; ++s2) h = (s2 < sidx) ? sa[s2].x * h + sa[s2].y : h;
#pragma unroll
            for (int t2 = 0; t2 < 32; ++t2) { HINT[t2 * 128 + tid] = h; h = ta[t2].x * h + ta[t2].y; } }
        __syncthreads();
        const unsigned* PS = (const unsigned*)(ws + WS_PS); const bf16* GGp = (const bf16*)(ws + WS_GG); bf16* ROp = (bf16*)(ws + WS_RO);
        const int c4 = (tid & 31) * 4, r0 = tid >> 5;
#pragma unroll 4
        for (int i = 0; i < 32; ++i) { const int row = r0 + 16 * i; const size_t off = (size_t)(m0 + row) * 1024 + nb * 128 + c4, offo = (size_t)(m0 + row) * 2048 + nb * 128 + c4;
            const u32x4 ps = *(const u32x4*)(PS + off); const u32x2 gv = *(const u32x2*)(GGp + off); const f32x4 hin = *(const LAS f32x4*)(HINT + (row >> 4) * 128 + c4);
            const float h0 = bflo(ps.x) * hin[0] + bfhi(ps.x), h1 = bflo(ps.y) * hin[1] + bfhi(ps.y), h2 = bflo(ps.z) * hin[2] + bfhi(ps.z), h3 = bflo(ps.w) * hin[3] + bfhi(ps.w);
            u32x2 o; o.x = pk2(h0 * bflo(gv.x), h1 * bfhi(gv.x)); o.y = pk2(h2 * bflo(gv.y), h3 * bfhi(gv.y)); *(u32x2*)(ROp + offo) = o; }
    }
}

constexpr int L_K = 0, L_V = 69632;
DI f32x16 mfma32(bf16x8 a, bf16x8 b, f32x16 c) { return __builtin_amdgcn_mfma_f32_32x32x16_bf16(a, b, c, 0, 0, 0); }
DI void attn_phase(LAS unsigned char* lds, int l, int tid, int wave, int lane, int it_first, int it_count, int it_stride) {
    const int r = lane & 31, h = lane >> 5;
    const kargp_t kp = kargs(); unsigned char* ws = karg_ws(kp);
    const bf16* Q = (const bf16*)(ws + WS_Q); const bf16* KB = (const bf16*)(ws + WS_KB); const bf16* VB = (const bf16*)(ws + WS_VB); bf16* AO = (bf16*)(ws + WS_RO) + 1024;   const float* sinks = karg_in(kp, 16) + l * 8;
    for (int itk = 0; itk < it_count; ++itk) { const int it = it_first + itk * it_stride;
        const int b = it >> 7, qblk = (it >> 1) & 63, kvh = it & 1; const int rowbase = b * SEQ + qblk * 128;
        __syncthreads();
        { u32x4 kreg[8], vreg[8];
#pragma unroll
          for (int i = 0; i < 8; ++i) { const int idx = tid + 512 * i, j = idx >> 4, c = idx & 15; const int jr = (qblk > 0 || j >= 128) ? j : 128;
            kreg[i] = *(const u32x4*)(KB + (size_t)(rowbase - 128 + jr) * 256 + kvh * 128 + c * 8); vreg[i] = *(const u32x4*)(VB + (size_t)(rowbase - 128 + jr) * 256 + kvh * 128 + c * 8); }
#pragma unroll
          for (int i = 0; i < 8; ++i) { const int idx = tid + 512 * i, j = idx >> 4, c = idx & 15; const bool ok = (qblk > 0 || j >= 128); const u32x4 z = (u32x4){0u, 0u, 0u, 0u};
            *(LAS u32x4*)(lds + L_K + j * 272 + c * 16) = ok ? kreg[i] : z; *(LAS u32x4*)(lds + L_V + j * 272 + c * 16) = ok ? vreg[i] : z; } }
        const int g = wave >> 1, head = kvh * 4 + g;
        bf16x8 qf[8], qn[8];
#pragma unroll
        for (int ks = 0; ks < 8; ++ks) qf[ks] = *(const bf16x8*)(Q + (size_t)(rowbase + 64 * (wave & 1) + r) * 1024 + head * 128 + 16 * ks + 8 * h);
        __syncthreads();
        const float slope2 = exp2f(-(float)(head + 1)) * LOG2E, sink2 = sinks[head] * LOG2E;
#pragma unroll 1
        for (int si = 0; si < 2; ++si) {
            const int q0 = 64 * (wave & 1) + 32 * si, kt0 = q0 >> 5; const size_t qrow = (size_t)(rowbase + q0 + r);
            const LAS unsigned char* kbase = lds + L_K + (32 * kt0 + r) * 272 + 16 * h;
            const LAS unsigned char* vbase = lds + L_V + (32 * kt0 + 4 * h + ((lane & 15) >> 2)) * 272 + (16 * ((lane >> 4) & 1) + 4 * (lane & 3)) * 2;
            const int d0 = (q0 + r) + 128 - (32 * kt0 + 4 * h);
            const int jlim = qblk > 0 ? -100000 : 128 - (32 * kt0 + 4 * h);
            const float fd0 = (float)d0, fjl = (float)jlim;
            f32x16 p[5];
#pragma unroll
            for (int t = 0; t < 5; ++t) {
#pragma unroll
                for (int e = 0; e < 16; ++e) p[t][e] = 0.f;
#pragma unroll
                for (int ks = 0; ks < 8; ++ks) { const bf16x8 kf = *(const LAS bf16x8*)(kbase + t * 8704 + ks * 32); p[t] = mfma32(kf, qf[ks], p[t]); } }
            if (si == 0) {
#pragma unroll
                for (int ks = 0; ks < 8; ++ks) qn[ks] = *(const bf16x8*)(Q + (qrow + 32) * 1024 + head * 128 + 16 * ks + 8 * h);
            }
            float mx = sink2;
#pragma unroll
            for (int t = 0; t < 5; ++t) {
                if (t >= 1 && t <= 3 && qblk > 0) {
#pragma unroll
                    for (int e = 0; e < 16; ++e) { const float cte = (float)(32 * t + (e & 3) + 8 * (e >> 2)); p[t][e] = p[t][e] - slope2 * (fd0 - cte); mx = fmaxf(mx, p[t][e]); }
                } else {
#pragma unroll
                    for (int e = 0; e < 16; ++e) { const float cte = (float)(32 * t + (e & 3) + 8 * (e >> 2)); const float fd = fd0 - cte;
                        const float bad = fmaxf(fmaxf(-fd, fd - 127.0f), fjl - cte);
                        p[t][e] = p[t][e] - slope2 * fd + fminf(0.f, -1e30f * bad); mx = fmaxf(mx, p[t][e]); }
                } }
            mx = fmaxf(mx, __shfl_xor(mx, 32));
            float sum = 0.f;
#pragma unroll
            for (int t = 0; t < 5; ++t)
#pragma unroll
                for (int e = 0; e < 16; ++e) { const float ev = fexp2(p[t][e] - mx); p[t][e] = ev; sum += ev; }
            sum += __shfl_xor(sum, 32); sum += fexp2(sink2 - mx);
            const float inv = 1.0f / sum;
            f32x16 o[4];
#pragma unroll
            for (int dt = 0; dt < 4; ++dt)
#pragma unroll
                for (int e = 0; e < 16; ++e) o[dt][e] = 0.f;
#pragma unroll
            for (int t = 0; t < 5; ++t) {
#pragma unroll
                for (int s = 0; s < 2; ++s) { u32x4 pk; pk.x = pk2(p[t][8 * s + 0], p[t][8 * s + 1]); pk.y = pk2(p[t][8 * s + 2], p[t][8 * s + 3]); pk.z = pk2(p[t][8 * s + 4], p[t][8 * s + 5]); pk.w = pk2(p[t][8 * s + 6], p[t][8 * s + 7]);
                    const bf16x8 pf = __builtin_bit_cast(bf16x8, pk);
#pragma unroll
                    for (int dt = 0; dt < 4; ++dt) { const LAS unsigned char* va = vbase + t * 8704 + s * 4352 + dt * 64;
                        const s16x4 lo = __builtin_amdgcn_ds_read_tr16_b64_v4i16((LAS s16x4*)va), hi = __builtin_amdgcn_ds_read_tr16_b64_v4i16((LAS s16x4*)(va + 2176));
                        const bf16x8 vf = __builtin_shufflevector(lo, hi, 0, 1, 2, 3, 4, 5, 6, 7); o[dt] = mfma32(vf, pf, o[dt]); } } }
#pragma unroll
            for (int dt = 0; dt < 4; ++dt)
#pragma unroll
                for (int gg = 0; gg < 4; ++gg) { u32x2 w; w.x = pk2(o[dt][4 * gg] * inv, o[dt][4 * gg + 1] * inv); w.y = pk2(o[dt][4 * gg + 2] * inv, o[dt][4 * gg + 3] * inv);
                    *(u32x2*)(AO + qrow * 2048 + head * 128 + 32 * dt + 8 * gg + 4 * h) = w; }
#pragma unroll
            for (int ks = 0; ks < 8; ++ks) qf[ks] = qn[ks];
        }
    }
}

constexpr int N_PHASES = 2 + 9 * DEPTH;
__global__ void __launch_bounds__(NWAVES * 64, 2) trunk_fwd(Args args) {
    extern __shared__ __attribute__((aligned(16))) unsigned char lds_raw[];
    LAS unsigned char* lds = (LAS unsigned char*)lds_raw;
    volatile LAS unsigned* MISC = (volatile LAS unsigned*)(lds + MISC_OFF);
    const int tid0 = threadIdx.x;
#define TID_DEFS int tid = tid0; asm volatile("" : "+v"(tid)); const int lane = tid & 63, wave = __builtin_amdgcn_readfirstlane(tid >> 6); (void)lane; (void)wave;
    const int G = gridDim.x;
    gu32* ctl = (gu32*)(args.ws + WS_CTL);
    for (int u = tid0; u < (LDS_BYTES - LDSCTL_OFF) / 4; u += NWAVES * 64) ((LAS unsigned*)(lds + LDSCTL_OFF))[u] = 0u;
    __syncthreads();
    XcdBarrier bar = xcd_barrier_post((unsigned*)ctl + CW_BAR, MISC + 8);
    const int lo = args.ph_lo, hi = args.ph_hi;
#ifndef PH_MASK
#define PH_MASK 0xffffffffu
#endif
#define EN(b) ((PH_MASK >> (b)) & 1u)
#ifndef A_ALIGN
#define A_ALIGN true
#endif
#ifndef MIX_DEAL
#define MIX_DEAL 0
#endif
#ifndef BINPACK
#define BINPACK 1
#endif
#ifndef FUSE_DENSE
#define FUSE_DENSE 0
#endif
#ifndef PH_REPEAT
#define PH_REPEAT 0u
#endif
#ifndef PH_NREP
#define PH_NREP 2
#endif
#define REPS(b) (((PH_REPEAT >> (b)) & 1u) ? PH_NREP : 1)
#define REP_BEGIN(b) for (int rep_ = 0; rep_ < REPS(b); ++rep_) { if (rep_) xcd_barrier(bar);
#define REP_END }
#define IN(k) (lo <= (k) && (k) < hi)
#ifndef BAR_TWICE
#define BAR_TWICE 0
#endif
#define SEAM(k) do { if (IN(k) && IN((k) + 1)) { xcd_barrier(bar); if (BAR_TWICE) xcd_barrier(bar); } } while (0)
#if NAIVE_GEMM
#define RUN_GEMM(EPI, SCHED, ALIGN, g, S, E) pg8::gemm_phase_naive<EPI, SCHED>(g, S, E)
#else
#ifndef BF_SP2
#define BF_SP2 true
#endif
#define RUN_GEMM(EPI, SCHED, ALIGN, g, S, E) pg8::gemm_phase<EPI, SCHED, ALIGN, BF_SP2>(lds + RING_OFF, g, S, E)
#endif
#ifndef F8_ALIGN
#define F8_ALIGN(a) (a)
#endif
#ifndef F8_SP2
#define F8_SP2 false
#endif
#define RUN_GEMM8(EPI, SCHED, ALIGN, g, S, E) pg8::gemm_phase<EPI, SCHED, F8_ALIGN(ALIGN), F8_SP2, true>(lds + RING_OFF, g, S, E)
#define SC_ONE 0x7f7f7f7f
#define SC_M5 0x7a7a7a7a
#define SC_M6 0x79797979
    if (EN(0) && IN(0)) { REP_BEGIN(0) TID_DEFS p0_prologue(lds, tid, wave, lane); REP_END } SEAM(0);
    if (EN(1) && IN(1)) { REP_BEGIN(1) TID_DEFS thin_start(wave, lane); REP_END } SEAM(1);

    for (int l = 0; l < DEPTH; ++l) {
        const int pb = 2 + 9 * l;
        const bool binpack = BINPACK && G == 256;
        if (EN(2) && IN(pb + 0)) { REP_BEGIN(2)
            unsigned char* ws = karg_ws(kargs());
            pg8::Gemm g{(const bf16*)(ws + WS_XN), (const bf16*)(ws + WS_WL + (size_t)l * WL_STRIDE + WL_WIN), M, D_IN, D}; pg8::StaticOrder S; S.init(M, binpack ? 16 * 256 : D_IN, G, (int)blockIdx.x);
            pg8::EpiWin E; E.R = ws + WS_R;
            RUN_GEMM(pg8::EpiWin, pg8::StaticOrder, A_ALIGN, g, S, E);
        REP_END } SEAM(pb + 0);
        if (IN(pb + 1)) {
            if (binpack) {
                const int xq = (int)blockIdx.x & 7, qq = (int)blockIdx.x >> 3; const bool gx = qq < 16; const int c = gx ? xq * 16 + qq : 128 + xq * 16 + (qq - 16);
#define MIX_GEMM() do { unsigned char* ws = karg_ws(kargs()); \
                    pg8::Gemm g{(const bf16*)(ws + WS_XN), (const bf16*)(ws + WS_WL + (size_t)l * WL_STRIDE + WL_WIN), M, D_IN, D}; pg8::ListOrder S; S.first = gx ? 48 * xq + qq : 48 * xq + 16 + 2 * (qq - 16); S.count = gx ? 1 : 2; S.ncol = 6; S.pn0 = 16; \
                    pg8::EpiWin E; E.R = ws + WS_R; \
                    RUN_GEMM(pg8::EpiWin, pg8::ListOrder, A_ALIGN, g, S, E); } while (0)
                if (EN(2)) MIX_GEMM();
                if (gx) { if (EN(3)) { TID_DEFS rnn_pass1(lds, l, tid, wave, lane, 2 * c, 2, 1); } }
                else { if (EN(4)) { TID_DEFS attn_phase(lds, l, tid, wave, lane, 2 * (c - 128), 2, 1); } }
#undef MIX_GEMM
            } else {
                const int c = vcu_index(), cnt = c < 256 ? (256 - c + G - 1) / G : 0;
                if (EN(3)) { REP_BEGIN(3) TID_DEFS rnn_pass1(lds, l, tid, wave, lane, c, cnt, G); REP_END }
                if (EN(4)) { REP_BEGIN(4) TID_DEFS attn_phase(lds, l, tid, wave, lane, c, cnt, G); REP_END }
            }
        } SEAM(pb + 1);
        if (EN(5) && IN(pb + 2)) { REP_BEGIN(5) TID_DEFS rnn_pass2(lds, tid); REP_END } SEAM(pb + 2);
        if (EN(6) && IN(pb + 3)) { REP_BEGIN(6)
            unsigned char* ws = karg_ws(kargs());
            pg8::Gemm g{(const bf16*)(ws + WS_RO), (const bf16*)(ws + WS_WL + (size_t)l * WL_STRIDE + WL_WB), M, D, 2 * D}; pg8::StaticOrder S; S.init(M, D, G, (int)blockIdx.x);
            pg8::EpiMerge E; E.R = ws + WS_R; RUN_GEMM(pg8::EpiMerge, pg8::StaticOrder, false, g, S, E);
         REP_END } SEAM(pb + 3);
        const bool fuse = FUSE_DENSE && !(l & 1) && G == 256;
        if (EN(7) && IN(pb + 4)) { REP_BEGIN(7)
            const kargp_t kp = kargs(); unsigned char* ws = karg_ws(kp);
            pg8::Gemm g{(const bf16*)(ws + WS_MG), (const bf16*)(ws + WS_WL + (size_t)l * WL_STRIDE + WL_WO), M, D, D}; pg8::StaticOrder S; S.init(M, D, G, (int)blockIdx.x);
            if (fuse) {
                const float* ada = (const float*)(ws + WS_ADA) + (size_t)(l * 2) * 6144; unsigned* ctlw = (unsigned*)(ws + WS_CTL); const int bank = (l >> 1) * 4;
                pg8::EpiRmsResRms E; E.xin32 = (l == 0) ? karg_in(kp, 0) : nullptr; E.xin16 = (const bf16*)(ws + WS_XB); E.XB = (bf16*)(ws + WS_XB); E.XN = (bf16*)(ws + WS_XN); E.xn_fp8 = (int)((FP8_LAYERS >> l) & 1u);
                E.gainA = karg_in(kp, 5) + l * D; E.gateA = ada + 2048; E.gainB = karg_in(kp, 6) + l * D; E.scB = ada + 4096; E.shB = ada + 3072;
                E.st1.xbuf = (float*)(ws + WS_XS) + (size_t)bank * 65536; E.st1.cnt = ctlw + CW_SEAM + bank * SEAM_BANK; E.st1.tmo = ctlw;
                E.st2.xbuf = (float*)(ws + WS_XS) + (size_t)(bank + 1) * 65536; E.st2.cnt = ctlw + CW_SEAM + (bank + 1) * SEAM_BANK; E.st2.tmo = ctlw;
                RUN_GEMM(pg8::EpiRmsResRms, pg8::StaticOrder, false, g, S, E);
            } else { pg8::EpiBf16N E; E.O = (bf16*)(ws + WS_MIX); RUN_GEMM(pg8::EpiBf16N, pg8::StaticOrder, false, g, S, E); }
        REP_END } SEAM(pb + 4);
        if (IN(pb + 5) && !fuse) { if (l & 1) { if (EN(9)) { TID_DEFS thin_mid_moe(lds, l, tid, wave, lane); } } else { if (EN(8)) { TID_DEFS thin_mid_dense(l, wave, lane); } } }
        if (!fuse) SEAM(pb + 5);
        if (l & 1) {
            if (EN(10) && IN(pb + 6)) { REP_BEGIN(10)
                unsigned char* ws = karg_ws(kargs()); const unsigned* cntg = (const unsigned*)(ws + WS_CTL) + CW_CNT + 64 * (l >> 1);
                pg8::Gemm g{(const bf16*)(ws + WS_AP), (const bf16*)(ws + WS_WM + (size_t)(l >> 1) * WM_STRIDE + WM_MIN), 0, 0, D, SC_M5, SC_ONE}; pg8::MoeOrder S; S.init(cntg, 12, G, (int)blockIdx.x, ECAP / 256);
                if ((FP8_LAYERS >> l) & 1u) { pg8::EpiSwiglu8 E; E.O = ws + WS_ACTP; E.ldc = D_FFE; E.ntile = 12; RUN_GEMM8(pg8::EpiSwiglu8, pg8::MoeOrder, true, g, S, E); }
                else { pg8::EpiSwiglu E; E.O = (bf16*)(ws + WS_ACTP); E.ldc = D_FFE; E.ntile = 12; RUN_GEMM(pg8::EpiSwiglu, pg8::MoeOrder, true, g, S, E); }
             REP_END } SEAM(pb + 6);
            if (EN(11) && IN(pb + 7)) { REP_BEGIN(11)
                unsigned char* ws = karg_ws(kargs()); const unsigned* cntg = (const unsigned*)(ws + WS_CTL) + CW_CNT + 64 * (l >> 1);
                pg8::Gemm g{(const bf16*)(ws + WS_ACTP), (const bf16*)(ws + WS_WM + (size_t)(l >> 1) * WM_STRIDE + WM_MOUT), 0, 0, D_FFE, SC_M5, SC_ONE}; pg8::MoeOrder S; S.init(cntg, 4, G, (int)blockIdx.x, 0);
                pg8::EpiBf16Mod4 E; E.O = (bf16*)(ws + WS_YP);
                if ((FP8_LAYERS >> l) & 1u) RUN_GEMM8(pg8::EpiBf16Mod4, pg8::MoeOrder, true, g, S, E); else RUN_GEMM(pg8::EpiBf16Mod4, pg8::MoeOrder, true, g, S, E);
             REP_END } SEAM(pb + 7);
        } else {
            if (EN(12) && IN(pb + 6)) { REP_BEGIN(12)
                unsigned char* ws = karg_ws(kargs());
                pg8::Gemm g{(const bf16*)(ws + WS_XN), (const bf16*)(ws + WS_WD + (size_t)(l >> 1) * WD_STRIDE + WD_FIN), M, 2 * D_FF, D, SC_M5, SC_ONE}; pg8::StaticOrder S; S.init(M, 2 * D_FF, G, (int)blockIdx.x);
                if ((FP8_LAYERS >> l) & 1u) { pg8::EpiSwiglu8 E; E.O = ws + WS_ACT; E.ldc = D_FF; E.ntile = 24; RUN_GEMM8(pg8::EpiSwiglu8, pg8::StaticOrder, true, g, S, E); }
                else { pg8::EpiSwiglu E; E.O = (bf16*)(ws + WS_ACT); E.ldc = D_FF; E.ntile = 24; RUN_GEMM(pg8::EpiSwiglu, pg8::StaticOrder, true, g, S, E); }
             REP_END } SEAM(pb + 6);
            if (EN(13) && IN(pb + 7)) { REP_BEGIN(13)
                unsigned char* ws = karg_ws(kargs());
                pg8::Gemm g{(const bf16*)(ws + WS_ACT), (const bf16*)(ws + WS_WD + (size_t)(l >> 1) * WD_STRIDE + WD_FOUT), M, D, D_FF, SC_M6, SC_ONE}; pg8::StaticOrder S; S.init(M, D, G, (int)blockIdx.x);
                if (fuse) {
                    const kargp_t kp = kargs(); const float* ada = (const float*)(ws + WS_ADA) + (size_t)(l * 2) * 6144; const float* adan = (const float*)(ws + WS_ADA) + (size_t)((l + 1) * 2) * 6144; unsigned* ctlw = (unsigned*)(ws + WS_CTL); const int bank = (l >> 1) * 4 + 2;
                    pg8::EpiRmsResRms E; E.xin32 = nullptr; E.xin16 = (const bf16*)(ws + WS_XB); E.XB = (bf16*)(ws + WS_XB); E.XN = (bf16*)(ws + WS_XN); E.xn_fp8 = 0;
                    E.gainA = karg_in(kp, 7) + l * D; E.gateA = ada + 5120; E.gainB = karg_in(kp, 4) + (l + 1) * D; E.scB = adan + 1024; E.shB = adan;
                    E.st1.xbuf = (float*)(ws + WS_XS) + (size_t)bank * 65536; E.st1.cnt = ctlw + CW_SEAM + bank * SEAM_BANK; E.st1.tmo = ctlw;
                    E.st2.xbuf = (float*)(ws + WS_XS) + (size_t)(bank + 1) * 65536; E.st2.cnt = ctlw + CW_SEAM + (bank + 1) * SEAM_BANK; E.st2.tmo = ctlw;
                    if ((FP8_LAYERS >> l) & 1u) RUN_GEMM8(pg8::EpiRmsResRms, pg8::StaticOrder, false, g, S, E); else RUN_GEMM(pg8::EpiRmsResRms, pg8::StaticOrder, false, g, S, E);
                } else { pg8::EpiBf16N E; E.O = (bf16*)(ws + WS_MIX);
                    if ((FP8_LAYERS >> l) & 1u) RUN_GEMM8(pg8::EpiBf16N, pg8::StaticOrder, false, g, S, E); else RUN_GEMM(pg8::EpiBf16N, pg8::StaticOrder, false, g, S, E); }
             REP_END } SEAM(pb + 7);
        }
        if (EN(14) && IN(pb + 8) && !fuse) { TID_DEFS thin_end(l, wave, lane); }
        if (!fuse) SEAM(pb + 8);
    }
#undef IN
#undef SEAM
}

extern "C" void kernel_launch(void* const* d_in, const int* in_sizes, int n_in, void* d_out, int out_size, void* d_ws, size_t ws_size, hipStream_t stream) {
    static int grid = 0;
    if (grid == 0) {
        if (n_in != 24 || in_sizes[0] != M * D || out_size != M * D || ws_size < WS_END) { fprintf(stderr, "kernel_launch: unexpected shapes or workspace (n_in %d, in0 %d, out %d, ws %zu < %zu); nothing launched\n", n_in, n_in > 0 ? in_sizes[0] : -1, out_size, ws_size, (size_t)WS_END); grid = -1; return; }
        int dev = 0, cus = 0, per_cu = 0;
        if (hipGetDevice(&dev) != hipSuccess || hipDeviceGetAttribute(&cus, hipDeviceAttributeMultiprocessorCount, dev) != hipSuccess) { grid = -1; return; }
        if (hipFuncSetAttribute((const void*)trunk_fwd, hipFuncAttributeMaxDynamicSharedMemorySize, LDS_BYTES) != hipSuccess) { fprintf(stderr, "kernel_launch: hipFuncSetAttribute failed\n"); grid = -1; return; }
        if (hipOccupancyMaxActiveBlocksPerMultiprocessor(&per_cu, (const void*)trunk_fwd, NWAVES * 64, LDS_BYTES) != hipSuccess || per_cu < 1)
            fprintf(stderr, "kernel_launch: note: occupancy query reports %d workgroups per CU\n", per_cu);
        (void)hipGetLastError();
        grid = cus;
    }
    if (grid < 0) return;
    if (hipMemsetAsync((char*)d_ws + WS_CTL, 0, CTL_ZERO_BYTES, stream) != hipSuccess) return;
    Args a{};
    for (int i = 0; i < 24; ++i) a.in[i] = (const float*)d_in[i];
    a.out = (float*)d_out; a.ws = (unsigned char*)d_ws;
#if MK_ONE_LAUNCH
    a.ph_lo = 0; a.ph_hi = N_PHASES;
    hipLaunchKernelGGL(trunk_fwd, dim3(grid), dim3(NWAVES * 64), LDS_BYTES, stream, a);
#else
    for (int p = 0; p < N_PHASES; ++p) { a.ph_lo = p; a.ph_hi = p + 1; hipLaunchKernelGGL(trunk_fwd, dim3(grid), dim3(NWAVES * 64), LDS_BYTES, stream, a); }
#endif
}
```
